# Optimizing an MI355X kernel written in HIP

```python
import jax, jax.numpy as jnp
from jax import lax
import numpy as np

D_MODEL = 1024
BATCH = 4
SEQ = 8192
DEPTH = 1

HEAD_DIM = 64
ATTN_GROUPS = ((128, 1), (512, 4), (2048, 16))
N_GROUPS = len(ATTN_GROUPS)
ATTN_HEADS_PER_GROUP = 4
ATTN_GROUP_WIDTH = ATTN_HEADS_PER_GROUP * HEAD_DIM
Q_BLOCK = 128
ROPE_THETA = 10000.0
RWKV_HEADS = 8
RWKV_WIDTH = RWKV_HEADS * HEAD_DIM
DECAY_LORA = 32
ICLR_LORA = 32
GATE_LORA = 96
RWKV_GN_EPS = 64e-5
D_FF = 4 * D_MODEL
PLE_DIM = 256
NORM_EPS = 1e-6

ATTN_QKV_COLS = 3 * N_GROUPS * ATTN_GROUP_WIDTH
RWKV_SPLITS = (RWKV_WIDTH, 2 * RWKV_WIDTH, 3 * RWKV_WIDTH,
               3 * RWKV_WIDTH + DECAY_LORA, 3 * RWKV_WIDTH + DECAY_LORA + ICLR_LORA)
RWKV_COLS = 3 * RWKV_WIDTH + DECAY_LORA + ICLR_LORA + GATE_LORA
GATE_COLS = 2 * D_MODEL
IN_COLS = ATTN_QKV_COLS + RWKV_COLS + GATE_COLS

kernel_name = 'hybrid_dilated_attn_rwkv7_gated_block'


def rmsnorm(x, g):
    xf = x.astype(jnp.float32)
    y = xf * lax.rsqrt(jnp.mean(xf * xf, axis=-1, keepdims=True) + NORM_EPS)
    return (y * g.astype(jnp.float32)).astype(x.dtype)


def rope(x, pos):
    half = HEAD_DIM // 2
    inv_freq = ROPE_THETA ** (-jnp.arange(0, HEAD_DIM, 2, dtype=jnp.float32) / HEAD_DIM)
    ang = pos[:, None] * inv_freq[None, :]
    ang = ang.reshape((pos.shape[0],) + (1,) * (x.ndim - 3) + (half,))
    c, s = jnp.cos(ang), jnp.sin(ang)
    xf = x.astype(jnp.float32)
    x1, x2 = xf[..., :half], xf[..., half:]
    return jnp.concatenate([x1 * c - x2 * s, x2 * c + x1 * s], axis=-1).astype(x.dtype)


def token_shift(z):
    return jnp.pad(z[:, :-1], ((0, 0), (1, 0), (0, 0)))


def dilated_attention_branch(z_attn):
    B, S, _ = z_attn.shape
    qkv = z_attn.reshape(B, S, 3, N_GROUPS, ATTN_HEADS_PER_GROUP, HEAD_DIM)
    pos = jnp.arange(S, dtype=jnp.float32)
    q = rope(qkv[:, :, 0], pos)
    k = rope(qkv[:, :, 1], pos)
    v = qkv[:, :, 2]
    qs = [q[:, :, g] for g in range(N_GROUPS)]
    ks = [k[:, :, g] for g in range(N_GROUPS)]
    vs = [v[:, :, g] for g in range(N_GROUPS)]
    scale = HEAD_DIM ** -0.5

    def block(bi):
        start = bi * Q_BLOCK
        t = start + jnp.arange(Q_BLOCK)
        outs, lses = [], []
        for g, (window, dil) in enumerate(ATTN_GROUPS):
            j = jnp.arange(window // dil + 1)
            idx = t[:, None] - dil * j[None, :]
            valid = idx >= 0
            idx_c = jnp.maximum(idx, 0)
            qb = lax.dynamic_slice_in_dim(qs[g], start, Q_BLOCK, axis=1)
            kg = jnp.take(ks[g], idx_c, axis=1)
            vg = jnp.take(vs[g], idx_c, axis=1)
            s = jnp.einsum('bqhd,bqjhd->bqhj', qb, kg, preferred_element_type=jnp.float32) * scale
            s = jnp.where(valid[None, :, None, :], s, -jnp.inf)
            m = jnp.max(s, axis=-1, keepdims=True)
            e = jnp.exp(s - m)
            den = jnp.sum(e, axis=-1)
            o = jnp.einsum('bqhj,bqjhd->bqhd', e, vg.astype(jnp.float32)) / den[..., None]
            outs.append(o)
            lses.append(m[..., 0] + jnp.log(den))
        alpha = jax.nn.softmax(jnp.stack(lses, axis=0), axis=0)
        o = alpha[0][..., None] * outs[0]
        for g in range(1, N_GROUPS):
            o = o + alpha[g][..., None] * outs[g]
        return o.astype(z_attn.dtype)

    out = lax.map(block, jnp.arange(S // Q_BLOCK))
    return out.transpose(1, 0, 2, 3, 4).reshape(B, S, ATTN_GROUP_WIDTH)


def rwkv7_time_mix(z, mu, w0, w2, a0, a2, g2, k_k, k_a, r_k, ln_w, ln_b):
    B, S, _ = z.shape
    f32 = jnp.float32
    z = z + (token_shift(z) - z) * mu
    r, k, v, xw, xa, xg = jnp.split(z, RWKV_SPLITS, axis=-1)
    logw = -jax.nn.softplus(-(w0 + jnp.tanh(xw) @ w2)) - 0.5
    decay = jnp.exp(-jnp.exp(logw.astype(f32)))
    a = jax.nn.sigmoid(a0 + xa @ a2)
    g = jax.nn.sigmoid(xg) @ g2
    heads = lambda t: t.reshape(B, S, RWKV_HEADS, HEAD_DIM).astype(f32)
    kk = heads(k * k_k)
    kk = kk / jnp.maximum(jnp.sqrt(jnp.sum(kk * kk, axis=-1, keepdims=True)), 1e-12)
    k = k * (1.0 + (a - 1.0) * k_a)
    r_h, k_h, v_h, a_h, w_h = heads(r), heads(k), heads(v), heads(a), heads(decay)
    seq = tuple(jnp.moveaxis(t, 1, 0) for t in (r_h, w_h, k_h, v_h, -kk, kk * a_h))

    def step(state, inp):
        r_t, w_t, k_t, v_t, a_t, b_t = inp
        sa = jnp.einsum('bhvk,bhk->bhv', state, a_t)
        state = (state * w_t[:, :, None, :] + sa[..., None] * b_t[:, :, None, :]
                 + v_t[..., None] * k_t[:, :, None, :])
        y = jnp.einsum('bhvk,bhk->bhv', state, r_t)
        return state, y

    state0 = jnp.zeros((B, RWKV_HEADS, HEAD_DIM, HEAD_DIM), f32)
    _, y = lax.scan(step, state0, seq)
    y = jnp.moveaxis(y, 0, 1)
    mean = jnp.mean(y, axis=-1, keepdims=True)
    var = jnp.mean(jnp.square(y - mean), axis=-1, keepdims=True)
    y = (y - mean) * lax.rsqrt(var + RWKV_GN_EPS)
    y = y.reshape(B, S, RWKV_WIDTH) * ln_w.astype(f32) + ln_b.astype(f32)
    bonus = jnp.sum(r_h * k_h * r_k.astype(f32), axis=-1, keepdims=True) * v_h
    y = (y + bonus.reshape(B, S, RWKV_WIDTH)) * g.astype(f32)
    return y.astype(z.dtype)


def setup_inputs(seed: int = 0) -> dict:
    key = jax.random.key(seed)
    ks = jax.random.split(key, 32)
    f32 = jnp.float32
    nrm = lambda k, shape, scale: jax.random.normal(k, shape, f32) * scale
    gain = lambda k, n: 1.0 + 0.02 * jax.random.normal(k, (DEPTH, n), f32)
    L = DEPTH
    return {
        'x': jax.random.normal(ks[0], (BATCH, SEQ, D_MODEL), f32),
        'p': jax.random.normal(ks[1], (DEPTH, BATCH, SEQ, PLE_DIM), f32),
        'mix_pre_norm': gain(ks[2], D_MODEL),
        'w_in': nrm(ks[3], (L, D_MODEL, IN_COLS), D_MODEL ** -0.5),
        'rwkv_mu': jax.random.uniform(ks[4], (L, RWKV_COLS), f32, 0.2, 0.8),
        'rwkv_w0': jax.random.uniform(ks[5], (L, RWKV_WIDTH), f32, -4.0, 0.0),
        'rwkv_w2': nrm(ks[6], (L, DECAY_LORA, RWKV_WIDTH), 0.5 * DECAY_LORA ** -0.5),
        'rwkv_a0': nrm(ks[7], (L, RWKV_WIDTH), 0.1),
        'rwkv_a2': nrm(ks[8], (L, ICLR_LORA, RWKV_WIDTH), 0.5 * ICLR_LORA ** -0.5),
        'rwkv_g2': nrm(ks[9], (L, GATE_LORA, RWKV_WIDTH), GATE_LORA ** -0.5),
        'rwkv_k_k': 0.85 + 0.02 * jax.random.normal(ks[10], (L, RWKV_WIDTH), f32),
        'rwkv_k_a': 1.0 + 0.02 * jax.random.normal(ks[11], (L, RWKV_WIDTH), f32),
        'rwkv_r_k': nrm(ks[12], (L, RWKV_HEADS, HEAD_DIM), 0.1),
        'rwkv_ln_w': gain(ks[13], RWKV_WIDTH),
        'rwkv_ln_b': nrm(ks[14], (L, RWKV_WIDTH), 0.02),
        'w_attn_up': nrm(ks[15], (L, ATTN_GROUP_WIDTH, D_MODEL), ATTN_GROUP_WIDTH ** -0.5),
        'w_rwkv_up': nrm(ks[16], (L, RWKV_WIDTH, D_MODEL), RWKV_WIDTH ** -0.5),
        'w_out': nrm(ks[17], (L, D_MODEL, D_MODEL), D_MODEL ** -0.5),
        'mix_post_norm': gain(ks[18], D_MODEL),
        'ffn_pre_norm': gain(ks[19], D_MODEL),
        'w_ff_in': nrm(ks[20], (L, D_MODEL, D_FF), D_MODEL ** -0.5),
        'w_ff_out': nrm(ks[21], (L, D_FF, D_MODEL), D_FF ** -0.5),
        'ffn_post_norm': gain(ks[22], D_MODEL),
        'w_ple': nrm(ks[23], (L, PLE_DIM, D_MODEL), PLE_DIM ** -0.5),
        'w_ple_gate': nrm(ks[24], (L, D_MODEL, D_MODEL), D_MODEL ** -0.5),
        'ple_post_norm': gain(ks[25], D_MODEL),
    }


def reference(x, p, mix_pre_norm, w_in, rwkv_mu, rwkv_w0, rwkv_w2, rwkv_a0, rwkv_a2, rwkv_g2,
              rwkv_k_k, rwkv_k_a, rwkv_r_k, rwkv_ln_w, rwkv_ln_b, w_attn_up, w_rwkv_up, w_out,
              mix_post_norm, ffn_pre_norm, w_ff_in, w_ff_out, ffn_post_norm, w_ple, w_ple_gate,
              ple_post_norm):
    h = x
    for i in range(DEPTH):
        u = rmsnorm(h, mix_pre_norm[i])
        z = u @ w_in[i]
        z_attn = z[..., :ATTN_QKV_COLS]
        z_rwkv = z[..., ATTN_QKV_COLS:ATTN_QKV_COLS + RWKV_COLS]
        z_gate = z[..., ATTN_QKV_COLS + RWKV_COLS:]
        o_attn = dilated_attention_branch(z_attn)
        o_rwkv = rwkv7_time_mix(z_rwkv, rwkv_mu[i], rwkv_w0[i], rwkv_w2[i], rwkv_a0[i],
                                rwkv_a2[i], rwkv_g2[i], rwkv_k_k[i], rwkv_k_a[i], rwkv_r_k[i],
                                rwkv_ln_w[i], rwkv_ln_b[i])
        gate_attn, gate_rwkv = jnp.split(jax.nn.sigmoid(z_gate), 2, axis=-1)
        merged = gate_attn * (o_attn @ w_attn_up[i]) + gate_rwkv * (o_rwkv @ w_rwkv_up[i])
        h = h + rmsnorm(merged @ w_out[i], mix_post_norm[i])
        f = rmsnorm(h, ffn_pre_norm[i])
        f = jnp.square(jax.nn.relu(f @ w_ff_in[i])) @ w_ff_out[i]
        h = h + rmsnorm(f, ffn_post_norm[i])
        e = (p[i] @ w_ple[i]) * jax.nn.sigmoid(h @ w_ple_gate[i])
        h = h + rmsnorm(e, ple_post_norm[i])
    return h
```

```cpp
#include <hip/hip_runtime.h>
#include <cstdio>
#include <cstdint>
namespace pg8 {
#define PG8_LAS __attribute__((address_space(3)))
typedef unsigned short bf16_t;
typedef short bf16x8 __attribute__((ext_vector_type(8)));
typedef float f32x4 __attribute__((ext_vector_type(4)));
typedef unsigned u32x4 __attribute__((ext_vector_type(4)));
constexpr int BM = 256, BK = 64, HALF = 128, HTB = HALF * BK * 2  , STAGE_BYTES = 8 * HTB, NXCD = 8, WGM = 8;

__host__ __device__ __forceinline__ int lds_byte(int r, int c) { const int st = (r >> 4) * 2 + (c >> 5), rr = r & 15, cc = c & 31, ob = rr * 64 + cc * 2; return st * 1024 + (ob ^ (((ob >> 9) & 1) << 5)); }
__host__ __device__ __forceinline__ void stage_rc(int b, int& R, int& C) { const int st = b / 1024, sb = b % 1024, swz = sb ^ (((sb >> 9) & 1) << 5); R = (st >> 1) * 16 + swz / 64; C = (st & 1) * 32 + (swz % 64) / 2; }
__host__ __device__ __forceinline__ int perm32(int rho) { const int n = rho >> 4, i = rho & 15; return 8 * (i >> 2) + 4 * n + (i & 3); }

struct Unit { int pm, pn; };
struct Gemm { const bf16_t* A; const bf16_t* Bt; int M, N, K; };

struct StaticOrder {
    int nM, nN, nwg, G, c;
    __host__ __device__ void init(int M, int N, int G_, int c_) { nM = M / BM; nN = N / BM; nwg = nM * nN; G = G_; c = c_; }
    __host__ __device__ bool next(int i, Unit& u) const {
        const long L = (long)i * G + c; if (L >= nwg) return false;
        int wgid = (int)L; { const int q = nwg / NXCD, r = nwg % NXCD, xcd = wgid % NXCD, off = wgid / NXCD; wgid = (xcd < r ? xcd * (q + 1) : r * (q + 1) + (xcd - r) * q) + off; }
        const int nig = WGM * nN, gid = wgid / nig, fm = gid * WGM, gsz = (nM - fm) < WGM ? (nM - fm) : WGM;
        u.pm = fm + ((wgid % nig) % gsz); u.pn = (wgid % nig) / gsz; return true;
    }
    __device__ __forceinline__ void a_ready(const Unit&) const {}
    __device__ __forceinline__ void done(const Unit&) const {}
};

__device__ __forceinline__ unsigned cvt_pk_bf16(float lo, float hi) { unsigned r; asm volatile("v_cvt_pk_bf16_f32 %0, %1, %2" : "=v"(r) : "v"(lo), "v"(hi)); return r; }
typedef float f32x2 __attribute__((ext_vector_type(2)));
__device__ __forceinline__ f32x2 gelu_pk(f32x2 v) {
    const f32x2 av = __builtin_elementwise_abs(v), d = av * 0.2316418882f + 1.0f;
    f32x2 t; t.x = __builtin_amdgcn_rcpf(d.x); t.y = __builtin_amdgcn_rcpf(d.y);
    f32x2 q = t * 0.5307027145f + (-0.7265760135f); q = q * t + 0.7107068705f; q = q * t + (-0.142248368f); q = q * t + 0.127414796f; q = q * t;
    const f32x2 s = (v * v) * (-0.72134752044f);
    f32x2 e; e.x = __builtin_amdgcn_exp2f(s.x); e.y = __builtin_amdgcn_exp2f(s.y);
    const f32x2 m = v * (q * e), r = v - m;
    f32x2 o; o.x = v.x < 0.f ? m.x : r.x; o.y = v.y < 0.f ? m.y : r.y; return o;
}

template <int ACT  > struct EpiBf16 {
    static constexpr bool PERM = true, AFTER_DRAIN = false; static_assert(ACT == 0 || ACT == 1, "EpiBf16: ACT is 0 (none) or 1 (gelu_pk)");
    bf16_t* O; int ldc; const float* bias; int split_cols; size_t split_stride; float scale0;
    __device__ __forceinline__ void operator()(const f32x4 (&acc)[2][2][4][2], const Unit& u, int wr, int wc, int fr, int fq) const {
        const int row0 = u.pm * BM + wr * 64 + fr; int colt = u.pn * BM; bf16_t* base = O;
        float sc = 1.f; if (split_cols) { const int t = colt / split_cols; base += (size_t)t * split_stride; colt -= t * split_cols; if (t == 0) sc = scale0; }
        const int col0 = colt + wc * 32 + 8 * fq, bcol0 = u.pn * BM + wc * 32 + 8 * fq;
        f32x4 bv[2][2];
#pragma unroll
        for (int bj = 0; bj < 2; ++bj)
#pragma unroll
            for (int n = 0; n < 2; ++n) bv[bj][n] = bias ? *(const f32x4*)(bias + bcol0 + bj * HALF + 4 * n) : (f32x4){0.f, 0.f, 0.f, 0.f};
#pragma unroll
        for (int ai = 0; ai < 2; ++ai)
#pragma unroll
            for (int m = 0; m < 4; ++m) { bf16_t* rowp = base + (size_t)(row0 + ai * HALF + m * 16) * ldc + col0;
#pragma unroll
                for (int bj = 0; bj < 2; ++bj) { f32x4 v0 = acc[ai][bj][m][0] + bv[bj][0], v1 = acc[ai][bj][m][1] + bv[bj][1];
                    if (ACT == 1) { f32x2 a = gelu_pk((f32x2){v0[0], v0[1]}), b = gelu_pk((f32x2){v0[2], v0[3]}), c = gelu_pk((f32x2){v1[0], v1[1]}), d = gelu_pk((f32x2){v1[2], v1[3]});
                        v0 = (f32x4){a.x, a.y, b.x, b.y}; v1 = (f32x4){c.x, c.y, d.x, d.y}; }
                    v0 = v0 * sc; v1 = v1 * sc; u32x4 w; w.x = cvt_pk_bf16(v0[0], v0[1]); w.y = cvt_pk_bf16(v0[2], v0[3]); w.z = cvt_pk_bf16(v1[0], v1[1]); w.w = cvt_pk_bf16(v1[2], v1[3]);
                    *(u32x4*)(rowp + bj * HALF) = w; } }
    }
};
template <class Epi, class Sched, bool ALIGN_EPI = false, bool SP2 = false>
__device__ __forceinline__ void gemm_phase(PG8_LAS unsigned char* lds, const Gemm g, const Sched& S, const Epi& E) {
    const int tid = threadIdx.x, wid = __builtin_amdgcn_readfirstlane(tid >> 6), lane = tid & 63, wr = wid >> 2, wc = wid & 3, fr = lane & 15, fq = lane >> 4;
    const int K = g.K, nt = K / BK;
    unsigned voffA[2], voffB[2];
#pragma unroll
    for (int i = 0; i < 2; ++i) { int R, C; stage_rc(tid * 16 + i * 8192, R, C); const int Rb = Epi::PERM ? ((R & ~31) + perm32(R & 31)) : R;
        voffA[i] = (unsigned)(R * K + C) * 2u; voffB[i] = (unsigned)(Rb * K + C) * 2u; }
    const size_t kstep = (size_t)(BK * 2);
    const size_t hstep = (size_t)HALF * K * 2;
    const size_t tstep = 2 * hstep;
    const unsigned ldsw = (unsigned)wid * 1024u;
    const int aoff = lds_byte(wr * 64 + fr, fq * 8), boff = lds_byte(wc * 32 + fr, fq * 8);
#define PG8_SA(b, h) (((b) * 2 + (h)) * HTB)
#define PG8_SB(b, h) ((4 + (b) * 2 + (h)) * HTB)
#define PG8_STAGE(bufoff, gbase, voff) do { _Pragma("unroll") for (int _i = 0; _i < 2; ++_i) \
        __builtin_amdgcn_global_load_lds((const unsigned*)((const char*)(gbase) + (voff)[_i]), (PG8_LAS unsigned*)(lds + (bufoff) + ldsw + _i * 8192), 16, 0, 0); } while (0)
#define PG8_LDA(dst, b, h) do { _Pragma("unroll") for (int m = 0; m < 4; ++m) _Pragma("unroll") for (int k = 0; k < 2; ++k) dst[m][k] = *(const PG8_LAS bf16x8*)(lds + PG8_SA(b, h) + aoff + m * 2048 + k * 1024); } while (0)
#define PG8_LDB(dst, b, h) do { _Pragma("unroll") for (int n = 0; n < 2; ++n) _Pragma("unroll") for (int k = 0; k < 2; ++k) dst[n][k] = *(const PG8_LAS bf16x8*)(lds + PG8_SB(b, h) + boff + n * 2048 + k * 1024); } while (0)
#define PG8_MMA(ai, bj, At, Bt) do { __builtin_amdgcn_s_setprio(1); _Pragma("unroll") for (int m = 0; m < 4; ++m) _Pragma("unroll") for (int n = 0; n < 2; ++n) _Pragma("unroll") for (int k = 0; k < 2; ++k) \
        acc[ai][bj][m][n] = __builtin_amdgcn_mfma_f32_16x16x32_bf16(Bt[n][k], At[m][k], acc[ai][bj][m][n], 0, 0, 0); __builtin_amdgcn_s_setprio(0); } while (0)
#define PG8_WAIT_V(n) asm volatile("s_waitcnt vmcnt(" #n ")" ::: "memory")
#define PG8_WAIT_L(n) asm volatile("s_waitcnt lgkmcnt(" #n ")" ::: "memory")
#define PG8_BAR __builtin_amdgcn_s_barrier()
#define PG8_SCHED __builtin_amdgcn_sched_barrier(0)
    Unit cur, nxt; int ui = 0;
    if (!S.next(0, cur)) return;
    f32x4 acc[2][2][4][2];
#pragma unroll
    for (int a = 0; a < 2; ++a)
#pragma unroll
        for (int b = 0; b < 2; ++b)
#pragma unroll
            for (int m = 0; m < 4; ++m)
#pragma unroll
                for (int n = 0; n < 2; ++n) acc[a][b][m][n] = (f32x4){0.f, 0.f, 0.f, 0.f};
    bf16x8 At[4][2], B0[2][2], B1[2][2];
    const char* cA = (const char*)g.A + (size_t)cur.pm * tstep; const char* cB = (const char*)g.Bt + (size_t)cur.pn * tstep;
    S.a_ready(cur);
    if constexpr (SP2) {
        PG8_STAGE(PG8_SB(0, 0), cB, voffB); PG8_STAGE(PG8_SB(0, 1), cB + hstep, voffB); PG8_STAGE(PG8_SA(0, 0), cA, voffA); PG8_STAGE(PG8_SA(0, 1), cA + hstep, voffA);
        if (wr == 1) PG8_BAR;
        PG8_WAIT_V(2); PG8_BAR;
        PG8_STAGE(PG8_SB(1, 0), cB + kstep, voffB); PG8_STAGE(PG8_SA(1, 0), cA + kstep, voffA); PG8_STAGE(PG8_SB(1, 1), cB + hstep + kstep, voffB);
        PG8_WAIT_V(6); PG8_BAR;
    } else {
        PG8_STAGE(PG8_SB(0, 0), cB, voffB); PG8_STAGE(PG8_SA(0, 0), cA, voffA); PG8_STAGE(PG8_SB(0, 1), cB + hstep, voffB); PG8_STAGE(PG8_SA(0, 1), cA + hstep, voffA);
        if (wr == 1) PG8_BAR;
        PG8_WAIT_V(4); PG8_BAR;
        PG8_STAGE(PG8_SB(1, 0), cB + kstep, voffB); PG8_STAGE(PG8_SA(1, 0), cA + kstep, voffA); PG8_STAGE(PG8_SB(1, 1), cB + hstep + kstep, voffB);
        PG8_WAIT_V(6); PG8_BAR;
    }
    for (;;) {
        const bool has_next = S.next(ui + 1, nxt);
        const char* nA = has_next ? (const char*)g.A + (size_t)nxt.pm * tstep : cA; const char* nB = has_next ? (const char*)g.Bt + (size_t)nxt.pn * tstep : cB;
        for (int t = 0; t < nt; t += 2) {
            const bool last = (t == nt - 2);
            const char* a1 = cA + (size_t)(t + 1) * kstep;
            const char* a2 = last ? nA : cA + (size_t)(t + 2) * kstep; const char* b2 = last ? nB : cB + (size_t)(t + 2) * kstep;
            const char* a3 = a2 + kstep; const char* b3 = b2 + kstep;
            if (last && has_next) S.a_ready(nxt);
            if constexpr (SP2) {
            PG8_LDB(B0, 0, 0); PG8_LDB(B1, 0, 1); PG8_SCHED; PG8_LDA(At, 0, 0); PG8_STAGE(PG8_SA(1, 1), a1 + hstep, voffA);
            PG8_WAIT_V(8); PG8_WAIT_L(0); PG8_BAR; PG8_MMA(0, 0, At, B0); PG8_MMA(0, 1, At, B1); PG8_BAR; PG8_SCHED;
            PG8_LDA(At, 0, 1); PG8_STAGE(PG8_SB(0, 0), b2, voffB); PG8_STAGE(PG8_SB(0, 1), b2 + hstep, voffB); PG8_STAGE(PG8_SA(0, 0), a2, voffA);
            PG8_WAIT_V(8); PG8_WAIT_L(0); PG8_BAR; PG8_MMA(1, 0, At, B0); PG8_MMA(1, 1, At, B1); PG8_BAR; PG8_SCHED;
            PG8_LDB(B0, 1, 0); PG8_LDB(B1, 1, 1); PG8_SCHED; PG8_LDA(At, 1, 0); PG8_STAGE(PG8_SA(0, 1), a2 + hstep, voffA);
            PG8_WAIT_V(8); PG8_WAIT_L(0); PG8_BAR; PG8_MMA(0, 0, At, B0); PG8_MMA(0, 1, At, B1); PG8_BAR; PG8_SCHED;
            PG8_LDA(At, 1, 1); PG8_STAGE(PG8_SB(1, 0), b3, voffB); PG8_STAGE(PG8_SB(1, 1), b3 + hstep, voffB); PG8_STAGE(PG8_SA(1, 0), a3, voffA);
            PG8_WAIT_V(8); PG8_WAIT_L(0); PG8_BAR; PG8_MMA(1, 0, At, B0); PG8_MMA(1, 1, At, B1); PG8_BAR; PG8_SCHED;
            } else {
            PG8_LDB(B0, 0, 0); PG8_SCHED; PG8_LDA(At, 0, 0); PG8_STAGE(PG8_SA(1, 1), a1 + hstep, voffA);
            PG8_WAIT_L(8); PG8_BAR; PG8_WAIT_L(0); PG8_MMA(0, 0, At, B0); PG8_BAR; PG8_SCHED;
            PG8_LDB(B1, 0, 1); PG8_STAGE(PG8_SB(0, 0), b2, voffB);
            PG8_BAR; PG8_WAIT_L(0); PG8_MMA(0, 1, At, B1); PG8_BAR;
            PG8_LDA(At, 0, 1); PG8_STAGE(PG8_SA(0, 0), a2, voffA);
            PG8_BAR; PG8_WAIT_L(0); PG8_MMA(1, 0, At, B0); PG8_BAR; PG8_SCHED;
            PG8_STAGE(PG8_SB(0, 1), b2 + hstep, voffB);
            PG8_WAIT_V(6); PG8_BAR; PG8_MMA(1, 1, At, B1); PG8_BAR;
            PG8_LDB(B0, 1, 0); PG8_SCHED; PG8_LDA(At, 1, 0); PG8_STAGE(PG8_SA(0, 1), a2 + hstep, voffA);
            PG8_WAIT_L(8); PG8_BAR; PG8_WAIT_L(0); PG8_MMA(0, 0, At, B0); PG8_BAR; PG8_SCHED;
            PG8_LDB(B1, 1, 1); PG8_STAGE(PG8_SB(1, 0), b3, voffB);
            PG8_BAR; PG8_WAIT_L(0); PG8_MMA(0, 1, At, B1); PG8_BAR;
            PG8_LDA(At, 1, 1); PG8_STAGE(PG8_SA(1, 0), a3, voffA);
            PG8_BAR; PG8_WAIT_L(0); PG8_MMA(1, 0, At, B0); PG8_BAR; PG8_SCHED;
            PG8_STAGE(PG8_SB(1, 1), b3 + hstep, voffB);
            PG8_WAIT_V(6); PG8_BAR; PG8_MMA(1, 1, At, B1); PG8_BAR;
            }
        }
        if constexpr (ALIGN_EPI) { if (wr == 0) PG8_BAR; }
        if constexpr (!Epi::AFTER_DRAIN) { E(acc, cur, wr, wc, fr, fq); S.done(cur); }
        if (!has_next) break;
#pragma unroll
        for (int a = 0; a < 2; ++a)
#pragma unroll
            for (int b = 0; b < 2; ++b)
#pragma unroll
                for (int m = 0; m < 4; ++m)
#pragma unroll
                    for (int n = 0; n < 2; ++n) acc[a][b][m][n] = (f32x4){0.f, 0.f, 0.f, 0.f};
        cur = nxt; cA = nA; cB = nB; ++ui;
        if constexpr (ALIGN_EPI) { if (wr == 1) PG8_BAR; }
    }
    PG8_WAIT_V(0);
    if constexpr (!ALIGN_EPI) { if (wr == 0) PG8_BAR; }
    PG8_BAR;
    if constexpr (Epi::AFTER_DRAIN) { E.fused(acc, cur, wr, wc, fr, fq, lds, wid, lane); S.done(cur); }
#undef PG8_SA
#undef PG8_SB
#undef PG8_STAGE
#undef PG8_LDA
#undef PG8_LDB
#undef PG8_MMA
#undef PG8_WAIT_V
#undef PG8_WAIT_L
#undef PG8_BAR
#undef PG8_SCHED
}
}
#define GAS __attribute__((address_space(1)))
#define LAS __attribute__((address_space(3)))
typedef unsigned short bf16;
typedef unsigned v4u __attribute__((ext_vector_type(4)));
typedef float f32x4 __attribute__((ext_vector_type(4)));
typedef short bf16x8 __attribute__((ext_vector_type(8)));
typedef GAS unsigned gu32;
typedef GAS unsigned long long gu64;
#define RLX_AGENT __ATOMIC_RELAXED, __HIP_MEMORY_SCOPE_AGENT
#define LDS_WAIT() asm volatile("s_waitcnt lgkmcnt(0)" ::: "memory")
#define VM_WAIT() asm volatile("s_waitcnt vmcnt(0)" ::: "memory")
__device__ __forceinline__ unsigned long long rt() { return __builtin_amdgcn_s_memrealtime(); }
__device__ __forceinline__ unsigned f2bf(float f) { unsigned u = __builtin_bit_cast(unsigned, f); return (u + 0x7fffu + ((u >> 16) & 1u)) >> 16; }
__device__ __forceinline__ unsigned pk2(float lo, float hi) { return f2bf(lo) | (f2bf(hi) << 16); }

#define XB_TMO      128
#define XB_XCNT(j)  (256  + 64 * (j))
#define XB_XSUB(j)  (1280 + 64 * (j))
#define XB_XGEN(j)  (2304 + 64 * (j))
#define XB_TOP      3328
#define XB_TOPGEN   3392
#define XCD_BAR_WORDS 3456
#define XB_SPIN_CAP (1u << 18)

__device__ __forceinline__ unsigned xb_ld(unsigned* p)              { return __hip_atomic_load(p, __ATOMIC_RELAXED, __HIP_MEMORY_SCOPE_AGENT); }
__device__ __forceinline__ unsigned xb_add(unsigned* p, unsigned v) { return __hip_atomic_fetch_add(p, v, __ATOMIC_RELAXED, __HIP_MEMORY_SCOPE_AGENT); }
__device__ __forceinline__ unsigned xb_xcc_id() { return (unsigned)__builtin_amdgcn_s_getreg((3 << 11) | 20) & 0xFu; }
#define XB_SPIN(cond, bar) do { unsigned _sp = 0; while (cond) { __builtin_amdgcn_s_sleep(1); \
    if ((++_sp & 255u) == 0u) { if (xb_ld(&(bar)[XB_TMO])) break; if (_sp > XB_SPIN_CAP) { atomicAdd(&(bar)[XB_TMO], 1u); break; } } } } while (0)

struct XcdBarrier {
    unsigned* bar; unsigned x;
    volatile LAS unsigned* st;
};

__device__ __forceinline__ XcdBarrier xcd_barrier_post(unsigned* bar, volatile LAS unsigned* st) {
    XcdBarrier b; b.bar = bar; b.x = xb_xcc_id(); b.st = st;
    if (threadIdx.x == 0) (void)xb_add(&bar[XB_XCNT(b.x)], 1u);
    return b;
}
__device__ __forceinline__ void xcd_barrier_complete(unsigned* bar, unsigned x, unsigned& nloc, unsigned& nx) {
    const unsigned G = gridDim.x * gridDim.y * gridDim.z;
    unsigned sum, cnt, mine, sp = 0u;
    for (;;) {
        sum = 0u; cnt = 0u; mine = 0u;
#pragma unroll
        for (unsigned j = 0; j < 16; ++j) { const unsigned c = xb_ld(&bar[XB_XCNT(j)]); sum += c; cnt += (c > 0u) ? 1u : 0u; mine = (j == x) ? c : mine; }
        if (sum == G) break;
        __builtin_amdgcn_s_sleep(1);
        if ((++sp & 255u) == 0u) { if (xb_ld(&bar[XB_TMO])) break; if (sp > XB_SPIN_CAP) { atomicAdd(&bar[XB_TMO], 1u); break; } }
    }
    nloc = mine > 0u ? mine : 1u; nx = cnt > 0u ? cnt : 1u;
}

__device__ __forceinline__ void xcd_barrier(const XcdBarrier& b) {
    asm volatile("s_waitcnt vmcnt(0)" ::: "memory");
    __syncthreads();
    if (threadIdx.x == 0) {
        unsigned* bar = b.bar;
        __builtin_amdgcn_s_waitcnt(0);
        unsigned nloc = b.st[0], nx = b.st[1];
        if (nloc == 0u) { xcd_barrier_complete(bar, b.x, nloc, nx); b.st[0] = nloc; b.st[1] = nx; }
        const unsigned old = xb_add(&bar[XB_XSUB(b.x)], 1u);
        const unsigned gen = old / nloc;
        if (old + 1u == (gen + 1u) * nloc) {
            __builtin_amdgcn_fence(__ATOMIC_RELEASE, "agent");
            asm volatile("s_waitcnt vmcnt(0)" ::: "memory");
            const unsigned og = xb_add(&bar[XB_TOP], 1u);
            const unsigned tg = og / nx;
            if (og + 1u == (tg + 1u) * nx) xb_add(&bar[XB_TOPGEN], 1u);
            else XB_SPIN(xb_ld(&bar[XB_TOPGEN]) == tg, bar);
            __builtin_amdgcn_fence(__ATOMIC_ACQUIRE, "agent");
            xb_add(&bar[XB_XGEN(b.x)], 1u);
            asm volatile("s_waitcnt vmcnt(0)" ::: "memory");
        } else {
            XB_SPIN(xb_ld(&bar[XB_XGEN(b.x)]) == gen, bar);
            __builtin_amdgcn_fence(__ATOMIC_ACQUIRE, "agent");
            asm volatile("s_waitcnt vmcnt(0)" ::: "memory");
        }
    }
    __syncthreads();
}
#define PG8_SP2 true
#define PG8_ALIGN true

constexpr int NWAVES = 8;
constexpr int BATCH = 4, SEQ = 8192, D = 1024, T = BATCH * SEQ, HD = 64;
constexpr int NIN = 6144;
constexpr int FF = 4096, PLE = 256;
constexpr int ZA_LD = 2304, ZR_LD = 1792, ZG_LD = 2048;
constexpr int RW = 512;
constexpr float NORM_EPS = 1e-6f, GN_EPS = 64e-5f;
#ifndef MK_PER_PHASE
#define MK_PER_PHASE 0
#endif
constexpr int N_PHASES = 16;

constexpr size_t MiB = 1u << 20;
constexpr size_t WS_CTL = 0, CTL_ZERO_BYTES = 1 * MiB;
constexpr size_t WS_CS = 1 * MiB;
constexpr size_t WS_BONUS = 3 * MiB;
constexpr size_t WS_LSE = 4 * MiB;
constexpr size_t WS_WIN = 6 * MiB, WS_WFI = 18 * MiB, WS_WFO = 26 * MiB, WS_WO = 34 * MiB, WS_WPG = 36 * MiB;
constexpr size_t WS_WPLE = 38 * MiB, WS_WAU = 38 * MiB + 512 * 1024, WS_WRU = 39 * MiB;
constexpr size_t WS_XN = 40 * MiB;
constexpr size_t WS_PB = 104 * MiB;
constexpr size_t WS_ZA = 120 * MiB;
constexpr size_t WS_ZR = 264 * MiB;
constexpr size_t WS_ZG = 376 * MiB;
constexpr size_t WS_END = 512 * MiB;
constexpr size_t WS_OA = WS_XN;
constexpr size_t WS_R = WS_ZA, WS_KP = WS_ZA + 32 * MiB, WS_V = WS_ZA + 64 * MiB, WS_AV = WS_ZA + 96 * MiB;
constexpr size_t WS_Y = WS_ZR;
constexpr size_t WS_ORW = WS_ZR + 64 * MiB;
constexpr size_t WS_M1 = WS_ZA;
constexpr size_t WS_TMP2A = 184 * MiB;
constexpr size_t WS_H = WS_ZA;
constexpr size_t WS_TMP2B = WS_ZG;
constexpr size_t WS_E = WS_ZA;
constexpr size_t WS_OG = WS_XN + 16 * MiB;
constexpr size_t DO_DEC = 0;
constexpr size_t DO_BV = 64 * MiB, DO_GT = 96 * MiB;
constexpr int CW_TMO = 0, CW_CODE = 1, CW_BAR = 4096;

constexpr int RING_OFF = 0, RING_BYTES = 131072;
constexpr int LDSCTL_OFF = RING_BYTES, MISC_OFF = LDSCTL_OFF + 320;
constexpr int LDS_BYTES = 147456;

__device__ __forceinline__ float bf2f(bf16 u) { return __builtin_bit_cast(float, (unsigned)u << 16); }
__device__ __forceinline__ float bflo(unsigned u) { return __builtin_bit_cast(float, u << 16); }
__device__ __forceinline__ float bfhi(unsigned u) { return __builtin_bit_cast(float, u & 0xffff0000u); }
__device__ __forceinline__ float sigmoidf_(float x) { return 1.0f / (1.0f + __expf(-x)); }
__device__ __forceinline__ float wave_sum(float v) {
#pragma unroll
    for (int o = 1; o < 64; o <<= 1) v += __shfl_xor(v, o);
    return v;
}

namespace pg8 {
struct EpiInProj {
    static constexpr bool PERM = true, AFTER_DRAIN = false;
    bf16_t *za, *zr, *zg;
    __device__ __forceinline__ void operator()(const f32x4 (&acc)[2][2][4][2], const Unit& u, int wr, int wc, int fr, int fq) const {
        bf16_t* base; int ld, colt; bool sig = false;
        if (u.pn < 9) { base = za; ld = 2304; colt = u.pn * 256; }
        else if (u.pn < 16) { base = zr; ld = 1792; colt = (u.pn - 9) * 256; }
        else { base = zg; ld = 2048; colt = (u.pn - 16) * 256; sig = true; }
        const int row0 = u.pm * BM + wr * 64 + fr, col0 = colt + wc * 32 + 8 * fq;
#pragma unroll
        for (int ai = 0; ai < 2; ++ai)
#pragma unroll
            for (int m = 0; m < 4; ++m) { bf16_t* rowp = base + (size_t)(row0 + ai * HALF + m * 16) * ld + col0;
#pragma unroll
                for (int bj = 0; bj < 2; ++bj) { f32x4 v0 = acc[ai][bj][m][0], v1 = acc[ai][bj][m][1];
                    if (sig) {
#pragma unroll
                        for (int k = 0; k < 4; ++k) { v0[k] = 1.0f / (1.0f + __expf(-v0[k])); v1[k] = 1.0f / (1.0f + __expf(-v1[k])); } }
                    u32x4 w; w.x = cvt_pk_bf16(v0[0], v0[1]); w.y = cvt_pk_bf16(v0[2], v0[3]); w.z = cvt_pk_bf16(v1[0], v1[1]); w.w = cvt_pk_bf16(v1[2], v1[3]);
                    *(u32x4*)(rowp + bj * HALF) = w; } }
    }
};
struct EpiGateF32 {
    static constexpr bool PERM = false, AFTER_DRAIN = false;
    float* out; const bf16_t* gate; int gld, gcol0;
    __device__ __forceinline__ void operator()(const f32x4 (&acc)[2][2][4][2], const Unit& u, int wr, int wc, int fr, int fq) const {
        const int col0 = u.pn * BM + wc * 32 + 4 * fq;
#pragma unroll
        for (int ai = 0; ai < 2; ++ai)
#pragma unroll
            for (int m = 0; m < 4; ++m) { const int r = u.pm * BM + ai * HALF + wr * 64 + m * 16 + fr;
#pragma unroll
                for (int bj = 0; bj < 2; ++bj)
#pragma unroll
                    for (int n = 0; n < 2; ++n) { const int c = col0 + bj * HALF + n * 16;
                        const unsigned long long gq = *(const unsigned long long*)(gate + (size_t)r * gld + gcol0 + c);
                        const unsigned g0 = (unsigned)gq, g1 = (unsigned)(gq >> 32);
                        f32x4 a = acc[ai][bj][m][n];
                        a[0] *= __builtin_bit_cast(float, g0 << 16); a[1] *= __builtin_bit_cast(float, g0 & 0xffff0000u);
                        a[2] *= __builtin_bit_cast(float, g1 << 16); a[3] *= __builtin_bit_cast(float, g1 & 0xffff0000u);
                        *(f32x4*)(out + (size_t)r * 1024 + c) = a; } }
    }
};
struct EpiMerge {
    static constexpr bool PERM = true, AFTER_DRAIN = false;
    const float* tmp; const bf16_t* gate; int gld, gcol0; bf16_t* out;
    __device__ __forceinline__ void operator()(const f32x4 (&acc)[2][2][4][2], const Unit& u, int wr, int wc, int fr, int fq) const {
        const int row0 = u.pm * BM + wr * 64 + fr, col0 = u.pn * BM + wc * 32 + 8 * fq;
#pragma unroll
        for (int ai = 0; ai < 2; ++ai)
#pragma unroll
            for (int m = 0; m < 4; ++m) { const int r = row0 + ai * HALF + m * 16;
#pragma unroll
                for (int bj = 0; bj < 2; ++bj) { const int c = col0 + bj * HALF;
                    const u32x4 gq = *(const u32x4*)(gate + (size_t)r * gld + gcol0 + c);
                    const f32x4 t0 = *(const f32x4*)(tmp + (size_t)r * 1024 + c), t1 = *(const f32x4*)(tmp + (size_t)r * 1024 + c + 4);
                    f32x4 v0 = acc[ai][bj][m][0], v1 = acc[ai][bj][m][1];
                    v0[0] = t0[0] + v0[0] * __builtin_bit_cast(float, gq.x << 16); v0[1] = t0[1] + v0[1] * __builtin_bit_cast(float, gq.x & 0xffff0000u);
                    v0[2] = t0[2] + v0[2] * __builtin_bit_cast(float, gq.y << 16); v0[3] = t0[3] + v0[3] * __builtin_bit_cast(float, gq.y & 0xffff0000u);
                    v1[0] = t1[0] + v1[0] * __builtin_bit_cast(float, gq.z << 16); v1[1] = t1[1] + v1[1] * __builtin_bit_cast(float, gq.z & 0xffff0000u);
                    v1[2] = t1[2] + v1[2] * __builtin_bit_cast(float, gq.w << 16); v1[3] = t1[3] + v1[3] * __builtin_bit_cast(float, gq.w & 0xffff0000u);
                    u32x4 w; w.x = cvt_pk_bf16(v0[0], v0[1]); w.y = cvt_pk_bf16(v0[2], v0[3]); w.z = cvt_pk_bf16(v1[0], v1[1]); w.w = cvt_pk_bf16(v1[2], v1[3]);
                    *(u32x4*)(out + (size_t)r * 1024 + c) = w; } }
    }
};
template <int MODE> struct EpiF32 {
    static constexpr bool PERM = false, AFTER_DRAIN = false;
    float* out;
    __device__ __forceinline__ void operator()(const f32x4 (&acc)[2][2][4][2], const Unit& u, int wr, int wc, int fr, int fq) const {
        const int col0 = u.pn * BM + wc * 32 + 4 * fq;
#pragma unroll
        for (int ai = 0; ai < 2; ++ai)
#pragma unroll
            for (int m = 0; m < 4; ++m) { const int r = u.pm * BM + ai * HALF + wr * 64 + m * 16 + fr;
#pragma unroll
                for (int bj = 0; bj < 2; ++bj)
#pragma unroll
                    for (int n = 0; n < 2; ++n) { float* p = out + (size_t)r * 1024 + col0 + bj * HALF + n * 16; f32x4 a = acc[ai][bj][m][n];
                        if (MODE == 1) { const f32x4 e = *(const f32x4*)p;
#pragma unroll
                            for (int k = 0; k < 4; ++k) a[k] = e[k] / (1.0f + __expf(-a[k])); }
                        *(f32x4*)p = a; } }
    }
};
struct EpiRelu2 {
    static constexpr bool PERM = true, AFTER_DRAIN = false;
    bf16_t* out;
    __device__ __forceinline__ void operator()(const f32x4 (&acc)[2][2][4][2], const Unit& u, int wr, int wc, int fr, int fq) const {
        const int row0 = u.pm * BM + wr * 64 + fr, col0 = u.pn * BM + wc * 32 + 8 * fq;
#pragma unroll
        for (int ai = 0; ai < 2; ++ai)
#pragma unroll
            for (int m = 0; m < 4; ++m) { bf16_t* rowp = out + (size_t)(row0 + ai * HALF + m * 16) * 4096 + col0;
#pragma unroll
                for (int bj = 0; bj < 2; ++bj) { f32x4 v0 = acc[ai][bj][m][0], v1 = acc[ai][bj][m][1];
#pragma unroll
                    for (int k = 0; k < 4; ++k) { const float a = fmaxf(v0[k], 0.f), b = fmaxf(v1[k], 0.f); v0[k] = a * a; v1[k] = b * b; }
                    u32x4 w; w.x = cvt_pk_bf16(v0[0], v0[1]); w.y = cvt_pk_bf16(v0[2], v0[3]); w.z = cvt_pk_bf16(v1[0], v1[1]); w.w = cvt_pk_bf16(v1[2], v1[3]);
                    *(u32x4*)(rowp + bj * HALF) = w; } }
    }
};
}

__device__ __forceinline__ void p0_transpose_item(const float* W, int K, int N, bf16* WT, int row_off, LAS float* scr, int item, int lane) {
    const int nblk = N / 32, kb = item / nblk, nb = item % nblk, k0 = 64 * kb, n0 = 32 * nb;
#pragma unroll 8
    for (int i = 0; i < 32; ++i) { const int kk = 2 * i + (lane >> 5); scr[kk * 33 + (lane & 31)] = W[(size_t)(k0 + kk) * N + n0 + (lane & 31)]; }
    LDS_WAIT(); asm volatile("" ::: "memory");
    const int c = lane & 7;
#pragma unroll
    for (int j = 0; j < 4; ++j) { const int n = (lane >> 3) + 8 * j; const LAS float* s = scr + (8 * c) * 33 + n;
        v4u o; o.x = pk2(s[0 * 33], s[1 * 33]); o.y = pk2(s[2 * 33], s[3 * 33]); o.z = pk2(s[4 * 33], s[5 * 33]); o.w = pk2(s[6 * 33], s[7 * 33]);
        *(GAS v4u*)(WT + (size_t)(row_off + n0 + n) * K + k0 + 8 * c) = o; }
    LDS_WAIT(); asm volatile("" ::: "memory");
}
__device__ __forceinline__ void rms_row_to_bf16(const float* xrow, const float* g, bf16* orow, int lane) {
    const GAS f32x4* xr = (const GAS f32x4*)xrow + lane; const GAS f32x4* gr = (const GAS f32x4*)g + lane;
    f32x4 v[4]; float s = 0.f;
#pragma unroll
    for (int j = 0; j < 4; ++j) { v[j] = xr[64 * j]; s += (v[j].x * v[j].x + v[j].y * v[j].y) + (v[j].z * v[j].z + v[j].w * v[j].w); }
    const float rs = 1.f / sqrtf(wave_sum(s) * (1.f / D) + NORM_EPS);
    GAS unsigned long long* o8 = (GAS unsigned long long*)orow + lane;
#pragma unroll
    for (int j = 0; j < 4; ++j) { const f32x4 gg = gr[64 * j];
        o8[64 * j] = (unsigned long long)pk2(v[j].x * rs * gg.x, v[j].y * rs * gg.y) | ((unsigned long long)pk2(v[j].z * rs * gg.z, v[j].w * rs * gg.w) << 32); }
}

struct Args { const float* in[26]; float* out; unsigned char* ws; int ph_lo, ph_hi, li, pad; };

__global__ void __launch_bounds__(NWAVES * 64, 2) skel_fwd(Args args) {
    extern __shared__ __attribute__((aligned(16))) unsigned char lds_raw[];
    LAS unsigned char* const lds = (LAS unsigned char*)lds_raw;
    volatile LAS unsigned* const MISC = (volatile LAS unsigned*)(lds + MISC_OFF);
    const int tid = threadIdx.x, lane = tid & 63, wave = __builtin_amdgcn_readfirstlane(tid >> 6);
    const int G = gridDim.x; int vcu; { const int bx = blockIdx.x; vcu = (G % 8 == 0) ? (bx % 8) * (G / 8) + bx / 8 : bx; }
    unsigned char* const ws = args.ws;
    gu32* const ctl = (gu32*)(ws + WS_CTL);
    for (int u = tid; u < (LDS_BYTES - LDSCTL_OFF) / 4; u += NWAVES * 64) ((LAS unsigned*)(lds + LDSCTL_OFF))[u] = 0u;
    __syncthreads();
    XcdBarrier bar; bar.bar = (unsigned*)(ctl + CW_BAR); bar.x = 0; bar.st = nullptr;
    if (!MK_PER_PHASE) bar = xcd_barrier_post((unsigned*)(ctl + CW_BAR), MISC + 8);
#define GRID_BAR() do { if (MK_PER_PHASE) { if (tid == 0) __hip_atomic_store(ctl + CW_TMO, 0xBADBA0u, RLX_AGENT); } else { xcd_barrier(bar); } } while (0)
    const int lo = args.ph_lo, hi = args.ph_hi;
#ifndef PH_MASK
#define PH_MASK 0xFFFFFFFFu
#endif
#define IN(k) (((PH_MASK >> (k)) & 1u) && lo <= (k) && (k) < hi)
#define BOTH(k) (IN(k) && IN((k) + 1))
    const int gw = vcu * NWAVES + wave, NGW = G * NWAVES;
    const int gt = vcu * (NWAVES * 64) + tid, NGT = G * NWAVES * 64;

    const float* const x = args.in[0]; const float* const pin = args.in[1];
    float* const out = args.out;
    bf16* const WinT = (bf16*)(ws + WS_WIN); bf16* const WfiT = (bf16*)(ws + WS_WFI); bf16* const WfoT = (bf16*)(ws + WS_WFO);
    bf16* const WoT = (bf16*)(ws + WS_WO); bf16* const WpgT = (bf16*)(ws + WS_WPG); bf16* const WpleT = (bf16*)(ws + WS_WPLE);
    bf16* const WauT = (bf16*)(ws + WS_WAU); bf16* const WruT = (bf16*)(ws + WS_WRU);
    bf16* const XN = (bf16*)(ws + WS_XN); bf16* const PB = (bf16*)(ws + WS_PB);
    bf16* const ZA = (bf16*)(ws + WS_ZA); bf16* const ZR = (bf16*)(ws + WS_ZR); bf16* const ZG = (bf16*)(ws + WS_ZG);
    float2* const CS = (float2*)(ws + WS_CS);

    if (IN(0)) {
        LAS float* scr = (LAS float*)(lds + RING_OFF + wave * 16384);
        constexpr int I_IN = (D / 64) * (6048 / 32), I_FI = (D / 64) * (FF / 32), I_FO = (FF / 64) * (D / 32), I_O = (D / 64) * (D / 32), I_PG = I_O;
        constexpr int I_PLE = (PLE / 64) * (D / 32), I_AU = (256 / 64) * (D / 32), I_RU = (512 / 64) * (D / 32);
        constexpr int NITEMS = I_IN + I_FI + I_FO + I_O + I_PG + I_PLE + I_AU + I_RU;
        for (int it = gw; it < NITEMS; it += NGW) {
            int r = it;
            if (r < I_IN) { const int nb = r % (6048 / 32); p0_transpose_item(args.in[3], D, 6048, WinT, (nb * 32 >= 4000) ? 96 : 0, scr, r, lane); continue; } r -= I_IN;
            if (r < I_FI) { p0_transpose_item(args.in[20], D, FF, WfiT, 0, scr, r, lane); continue; } r -= I_FI;
            if (r < I_FO) { p0_transpose_item(args.in[21], FF, D, WfoT, 0, scr, r, lane); continue; } r -= I_FO;
            if (r < I_O) { p0_transpose_item(args.in[17], D, D, WoT, 0, scr, r, lane); continue; } r -= I_O;
            if (r < I_PG) { p0_transpose_item(args.in[24], D, D, WpgT, 0, scr, r, lane); continue; } r -= I_PG;
            if (r < I_PLE) { p0_transpose_item(args.in[23], PLE, D, WpleT, 0, scr, r, lane); continue; } r -= I_PLE;
            if (r < I_AU) { p0_transpose_item(args.in[15], 256, D, WauT, 0, scr, r, lane); continue; } r -= I_AU;
            p0_transpose_item(args.in[16], 512, D, WruT, 0, scr, r, lane);
        }
        for (int i = gt; i < 96 * 1024 / 8; i += NGT) ((GAS v4u*)(WinT + (size_t)4000 * 1024))[i] = (v4u){0u, 0u, 0u, 0u};
        for (int m = gw; m < T; m += NGW) rms_row_to_bf16(x + (size_t)m * D, args.in[2], XN + (size_t)m * D, lane);
        for (int m = gw; m < T; m += NGW) { const f32x4 v = ((const GAS f32x4*)(pin + (size_t)m * PLE))[lane];
            ((GAS unsigned long long*)(PB + (size_t)m * PLE))[lane] = (unsigned long long)pk2(v.x, v.y) | ((unsigned long long)pk2(v.z, v.w) << 32); }
        for (int i = gt; i < SEQ * 32; i += NGT) { const int pos = i >> 5, fi = i & 31;
            const float inv = (float)exp(-(double)fi * (1.0 / 32.0) * 9.210340371976184);
            const float ang = (float)pos * inv;
            const double a = (double)ang; const double kq = rint(a * 0.15915494309189535); const double rr = a - kq * 6.283185307179586;
            const float rf = (float)rr; CS[i] = make_float2(cosf(rf), sinf(rf)); }
        if (BOTH(0)) GRID_BAR();
    }

    if (IN(1)) {
        pg8::Gemm g{XN, WinT, T, NIN, D}; pg8::StaticOrder S; S.init(T, NIN, G, (int)blockIdx.x);
        pg8::EpiInProj E{ZA, ZR, ZG};
        pg8::gemm_phase<pg8::EpiInProj, pg8::StaticOrder, PG8_ALIGN, PG8_SP2>(lds + RING_OFF, g, S, E);
        if (BOTH(1)) GRID_BAR();
    }

    if (IN(2)) {
        bf16* const OG = (bf16*)(ws + WS_OG); float* const LSE = (float*)(ws + WS_LSE);
        LAS float* Ks = (LAS float*)(lds + RING_OFF); LAS float* Vs = Ks + 192 * 68;
        const int qi = tid >> 3, part = tid & 7;
        for (int unit = vcu; unit < BATCH * 3 * 4 * 128; unit += G) {
            const int tau = unit & 127, h = (unit >> 7) & 3, g = (unit >> 9) % 3, b = unit / (128 * 4 * 3);
            const int dl = (g == 0) ? 1 : (g == 1) ? 4 : 16;
            const int rho = tau % dl, it = tau / dl, i0 = it * 64;
            const int colq = g * 256 + h * 64, colk = 768 + colq, colv = 1536 + colq;
            for (int idx = tid; idx < 192 * 32; idx += 512) {
                const int lr = idx >> 5, dd = idx & 31, ik = i0 - 128 + lr;
                float k1 = 0.f, k2 = 0.f, v1 = 0.f, v2 = 0.f;
                if (ik >= 0) { const int t = ik * dl + rho; const bf16* row = ZA + (size_t)(b * SEQ + t) * ZA_LD;
                    const float x1 = bf2f(row[colk + dd]), x2 = bf2f(row[colk + dd + 32]); const float2 cs = CS[t * 32 + dd];
                    k1 = x1 * cs.x - x2 * cs.y; k2 = x2 * cs.x + x1 * cs.y; v1 = bf2f(row[colv + dd]); v2 = bf2f(row[colv + dd + 32]); }
                Ks[lr * 68 + dd] = k1; Ks[lr * 68 + dd + 32] = k2; Vs[lr * 68 + dd] = v1; Vs[lr * 68 + dd + 32] = v2;
            }
            const int tq = (i0 + qi) * dl + rho; const bf16* qrow = ZA + (size_t)(b * SEQ + tq) * ZA_LD + colq;
            float q[64];
#pragma unroll
            for (int dd = 0; dd < 32; ++dd) { const float x1 = bf2f(qrow[dd]), x2 = bf2f(qrow[dd + 32]); const float2 cs = CS[tq * 32 + dd];
                q[dd] = (x1 * cs.x - x2 * cs.y) * 0.125f; q[dd + 32] = (x2 * cs.x + x1 * cs.y) * 0.125f; }
            __syncthreads();
            float m = -INFINITY, l = 0.f; float o[64];
#pragma unroll
            for (int c = 0; c < 64; ++c) o[c] = 0.f;
#pragma unroll 1
            for (int jj = 0; jj < 17; ++jj) { const int off = part + 8 * jj; const int lr = qi + off; const bool valid = (off <= 128) && (i0 - 128 + lr >= 0);
                if (!valid) continue;
                const LAS f32x4* kr = (const LAS f32x4*)(Ks + lr * 68); float d0 = 0.f;
#pragma unroll
                for (int c = 0; c < 16; ++c) { const f32x4 kv = kr[c]; d0 += q[4 * c] * kv.x + q[4 * c + 1] * kv.y + q[4 * c + 2] * kv.z + q[4 * c + 3] * kv.w; }
                const float mn = fmaxf(m, d0); const float sc = __expf(m - mn), pj = __expf(d0 - mn); m = mn; l = l * sc + pj;
                const LAS f32x4* vr = (const LAS f32x4*)(Vs + lr * 68);
#pragma unroll
                for (int c = 0; c < 16; ++c) { const f32x4 vv = vr[c]; o[4 * c] = o[4 * c] * sc + pj * vv.x; o[4 * c + 1] = o[4 * c + 1] * sc + pj * vv.y; o[4 * c + 2] = o[4 * c + 2] * sc + pj * vv.z; o[4 * c + 3] = o[4 * c + 3] * sc + pj * vv.w; } }
            { float mm = fmaxf(m, __shfl_xor(m, 1)); mm = fmaxf(mm, __shfl_xor(mm, 2)); mm = fmaxf(mm, __shfl_xor(mm, 4));
              const float sc = __expf(m - mm); m = mm; l *= sc;
#pragma unroll
              for (int c = 0; c < 64; ++c) o[c] *= sc; }
            l += __shfl_xor(l, 1); l += __shfl_xor(l, 2); l += __shfl_xor(l, 4);
            float o32[32], o16[16], o8[8];
            { const bool up = (part & 4) != 0;
#pragma unroll
              for (int c = 0; c < 32; ++c) { const float send = up ? o[c] : o[c + 32]; const float recv = __shfl_xor(send, 4); o32[c] = (up ? o[c + 32] : o[c]) + recv; } }
            { const bool up = (part & 2) != 0;
#pragma unroll
              for (int c = 0; c < 16; ++c) { const float send = up ? o32[c] : o32[c + 16]; const float recv = __shfl_xor(send, 2); o16[c] = (up ? o32[c + 16] : o32[c]) + recv; } }
            { const bool up = (part & 1) != 0;
#pragma unroll
              for (int c = 0; c < 8; ++c) { const float send = up ? o16[c] : o16[c + 8]; const float recv = __shfl_xor(send, 1); o8[c] = (up ? o16[c + 8] : o16[c]) + recv; } }
            const float il = 1.0f / l; const size_t trow = (size_t)(b * SEQ + tq);
            v4u w; w.x = pk2(o8[0] * il, o8[1] * il); w.y = pk2(o8[2] * il, o8[3] * il); w.z = pk2(o8[4] * il, o8[5] * il); w.w = pk2(o8[6] * il, o8[7] * il);
            *(GAS v4u*)(OG + ((size_t)g * T + trow) * 256 + h * 64 + 8 * part) = w;
            if (part == 0) LSE[((size_t)g * T + trow) * 4 + h] = m + __logf(l);
            __syncthreads();
        }
        if (BOTH(2)) GRID_BAR();
    }

    if (IN(3)) {
        {
            const bf16* const OG = (const bf16*)(ws + WS_OG); const float* const LSE = (const float*)(ws + WS_LSE); bf16* const OA = (bf16*)(ws + WS_OA);
            for (int i = gt; i < T * 32; i += NGT) { const int t = i >> 5, h = (i >> 3) & 3, c8 = i & 7;
                const float l0 = LSE[((size_t)0 * T + t) * 4 + h], l1 = LSE[((size_t)1 * T + t) * 4 + h], l2 = LSE[((size_t)2 * T + t) * 4 + h];
                const float mx = fmaxf(l0, fmaxf(l1, l2)); const float e0 = __expf(l0 - mx), e1 = __expf(l1 - mx), e2 = __expf(l2 - mx); const float inv = 1.0f / (e0 + e1 + e2);
                const float a0 = e0 * inv, a1 = e1 * inv, a2 = e2 * inv;
                const v4u x0 = *(const GAS v4u*)(OG + ((size_t)0 * T + t) * 256 + h * 64 + 8 * c8), x1 = *(const GAS v4u*)(OG + ((size_t)1 * T + t) * 256 + h * 64 + 8 * c8), x2 = *(const GAS v4u*)(OG + ((size_t)2 * T + t) * 256 + h * 64 + 8 * c8);
                v4u w;
                w.x = pk2(a0 * bflo(x0.x) + a1 * bflo(x1.x) + a2 * bflo(x2.x), a0 * bfhi(x0.x) + a1 * bfhi(x1.x) + a2 * bfhi(x2.x));
                w.y = pk2(a0 * bflo(x0.y) + a1 * bflo(x1.y) + a2 * bflo(x2.y), a0 * bfhi(x0.y) + a1 * bfhi(x1.y) + a2 * bfhi(x2.y));
                w.z = pk2(a0 * bflo(x0.z) + a1 * bflo(x1.z) + a2 * bflo(x2.z), a0 * bfhi(x0.z) + a1 * bfhi(x1.z) + a2 * bfhi(x2.z));
                w.w = pk2(a0 * bflo(x0.w) + a1 * bflo(x1.w) + a2 * bflo(x2.w), a0 * bfhi(x0.w) + a1 * bfhi(x1.w) + a2 * bfhi(x2.w));
                *(GAS v4u*)(OA + (size_t)t * 256 + h * 64 + 8 * c8) = w; }
        }
        {
            const float* const mu = args.in[4]; const float* const w0 = args.in[5]; const float* const w2 = args.in[6]; const float* const a0 = args.in[7];
            const float* const a2 = args.in[8]; const float* const g2 = args.in[9]; const float* const k_k = args.in[10]; const float* const k_a = args.in[11]; const float* const r_k = args.in[12];
            bf16* const Rb = (bf16*)(ws + WS_R); bf16* const Kb = (bf16*)(ws + WS_KP); bf16* const Vb = (bf16*)(ws + WS_V); bf16* const AVb = (bf16*)(ws + WS_AV);
            float* const DEC = (float*)((unsigned char*)out + DO_DEC); bf16* const BVb = (bf16*)((unsigned char*)out + DO_BV); bf16* const GTb = (bf16*)((unsigned char*)out + DO_GT);
            float* const BONUS = (float*)(ws + WS_BONUS);
            const int c = tid;
            float w2c[32], a2c[32]; unsigned g2c[48];
#pragma unroll
            for (int j = 0; j < 32; ++j) { w2c[j] = w2[j * RW + c]; a2c[j] = a2[j * RW + c]; }
#pragma unroll
            for (int j = 0; j < 48; ++j) g2c[j] = pk2(g2[(2 * j) * RW + c], g2[(2 * j + 1) * RW + c]);
            const float mu_r = mu[c], mu_k = mu[512 + c], mu_v = mu[1024 + c], w0c = w0[c], a0c = a0[c], kkc = k_k[c], kac = k_a[c], rkc = r_k[c];
            LAS float* L = (LAS float*)(lds + RING_OFF);
            for (int tile = vcu; tile < T / 16; tile += G) {
                const int t0 = tile * 16;
                for (int idx = tid; idx < 16 * 160; idx += 512) { const int tok = idx / 160, j = idx - tok * 160, t = t0 + tok;
                    const float z = bf2f(ZR[(size_t)t * ZR_LD + 1536 + j]); const float zp = ((t & (SEQ - 1)) == 0) ? 0.f : bf2f(ZR[(size_t)(t - 1) * ZR_LD + 1536 + j]);
                    const float xx = z + (zp - z) * mu[1536 + j];
                    L[idx] = (j < 32) ? tanhf(xx) : (j < 64) ? xx : sigmoidf_(xx); }
                __syncthreads();
                float pr = 0.f, pk = 0.f, pv = 0.f;
                if ((t0 & (SEQ - 1)) != 0) { const bf16* zp = ZR + (size_t)(t0 - 1) * ZR_LD; pr = bf2f(zp[c]); pk = bf2f(zp[512 + c]); pv = bf2f(zp[1024 + c]); }
                for (int tok = 0; tok < 16; ++tok) { const int t = t0 + tok; const bf16* zc = ZR + (size_t)t * ZR_LD;
                    const float zr = bf2f(zc[c]), zk = bf2f(zc[512 + c]), zv = bf2f(zc[1024 + c]);
                    const float r = zr + (pr - zr) * mu_r; float k = zk + (pk - zk) * mu_k; const float v = zv + (pv - zv) * mu_v; pr = zr; pk = zk; pv = zv;
                    const LAS f32x4* Lt = (const LAS f32x4*)(L + tok * 160);
                    float wl = 0.f, al = 0.f, gl = 0.f;
#pragma unroll
                    for (int j = 0; j < 8; ++j) { const f32x4 a = Lt[j]; wl += a.x * w2c[4 * j] + a.y * w2c[4 * j + 1] + a.z * w2c[4 * j + 2] + a.w * w2c[4 * j + 3]; }
#pragma unroll
                    for (int j = 0; j < 8; ++j) { const f32x4 a = Lt[8 + j]; al += a.x * a2c[4 * j] + a.y * a2c[4 * j + 1] + a.z * a2c[4 * j + 2] + a.w * a2c[4 * j + 3]; }
#pragma unroll
                    for (int j = 0; j < 24; ++j) { const f32x4 a = Lt[16 + j]; gl += a.x * bflo(g2c[2 * j]) + a.y * bfhi(g2c[2 * j]) + a.z * bflo(g2c[2 * j + 1]) + a.w * bfhi(g2c[2 * j + 1]); }
                    const float wv = w0c + wl; const float nx = -wv;
                    const float sp = fmaxf(nx, 0.f) + log1pf(__expf(-fabsf(nx)));
                    const float dec = __expf(-__expf(-sp - 0.5f));
                    const float a = sigmoidf_(a0c + al);
                    float kk = k * kkc; const float ss = wave_sum(kk * kk); kk = kk / fmaxf(sqrtf(ss), 1e-12f);
                    k = k * (1.0f + (a - 1.0f) * kac);
                    const float bon = wave_sum(r * k * rkc);
                    const size_t o = (size_t)t * RW + c;
                    Rb[o] = (bf16)f2bf(r); Kb[o] = (bf16)f2bf(k); Vb[o] = (bf16)f2bf(v); AVb[o] = (bf16)f2bf(-kk); BVb[o] = (bf16)f2bf(kk * a); GTb[o] = (bf16)f2bf(gl); DEC[o] = dec;
                    if (lane == 0) BONUS[(size_t)t * 8 + wave] = bon;
                }
                __syncthreads();
            }
        }
        if (BOTH(3)) GRID_BAR();
    }

    if (IN(4)) {
        if (vcu < BATCH * 8) {
            const bf16* const Rb = (const bf16*)(ws + WS_R); const bf16* const Kb = (const bf16*)(ws + WS_KP); const bf16* const Vb = (const bf16*)(ws + WS_V); const bf16* const AVb = (const bf16*)(ws + WS_AV);
            const float* const DEC = (const float*)((unsigned char*)out + DO_DEC); const bf16* const BVb = (const bf16*)((unsigned char*)out + DO_BV);
            float* const Y = (float*)(ws + WS_Y);
            const int b = vcu >> 3, h = vcu & 7;
            LAS float* buf = (LAS float*)(lds + RING_OFF);
            LAS float* Ys = buf + 2 * 12288;
            const int v = tid >> 3, kq = tid & 7;
            float S[8];
#pragma unroll
            for (int i = 0; i < 8; ++i) S[i] = 0.f;
            float pre[6][4];
            const size_t base = (size_t)b * SEQ * RW + h * 64;
#define SCAN_LOAD(ck) do { _Pragma("unroll") for (int i = 0; i < 4; ++i) { const int e = tid + 512 * i; const size_t o = base + (size_t)((ck) * 32 + (e >> 6)) * RW + (e & 63); \
        pre[0][i] = bf2f(Rb[o]); pre[1][i] = DEC[o]; pre[2][i] = bf2f(Kb[o]); pre[3][i] = bf2f(Vb[o]); pre[4][i] = bf2f(AVb[o]); pre[5][i] = bf2f(BVb[o]); } } while (0)
#define SCAN_STORE(bi) do { _Pragma("unroll") for (int a = 0; a < 6; ++a) _Pragma("unroll") for (int i = 0; i < 4; ++i) buf[(bi) * 12288 + a * 2048 + tid + 512 * i] = pre[a][i]; } while (0)
            SCAN_LOAD(0); SCAN_STORE(0); __syncthreads();
            for (int ck = 0; ck < SEQ / 32; ++ck) {
                if (ck + 1 < SEQ / 32) SCAN_LOAD(ck + 1);
                const LAS float* bb = buf + (ck & 1) * 12288;
                for (int tok = 0; tok < 32; ++tok) {
                    const LAS float* p = bb + tok * 64 + kq * 8;
                    const f32x4 r0 = *(const LAS f32x4*)(p), r1 = *(const LAS f32x4*)(p + 4);
                    const f32x4 w0v = *(const LAS f32x4*)(p + 2048), w1v = *(const LAS f32x4*)(p + 2048 + 4);
                    const f32x4 k0 = *(const LAS f32x4*)(p + 4096), k1 = *(const LAS f32x4*)(p + 4096 + 4);
                    const float vv = bb[3 * 2048 + tok * 64 + v];
                    const f32x4 a0v = *(const LAS f32x4*)(p + 8192), a1v = *(const LAS f32x4*)(p + 8192 + 4);
                    const f32x4 b0 = *(const LAS f32x4*)(p + 10240), b1 = *(const LAS f32x4*)(p + 10240 + 4);
                    float sa = S[0] * a0v.x + S[1] * a0v.y + S[2] * a0v.z + S[3] * a0v.w + S[4] * a1v.x + S[5] * a1v.y + S[6] * a1v.z + S[7] * a1v.w;
                    sa += __shfl_xor(sa, 1); sa += __shfl_xor(sa, 2); sa += __shfl_xor(sa, 4);
                    S[0] = S[0] * w0v.x + sa * b0.x + vv * k0.x; S[1] = S[1] * w0v.y + sa * b0.y + vv * k0.y; S[2] = S[2] * w0v.z + sa * b0.z + vv * k0.z; S[3] = S[3] * w0v.w + sa * b0.w + vv * k0.w;
                    S[4] = S[4] * w1v.x + sa * b1.x + vv * k1.x; S[5] = S[5] * w1v.y + sa * b1.y + vv * k1.y; S[6] = S[6] * w1v.z + sa * b1.z + vv * k1.z; S[7] = S[7] * w1v.w + sa * b1.w + vv * k1.w;
                    float y = S[0] * r0.x + S[1] * r0.y + S[2] * r0.z + S[3] * r0.w + S[4] * r1.x + S[5] * r1.y + S[6] * r1.z + S[7] * r1.w;
                    y += __shfl_xor(y, 1); y += __shfl_xor(y, 2); y += __shfl_xor(y, 4);
                    if (kq == 0) Ys[tok * 64 + v] = y;
                }
                __syncthreads();
#pragma unroll
                for (int i = 0; i < 4; ++i) { const int e = tid + 512 * i; Y[base + (size_t)(ck * 32 + (e >> 6)) * RW + (e & 63)] = Ys[e]; }
                if (ck + 1 < SEQ / 32) SCAN_STORE((ck + 1) & 1);
                __syncthreads();
            }
#undef SCAN_LOAD
#undef SCAN_STORE
        }
        if (BOTH(4)) GRID_BAR();
    }

    if (IN(5)) {
        const float* const Y = (const float*)(ws + WS_Y); const bf16* const Vb = (const bf16*)(ws + WS_V); const bf16* const GTb = (const bf16*)((unsigned char*)out + DO_GT);
        const float* const BONUS = (const float*)(ws + WS_BONUS); bf16* const ORW = (bf16*)(ws + WS_ORW);
        const float lnw = args.in[13][tid], lnb = args.in[14][tid];
        for (int t = vcu; t < T; t += G) { const size_t o = (size_t)t * RW + tid;
            const float y = Y[o]; const float mean = wave_sum(y) * (1.f / 64.f); const float dy = y - mean; const float var = wave_sum(dy * dy) * (1.f / 64.f);
            const float yn = dy * (1.f / sqrtf(var + GN_EPS)) * lnw + lnb;
            const float res = (yn + BONUS[(size_t)t * 8 + wave] * bf2f(Vb[o])) * bf2f(GTb[o]);
            ORW[o] = (bf16)f2bf(res); }
        if (BOTH(5)) GRID_BAR();
    }

    if (IN(6)) {
        pg8::Gemm g{(const bf16*)(ws + WS_OA), WauT, T, D, 256}; pg8::StaticOrder S; S.init(T, D, G, (int)blockIdx.x);
        pg8::EpiGateF32 E{out, ZG, ZG_LD, 0};
        pg8::gemm_phase<pg8::EpiGateF32, pg8::StaticOrder, PG8_ALIGN, PG8_SP2>(lds + RING_OFF, g, S, E);
        if (BOTH(6)) GRID_BAR();
    }
    if (IN(7)) {
        pg8::Gemm g{(const bf16*)(ws + WS_ORW), WruT, T, D, 512}; pg8::StaticOrder S; S.init(T, D, G, (int)blockIdx.x);
        pg8::EpiMerge E{out, ZG, ZG_LD, 1024, (bf16*)(ws + WS_M1)};
        pg8::gemm_phase<pg8::EpiMerge, pg8::StaticOrder, PG8_ALIGN, PG8_SP2>(lds + RING_OFF, g, S, E);
        if (BOTH(7)) GRID_BAR();
    }
    if (IN(8)) {
        pg8::Gemm g{(const bf16*)(ws + WS_M1), WoT, T, D, D}; pg8::StaticOrder S; S.init(T, D, G, (int)blockIdx.x);
        pg8::EpiF32<0> E{(float*)(ws + WS_TMP2A)};
        pg8::gemm_phase<pg8::EpiF32<0>, pg8::StaticOrder, PG8_ALIGN, PG8_SP2>(lds + RING_OFF, g, S, E);
        if (BOTH(8)) GRID_BAR();
    }
    if (IN(9)) {
        const float* const tmp = (const float*)(ws + WS_TMP2A); const float* const g1 = args.in[18]; const float* const g2 = args.in[19];
        for (int m = gw; m < T; m += NGW) {
            const GAS f32x4* tr = (const GAS f32x4*)(tmp + (size_t)m * D) + lane; const GAS f32x4* xr = (const GAS f32x4*)(x + (size_t)m * D) + lane;
            f32x4 v[4]; float s = 0.f;
#pragma unroll
            for (int j = 0; j < 4; ++j) { v[j] = tr[64 * j]; s += (v[j].x * v[j].x + v[j].y * v[j].y) + (v[j].z * v[j].z + v[j].w * v[j].w); }
            const float rs = 1.f / sqrtf(wave_sum(s) * (1.f / D) + NORM_EPS); float s2 = 0.f;
#pragma unroll
            for (int j = 0; j < 4; ++j) { const f32x4 gg = ((const GAS f32x4*)g1)[lane + 64 * j]; const f32x4 xx = xr[64 * j];
                v[j].x = xx.x + v[j].x * rs * gg.x; v[j].y = xx.y + v[j].y * rs * gg.y; v[j].z = xx.z + v[j].z * rs * gg.z; v[j].w = xx.w + v[j].w * rs * gg.w;
                ((GAS f32x4*)(out + (size_t)m * D))[lane + 64 * j] = v[j];
                s2 += (v[j].x * v[j].x + v[j].y * v[j].y) + (v[j].z * v[j].z + v[j].w * v[j].w); }
            const float rs2 = 1.f / sqrtf(wave_sum(s2) * (1.f / D) + NORM_EPS);
            GAS unsigned long long* o8 = (GAS unsigned long long*)(XN + (size_t)m * D) + lane;
#pragma unroll
            for (int j = 0; j < 4; ++j) { const f32x4 gg = ((const GAS f32x4*)g2)[lane + 64 * j];
                o8[64 * j] = (unsigned long long)pk2(v[j].x * rs2 * gg.x, v[j].y * rs2 * gg.y) | ((unsigned long long)pk2(v[j].z * rs2 * gg.z, v[j].w * rs2 * gg.w) << 32); }
        }
        if (BOTH(9)) GRID_BAR();
    }
    if (IN(10)) {
        pg8::Gemm g{XN, WfiT, T, FF, D}; pg8::StaticOrder S; S.init(T, FF, G, (int)blockIdx.x);
        pg8::EpiRelu2 E{(bf16*)(ws + WS_H)};
        pg8::gemm_phase<pg8::EpiRelu2, pg8::StaticOrder, PG8_ALIGN, PG8_SP2>(lds + RING_OFF, g, S, E);
        if (BOTH(10)) GRID_BAR();
    }
    if (IN(11)) {
        pg8::Gemm g{(const bf16*)(ws + WS_H), WfoT, T, D, FF}; pg8::StaticOrder S; S.init(T, D, G, (int)blockIdx.x);
        pg8::EpiF32<0> E{(float*)(ws + WS_TMP2B)};
        pg8::gemm_phase<pg8::EpiF32<0>, pg8::StaticOrder, PG8_ALIGN, PG8_SP2>(lds + RING_OFF, g, S, E);
        if (BOTH(11)) GRID_BAR();
    }
    if (IN(12)) {
        const float* const tmp = (const float*)(ws + WS_TMP2B); const float* const g1 = args.in[22];
        for (int m = gw; m < T; m += NGW) {
            const GAS f32x4* tr = (const GAS f32x4*)(tmp + (size_t)m * D) + lane; GAS f32x4* hr = (GAS f32x4*)(out + (size_t)m * D) + lane;
            f32x4 v[4]; float s = 0.f;
#pragma unroll
            for (int j = 0; j < 4; ++j) { v[j] = tr[64 * j]; s += (v[j].x * v[j].x + v[j].y * v[j].y) + (v[j].z * v[j].z + v[j].w * v[j].w); }
            const float rs = 1.f / sqrtf(wave_sum(s) * (1.f / D) + NORM_EPS);
            GAS unsigned long long* o8 = (GAS unsigned long long*)(XN + (size_t)m * D) + lane;
#pragma unroll
            for (int j = 0; j < 4; ++j) { const f32x4 gg = ((const GAS f32x4*)g1)[lane + 64 * j]; const f32x4 hh = hr[64 * j];
                v[j].x = hh.x + v[j].x * rs * gg.x; v[j].y = hh.y + v[j].y * rs * gg.y; v[j].z = hh.z + v[j].z * rs * gg.z; v[j].w = hh.w + v[j].w * rs * gg.w;
                hr[64 * j] = v[j];
                o8[64 * j] = (unsigned long long)pk2(v[j].x, v[j].y) | ((unsigned long long)pk2(v[j].z, v[j].w) << 32); }
        }
        if (BOTH(12)) GRID_BAR();
    }
    if (IN(13)) {
        pg8::Gemm g{PB, WpleT, T, D, PLE}; pg8::StaticOrder S; S.init(T, D, G, (int)blockIdx.x);
        pg8::EpiF32<0> E{(float*)(ws + WS_E)};
        pg8::gemm_phase<pg8::EpiF32<0>, pg8::StaticOrder, PG8_ALIGN, PG8_SP2>(lds + RING_OFF, g, S, E);
        if (BOTH(13)) GRID_BAR();
    }
    if (IN(14)) {
        pg8::Gemm g{XN, WpgT, T, D, D}; pg8::StaticOrder S; S.init(T, D, G, (int)blockIdx.x);
        pg8::EpiF32<1> E{(float*)(ws + WS_E)};
        pg8::gemm_phase<pg8::EpiF32<1>, pg8::StaticOrder, PG8_ALIGN, PG8_SP2>(lds + RING_OFF, g, S, E);
        if (BOTH(14)) GRID_BAR();
    }
    if (IN(15)) {
        const float* const tmp = (const float*)(ws + WS_E); const float* const g1 = args.in[25];
        for (int m = gw; m < T; m += NGW) {
            const GAS f32x4* tr = (const GAS f32x4*)(tmp + (size_t)m * D) + lane; GAS f32x4* hr = (GAS f32x4*)(out + (size_t)m * D) + lane;
            f32x4 v[4]; float s = 0.f;
#pragma unroll
            for (int j = 0; j < 4; ++j) { v[j] = tr[64 * j]; s += (v[j].x * v[j].x + v[j].y * v[j].y) + (v[j].z * v[j].z + v[j].w * v[j].w); }
            const float rs = 1.f / sqrtf(wave_sum(s) * (1.f / D) + NORM_EPS);
#pragma unroll
            for (int j = 0; j < 4; ++j) { const f32x4 gg = ((const GAS f32x4*)g1)[lane + 64 * j]; const f32x4 hh = hr[64 * j];
                v[j].x = hh.x + v[j].x * rs * gg.x; v[j].y = hh.y + v[j].y * rs * gg.y; v[j].z = hh.z + v[j].z * rs * gg.z; v[j].w = hh.w + v[j].w * rs * gg.w;
                hr[64 * j] = v[j]; }
        }
    }
#undef IN
#undef BOTH
}

extern "C" void kernel_launch(void* const* d_in, const int* in_sizes, int n_in, void* d_out, int out_size, void* d_ws, size_t ws_size, hipStream_t stream) {
    static int grid = 0;
    if (grid == 0) {
        if (n_in != 26 || in_sizes[0] != T * D || out_size != T * D || ws_size < WS_END) { fprintf(stderr, "kernel_launch: shape/workspace mismatch (n_in %d, in0 %d, out %d, ws %zu)\n", n_in, n_in > 0 ? in_sizes[0] : -1, out_size, ws_size); grid = -1; return; }
        int dev = 0, cus = 0, per_cu = 0;
        if (hipGetDevice(&dev) != hipSuccess || hipDeviceGetAttribute(&cus, hipDeviceAttributeMultiprocessorCount, dev) != hipSuccess) { grid = -1; return; }
        if (hipFuncSetAttribute((const void*)skel_fwd, hipFuncAttributeMaxDynamicSharedMemorySize, LDS_BYTES) != hipSuccess) { fprintf(stderr, "kernel_launch: hipFuncSetAttribute failed\n"); grid = -1; return; }
        if (hipOccupancyMaxActiveBlocksPerMultiprocessor(&per_cu, (const void*)skel_fwd, NWAVES * 64, LDS_BYTES) != hipSuccess || per_cu < 1) { fprintf(stderr, "kernel_launch: occupancy query says %d\n", per_cu); }
        (void)hipGetLastError();
        grid = cus;
    }
    if (grid < 0) return;
    if (hipMemsetAsync((char*)d_ws + WS_CTL, 0, CTL_ZERO_BYTES, stream) != hipSuccess) return;
    Args a{};
    for (int i = 0; i < 26; ++i) a.in[i] = (const float*)d_in[i];
    a.out = (float*)d_out; a.ws = (unsigned char*)d_ws;
#if MK_PER_PHASE
    for (int li = 0; li < N_PHASES; ++li) { a.ph_lo = li; a.ph_hi = li + 1; a.li = li; hipLaunchKernelGGL(skel_fwd, dim3(grid), dim3(NWAVES * 64), LDS_BYTES, stream, a); }
#else
    a.ph_lo = 0; a.ph_hi = N_PHASES; a.li = 0; hipLaunchKernelGGL(skel_fwd, dim3(grid), dim3(NWAVES * 64), LDS_BYTES, stream, a);
#endif
}
```

```cpp
#include <hip/hip_runtime.h>
#include <cstdio>
#include <cstdint>
namespace pg8 {
#define PG8_LAS __attribute__((address_space(3)))
typedef unsigned short bf16_t;
typedef short bf16x8 __attribute__((ext_vector_type(8)));
typedef float f32x4 __attribute__((ext_vector_type(4)));
typedef unsigned u32x4 __attribute__((ext_vector_type(4)));
constexpr int BM = 256, BK = 64, HALF = 128, HTB = HALF * BK * 2  , STAGE_BYTES = 8 * HTB, NXCD = 8, WGM = 8;

__host__ __device__ __forceinline__ int lds_byte(int r, int c) { const int st = (r >> 4) * 2 + (c >> 5), rr = r & 15, cc = c & 31, ob = rr * 64 + cc * 2; return st * 1024 + (ob ^ (((ob >> 9) & 1) << 5)); }
__host__ __device__ __forceinline__ void stage_rc(int b, int& R, int& C) { const int st = b / 1024, sb = b % 1024, swz = sb ^ (((sb >> 9) & 1) << 5); R = (st >> 1) * 16 + swz / 64; C = (st & 1) * 32 + (swz % 64) / 2; }
__host__ __device__ __forceinline__ int perm32(int rho) { const int n = rho >> 4, i = rho & 15; return 8 * (i >> 2) + 4 * n + (i & 3); }

struct Unit { int pm, pn; };
struct Gemm { const bf16_t* A; const bf16_t* Bt; int M, N, K; };

struct StaticOrder {
    int nM, nN, nwg, G, c;
    __host__ __device__ void init(int M, int N, int G_, int c_) { nM = M / BM; nN = N / BM; nwg = nM * nN; G = G_; c = c_; }
    __host__ __device__ bool next(int i, Unit& u) const {
        const long L = (long)i * G + c; if (L >= nwg) return false;
        int wgid = (int)L; { const int q = nwg / NXCD, r = nwg % NXCD, xcd = wgid % NXCD, off = wgid / NXCD; wgid = (xcd < r ? xcd * (q + 1) : r * (q + 1) + (xcd - r) * q) + off; }
        const int nig = WGM * nN, gid = wgid / nig, fm = gid * WGM, gsz = (nM - fm) < WGM ? (nM - fm) : WGM;
        u.pm = fm + ((wgid % nig) % gsz); u.pn = (wgid % nig) / gsz; return true;
    }
    __device__ __forceinline__ void a_ready(const Unit&) const {}
    __device__ __forceinline__ void done(const Unit&) const {}
};

__device__ __forceinline__ unsigned cvt_pk_bf16(float lo, float hi) { unsigned r; asm volatile("v_cvt_pk_bf16_f32 %0, %1, %2" : "=v"(r) : "v"(lo), "v"(hi)); return r; }
typedef float f32x2 __attribute__((ext_vector_type(2)));
__device__ __forceinline__ f32x2 gelu_pk(f32x2 v) {
    const f32x2 av = __builtin_elementwise_abs(v), d = av * 0.2316418882f + 1.0f;
    f32x2 t; t.x = __builtin_amdgcn_rcpf(d.x); t.y = __builtin_amdgcn_rcpf(d.y);
    f32x2 q = t * 0.5307027145f + (-0.7265760135f); q = q * t + 0.7107068705f; q = q * t + (-0.142248368f); q = q * t + 0.127414796f; q = q * t;
    const f32x2 s = (v * v) * (-0.72134752044f);
    f32x2 e; e.x = __builtin_amdgcn_exp2f(s.x); e.y = __builtin_amdgcn_exp2f(s.y);
    const f32x2 m = v * (q * e), r = v - m;
    f32x2 o; o.x = v.x < 0.f ? m.x : r.x; o.y = v.y < 0.f ? m.y : r.y; return o;
}

template <int ACT  > struct EpiBf16 {
    static constexpr bool PERM = true, AFTER_DRAIN = false; static_assert(ACT == 0 || ACT == 1, "EpiBf16: ACT is 0 (none) or 1 (gelu_pk)");
    bf16_t* O; int ldc; const float* bias; int split_cols; size_t split_stride; float scale0;
    __device__ __forceinline__ void operator()(const f32x4 (&acc)[2][2][4][2], const Unit& u, int wr, int wc, int fr, int fq) const {
        const int row0 = u.pm * BM + wr * 64 + fr; int colt = u.pn * BM; bf16_t* base = O;
        float sc = 1.f; if (split_cols) { const int t = colt / split_cols; base += (size_t)t * split_stride; colt -= t * split_cols; if (t == 0) sc = scale0; }
        const int col0 = colt + wc * 32 + 8 * fq, bcol0 = u.pn * BM + wc * 32 + 8 * fq;
        f32x4 bv[2][2];
#pragma unroll
        for (int bj = 0; bj < 2; ++bj)
#pragma unroll
            for (int n = 0; n < 2; ++n) bv[bj][n] = bias ? *(const f32x4*)(bias + bcol0 + bj * HALF + 4 * n) : (f32x4){0.f, 0.f, 0.f, 0.f};
#pragma unroll
        for (int ai = 0; ai < 2; ++ai)
#pragma unroll
            for (int m = 0; m < 4; ++m) { bf16_t* rowp = base + (size_t)(row0 + ai * HALF + m * 16) * ldc + col0;
#pragma unroll
                for (int bj = 0; bj < 2; ++bj) { f32x4 v0 = acc[ai][bj][m][0] + bv[bj][0], v1 = acc[ai][bj][m][1] + bv[bj][1];
                    if (ACT == 1) { f32x2 a = gelu_pk((f32x2){v0[0], v0[1]}), b = gelu_pk((f32x2){v0[2], v0[3]}), c = gelu_pk((f32x2){v1[0], v1[1]}), d = gelu_pk((f32x2){v1[2], v1[3]});
                        v0 = (f32x4){a.x, a.y, b.x, b.y}; v1 = (f32x4){c.x, c.y, d.x, d.y}; }
                    v0 = v0 * sc; v1 = v1 * sc; u32x4 w; w.x = cvt_pk_bf16(v0[0], v0[1]); w.y = cvt_pk_bf16(v0[2], v0[3]); w.z = cvt_pk_bf16(v1[0], v1[1]); w.w = cvt_pk_bf16(v1[2], v1[3]);
                    *(u32x4*)(rowp + bj * HALF) = w; } }
    }
};
template <class Epi, class Sched, bool ALIGN_EPI = false, bool SP2 = false>
__device__ __forceinline__ void gemm_phase(PG8_LAS unsigned char* lds, const Gemm g, const Sched& S, const Epi& E) {
    const int tid = threadIdx.x, wid = __builtin_amdgcn_readfirstlane(tid >> 6), lane = tid & 63, wr = wid >> 2, wc = wid & 3, fr = lane & 15, fq = lane >> 4;
    const int K = g.K, nt = K / BK;
    unsigned voffA[2], voffB[2];
#pragma unroll
    for (int i = 0; i < 2; ++i) { int R, C; stage_rc(tid * 16 + i * 8192, R, C); const int Rb = Epi::PERM ? ((R & ~31) + perm32(R & 31)) : R;
        voffA[i] = (unsigned)(R * K + C) * 2u; voffB[i] = (unsigned)(Rb * K + C) * 2u; }
    const size_t kstep = (size_t)(BK * 2);
    const size_t hstep = (size_t)HALF * K * 2;
    const size_t tstep = 2 * hstep;
    const unsigned ldsw = (unsigned)wid * 1024u;
    const int aoff = lds_byte(wr * 64 + fr, fq * 8), boff = lds_byte(wc * 32 + fr, fq * 8);
#define PG8_SA(b, h) (((b) * 2 + (h)) * HTB)
#define PG8_SB(b, h) ((4 + (b) * 2 + (h)) * HTB)
#define PG8_STAGE(bufoff, gbase, voff) do { _Pragma("unroll") for (int _i = 0; _i < 2; ++_i) \
        __builtin_amdgcn_global_load_lds((const unsigned*)((const char*)(gbase) + (voff)[_i]), (PG8_LAS unsigned*)(lds + (bufoff) + ldsw + _i * 8192), 16, 0, 0); } while (0)
#define PG8_LDA(dst, b, h) do { _Pragma("unroll") for (int m = 0; m < 4; ++m) _Pragma("unroll") for (int k = 0; k < 2; ++k) dst[m][k] = *(const PG8_LAS bf16x8*)(lds + PG8_SA(b, h) + aoff + m * 2048 + k * 1024); } while (0)
#define PG8_LDB(dst, b, h) do { _Pragma("unroll") for (int n = 0; n < 2; ++n) _Pragma("unroll") for (int k = 0; k < 2; ++k) dst[n][k] = *(const PG8_LAS bf16x8*)(lds + PG8_SB(b, h) + boff + n * 2048 + k * 1024); } while (0)
#define PG8_MMA(ai, bj, At, Bt) do { __builtin_amdgcn_s_setprio(1); _Pragma("unroll") for (int m = 0; m < 4; ++m) _Pragma("unroll") for (int n = 0; n < 2; ++n) _Pragma("unroll") for (int k = 0; k < 2; ++k) \
        acc[ai][bj][m][n] = __builtin_amdgcn_mfma_f32_16x16x32_bf16(Bt[n][k], At[m][k], acc[ai][bj][m][n], 0, 0, 0); __builtin_amdgcn_s_setprio(0); } while (0)
#define PG8_WAIT_V(n) asm volatile("s_waitcnt vmcnt(" #n ")" ::: "memory")
#define PG8_WAIT_L(n) asm volatile("s_waitcnt lgkmcnt(" #n ")" ::: "memory")
#define PG8_BAR __builtin_amdgcn_s_barrier()
#define PG8_SCHED __builtin_amdgcn_sched_barrier(0)
    Unit cur, nxt; int ui = 0;
    if (!S.next(0, cur)) return;
    f32x4 acc[2][2][4][2];
#pragma unroll
    for (int a = 0; a < 2; ++a)
#pragma unroll
        for (int b = 0; b < 2; ++b)
#pragma unroll
            for (int m = 0; m < 4; ++m)
#pragma unroll
                for (int n = 0; n < 2; ++n) acc[a][b][m][n] = (f32x4){0.f, 0.f, 0.f, 0.f};
    bf16x8 At[4][2], B0[2][2], B1[2][2];
    const char* cA = (const char*)g.A + (size_t)cur.pm * tstep; const char* cB = (const char*)g.Bt + (size_t)cur.pn * tstep;
    S.a_ready(cur);
    if constexpr (SP2) {
        PG8_STAGE(PG8_SB(0, 0), cB, voffB); PG8_STAGE(PG8_SB(0, 1), cB + hstep, voffB); PG8_STAGE(PG8_SA(0, 0), cA, voffA); PG8_STAGE(PG8_SA(0, 1), cA + hstep, voffA);
        if (wr == 1) PG8_BAR;
        PG8_WAIT_V(2); PG8_BAR;
        PG8_STAGE(PG8_SB(1, 0), cB + kstep, voffB); PG8_STAGE(PG8_SA(1, 0), cA + kstep, voffA); PG8_STAGE(PG8_SB(1, 1), cB + hstep + kstep, voffB);
        PG8_WAIT_V(6); PG8_BAR;
    } else {
        PG8_STAGE(PG8_SB(0, 0), cB, voffB); PG8_STAGE(PG8_SA(0, 0), cA, voffA); PG8_STAGE(PG8_SB(0, 1), cB + hstep, voffB); PG8_STAGE(PG8_SA(0, 1), cA + hstep, voffA);
        if (wr == 1) PG8_BAR;
        PG8_WAIT_V(4); PG8_BAR;
        PG8_STAGE(PG8_SB(1, 0), cB + kstep, voffB); PG8_STAGE(PG8_SA(1, 0), cA + kstep, voffA); PG8_STAGE(PG8_SB(1, 1), cB + hstep + kstep, voffB);
        PG8_WAIT_V(6); PG8_BAR;
    }
    for (;;) {
        const bool has_next = S.next(ui + 1, nxt);
        const char* nA = has_next ? (const char*)g.A + (size_t)nxt.pm * tstep : cA; const char* nB = has_next ? (const char*)g.Bt + (size_t)nxt.pn * tstep : cB;
        for (int t = 0; t < nt; t += 2) {
            const bool last = (t == nt - 2);
            const char* a1 = cA + (size_t)(t + 1) * kstep;
            const char* a2 = last ? nA : cA + (size_t)(t + 2) * kstep; const char* b2 = last ? nB : cB + (size_t)(t + 2) * kstep;
            const char* a3 = a2 + kstep; const char* b3 = b2 + kstep;
            if (last && has_next) S.a_ready(nxt);
            if constexpr (SP2) {
            PG8_LDB(B0, 0, 0); PG8_LDB(B1, 0, 1); PG8_SCHED; PG8_LDA(At, 0, 0); PG8_STAGE(PG8_SA(1, 1), a1 + hstep, voffA);
            PG8_WAIT_V(8); PG8_WAIT_L(0); PG8_BAR; PG8_MMA(0, 0, At, B0); PG8_MMA(0, 1, At, B1); PG8_BAR; PG8_SCHED;
            PG8_LDA(At, 0, 1); PG8_STAGE(PG8_SB(0, 0), b2, voffB); PG8_STAGE(PG8_SB(0, 1), b2 + hstep, voffB); PG8_STAGE(PG8_SA(0, 0), a2, voffA);
            PG8_WAIT_V(8); PG8_WAIT_L(0); PG8_BAR; PG8_MMA(1, 0, At, B0); PG8_MMA(1, 1, At, B1); PG8_BAR; PG8_SCHED;
            PG8_LDB(B0, 1, 0); PG8_LDB(B1, 1, 1); PG8_SCHED; PG8_LDA(At, 1, 0); PG8_STAGE(PG8_SA(0, 1), a2 + hstep, voffA);
            PG8_WAIT_V(8); PG8_WAIT_L(0); PG8_BAR; PG8_MMA(0, 0, At, B0); PG8_MMA(0, 1, At, B1); PG8_BAR; PG8_SCHED;
            PG8_LDA(At, 1, 1); PG8_STAGE(PG8_SB(1, 0), b3, voffB); PG8_STAGE(PG8_SB(1, 1), b3 + hstep, voffB); PG8_STAGE(PG8_SA(1, 0), a3, voffA);
            PG8_WAIT_V(8); PG8_WAIT_L(0); PG8_BAR; PG8_MMA(1, 0, At, B0); PG8_MMA(1, 1, At, B1); PG8_BAR; PG8_SCHED;
            } else {
            PG8_LDB(B0, 0, 0); PG8_SCHED; PG8_LDA(At, 0, 0); PG8_STAGE(PG8_SA(1, 1), a1 + hstep, voffA);
            PG8_WAIT_L(8); PG8_BAR; PG8_WAIT_L(0); PG8_MMA(0, 0, At, B0); PG8_BAR; PG8_SCHED;
            PG8_LDB(B1, 0, 1); PG8_STAGE(PG8_SB(0, 0), b2, voffB);
            PG8_BAR; PG8_WAIT_L(0); PG8_MMA(0, 1, At, B1); PG8_BAR;
            PG8_LDA(At, 0, 1); PG8_STAGE(PG8_SA(0, 0), a2, voffA);
            PG8_BAR; PG8_WAIT_L(0); PG8_MMA(1, 0, At, B0); PG8_BAR; PG8_SCHED;
            PG8_STAGE(PG8_SB(0, 1), b2 + hstep, voffB);
            PG8_WAIT_V(6); PG8_BAR; PG8_MMA(1, 1, At, B1); PG8_BAR;
            PG8_LDB(B0, 1, 0); PG8_SCHED; PG8_LDA(At, 1, 0); PG8_STAGE(PG8_SA(0, 1), a2 + hstep, voffA);
            PG8_WAIT_L(8); PG8_BAR; PG8_WAIT_L(0); PG8_MMA(0, 0, At, B0); PG8_BAR; PG8_SCHED;
            PG8_LDB(B1, 1, 1); PG8_STAGE(PG8_SB(1, 0), b3, voffB);
            PG8_BAR; PG8_WAIT_L(0); PG8_MMA(0, 1, At, B1); PG8_BAR;
            PG8_LDA(At, 1, 1); PG8_STAGE(PG8_SA(1, 0), a3, voffA);
            PG8_BAR; PG8_WAIT_L(0); PG8_MMA(1, 0, At, B0); PG8_BAR; PG8_SCHED;
            PG8_STAGE(PG8_SB(1, 1), b3 + hstep, voffB);
            PG8_WAIT_V(6); PG8_BAR; PG8_MMA(1, 1, At, B1); PG8_BAR;
            }
        }
        if constexpr (ALIGN_EPI) { if (wr == 0) PG8_BAR; }
        if constexpr (!Epi::AFTER_DRAIN) { E(acc, cur, wr, wc, fr, fq); S.done(cur); }
        if (!has_next) break;
#pragma unroll
        for (int a = 0; a < 2; ++a)
#pragma unroll
            for (int b = 0; b < 2; ++b)
#pragma unroll
                for (int m = 0; m < 4; ++m)
#pragma unroll
                    for (int n = 0; n < 2; ++n) acc[a][b][m][n] = (f32x4){0.f, 0.f, 0.f, 0.f};
        cur = nxt; cA = nA; cB = nB; ++ui;
        if constexpr (ALIGN_EPI) { if (wr == 1) PG8_BAR; }
    }
    PG8_WAIT_V(0);
    if constexpr (!ALIGN_EPI) { if (wr == 0) PG8_BAR; }
    PG8_BAR;
    if constexpr (Epi::AFTER_DRAIN) { E.fused(acc, cur, wr, wc, fr, fq, lds, wid, lane); S.done(cur); }
#undef PG8_SA
#undef PG8_SB
#undef PG8_STAGE
#undef PG8_LDA
#undef PG8_LDB
#undef PG8_MMA
#undef PG8_WAIT_V
#undef PG8_WAIT_L
#undef PG8_BAR
#undef PG8_SCHED
}
}
#define GAS __attribute__((address_space(1)))
#define LAS __attribute__((address_space(3)))
typedef unsigned short bf16;
typedef unsigned v4u __attribute__((ext_vector_type(4)));
typedef float f32x4 __attribute__((ext_vector_type(4)));
typedef short bf16x8 __attribute__((ext_vector_type(8)));
typedef GAS unsigned gu32;
typedef GAS unsigned long long gu64;
#define RLX_AGENT __ATOMIC_RELAXED, __HIP_MEMORY_SCOPE_AGENT
#define LDS_WAIT() asm volatile("s_waitcnt lgkmcnt(0)" ::: "memory")
#define VM_WAIT() asm volatile("s_waitcnt vmcnt(0)" ::: "memory")
__device__ __forceinline__ unsigned long long rt() { return __builtin_amdgcn_s_memrealtime(); }
__device__ __forceinline__ unsigned f2bf(float f) { unsigned u = __builtin_bit_cast(unsigned, f); return (u + 0x7fffu + ((u >> 16) & 1u)) >> 16; }
__device__ __forceinline__ unsigned pk2(float lo, float hi) { return f2bf(lo) | (f2bf(hi) << 16); }

#define XB_TMO      128
#define XB_XCNT(j)  (256  + 64 * (j))
#define XB_XSUB(j)  (1280 + 64 * (j))
#define XB_XGEN(j)  (2304 + 64 * (j))
#define XB_TOP      3328
#define XB_TOPGEN   3392
#define XCD_BAR_WORDS 3456
#define XB_SPIN_CAP (1u << 18)

__device__ __forceinline__ unsigned xb_ld(unsigned* p)              { return __hip_atomic_load(p, __ATOMIC_RELAXED, __HIP_MEMORY_SCOPE_AGENT); }
__device__ __forceinline__ unsigned xb_add(unsigned* p, unsigned v) { return __hip_atomic_fetch_add(p, v, __ATOMIC_RELAXED, __HIP_MEMORY_SCOPE_AGENT); }
__device__ __forceinline__ unsigned xb_xcc_id() { return (unsigned)__builtin_amdgcn_s_getreg((3 << 11) | 20) & 0xFu; }
#define XB_SPIN(cond, bar) do { unsigned _sp = 0; while (cond) { __builtin_amdgcn_s_sleep(1); \
    if ((++_sp & 255u) == 0u) { if (xb_ld(&(bar)[XB_TMO])) break; if (_sp > XB_SPIN_CAP) { atomicAdd(&(bar)[XB_TMO], 1u); break; } } } } while (0)

struct XcdBarrier {
    unsigned* bar; unsigned x;
    volatile LAS unsigned* st;
};

__device__ __forceinline__ XcdBarrier xcd_barrier_post(unsigned* bar, volatile LAS unsigned* st) {
    XcdBarrier b; b.bar = bar; b.x = xb_xcc_id(); b.st = st;
    if (threadIdx.x == 0) (void)xb_add(&bar[XB_XCNT(b.x)], 1u);
    return b;
}
__device__ __forceinline__ void xcd_barrier_complete(unsigned* bar, unsigned x, unsigned& nloc, unsigned& nx) {
    const unsigned G = gridDim.x * gridDim.y * gridDim.z;
    unsigned sum, cnt, mine, sp = 0u;
    for (;;) {
        sum = 0u; cnt = 0u; mine = 0u;
#pragma unroll
        for (unsigned j = 0; j < 16; ++j) { const unsigned c = xb_ld(&bar[XB_XCNT(j)]); sum += c; cnt += (c > 0u) ? 1u : 0u; mine = (j == x) ? c : mine; }
        if (sum == G) break;
        __builtin_amdgcn_s_sleep(1);
        if ((++sp & 255u) == 0u) { if (xb_ld(&bar[XB_TMO])) break; if (sp > XB_SPIN_CAP) { atomicAdd(&bar[XB_TMO], 1u); break; } }
    }
    nloc = mine > 0u ? mine : 1u; nx = cnt > 0u ? cnt : 1u;
}

__device__ __forceinline__ void xcd_barrier(const XcdBarrier& b) {
    asm volatile("s_waitcnt vmcnt(0)" ::: "memory");
    __syncthreads();
    if (threadIdx.x == 0) {
        unsigned* bar = b.bar;
        __builtin_amdgcn_s_waitcnt(0);
        unsigned nloc = b.st[0], nx = b.st[1];
        if (nloc == 0u) { xcd_barrier_complete(bar, b.x, nloc, nx); b.st[0] = nloc; b.st[1] = nx; }
        const unsigned old = xb_add(&bar[XB_XSUB(b.x)], 1u);
        const unsigned gen = old / nloc;
        if (old + 1u == (gen + 1u) * nloc) {
            __builtin_amdgcn_fence(__ATOMIC_RELEASE, "agent");
            asm volatile("s_waitcnt vmcnt(0)" ::: "memory");
            const unsigned og = xb_add(&bar[XB_TOP], 1u);
            const unsigned tg = og / nx;
            if (og + 1u == (tg + 1u) * nx) xb_add(&bar[XB_TOPGEN], 1u);
            else XB_SPIN(xb_ld(&bar[XB_TOPGEN]) == tg, bar);
            __builtin_amdgcn_fence(__ATOMIC_ACQUIRE, "agent");
            xb_add(&bar[XB_XGEN(b.x)], 1u);
            asm volatile("s_waitcnt vmcnt(0)" ::: "memory");
        } else {
            XB_SPIN(xb_ld(&bar[XB_XGEN(b.x)]) == gen, bar);
            __builtin_amdgcn_fence(__ATOMIC_ACQUIRE, "agent");
            asm volatile("s_waitcnt vmcnt(0)" ::: "memory");
        }
    }
    __syncthreads();
}
#define PG8_SP2 true
#define PG8_ALIGN true

constexpr int NWAVES = 8;
constexpr int BATCH = 4, SEQ = 8192, D = 1024, T = BATCH * SEQ, HD = 64;
constexpr int NIN = 6144;
constexpr int FF = 4096, PLE = 256;
constexpr int ZA_LD = 2304, ZR_LD = 1792, ZG_LD = 2048;
constexpr int RW = 512;
constexpr float NORM_EPS = 1e-6f, GN_EPS = 64e-5f;
#ifndef MK_PER_PHASE
#define MK_PER_PHASE 0
#endif
enum { PH_PRO = 0, PH_INPROJ, PH_ATT, PH_PREP, PH_CHUNK, PH_SEQ, PH_POST, PH_UPA, PH_UPR, PH_WO, PH_ROWA, PH_FFI, PH_FFO, PH_ROWB, PH_PLE, PH_PLEG, PH_ROWC, N_PHASES };

constexpr size_t MiB = 1u << 20;
constexpr size_t WS_CTL = 0, CTL_ZERO_BYTES = 1 * MiB;
constexpr size_t WS_CS = 1 * MiB;
constexpr size_t WS_BONUS = 3 * MiB;
constexpr size_t WS_LSE = 4 * MiB;
constexpr size_t WS_WIN = 6 * MiB, WS_WFI = 18 * MiB, WS_WFO = 26 * MiB, WS_WO = 34 * MiB, WS_WPG = 36 * MiB;
constexpr size_t WS_WPLE = 38 * MiB, WS_WAU = 38 * MiB + 512 * 1024, WS_WRU = 39 * MiB;
constexpr size_t WS_XN = 40 * MiB;
constexpr size_t WS_PB = 104 * MiB;
constexpr size_t WS_ZA = 120 * MiB;
constexpr size_t WS_ZR = 264 * MiB;
constexpr size_t WS_ZG = 376 * MiB;
constexpr size_t WS_END = 512 * MiB;
constexpr size_t WS_OA = WS_XN;
constexpr size_t WS_R = WS_ZA, WS_KP = WS_ZA + 32 * MiB, WS_V = WS_ZA + 64 * MiB, WS_AV = WS_ZA + 96 * MiB;
constexpr size_t WS_Y = WS_ZR;
constexpr size_t WS_ORW = WS_ZR + 64 * MiB;
constexpr size_t WS_M1 = WS_ZA;
constexpr size_t WS_TMP2A = 184 * MiB;
constexpr size_t WS_H = WS_ZA;
constexpr size_t WS_TMP2B = WS_ZG;
constexpr size_t WS_E = WS_ZA;
constexpr size_t WS_OG = WS_XN + 16 * MiB;
constexpr size_t DO_DEC = 0;
constexpr size_t DO_BV = 64 * MiB, DO_GT = 96 * MiB;
constexpr size_t WS_YLT = WS_XN + 16 * MiB;
constexpr size_t WS_GC = 504 * MiB;
constexpr int CW_TMO = 0, CW_CODE = 1, CW_BAR = 4096;

constexpr int RING_OFF = 0, RING_BYTES = 131072;
constexpr int LDSCTL_OFF = RING_BYTES, MISC_OFF = LDSCTL_OFF + 320;
constexpr int LDS_BYTES = 147456;

typedef unsigned v2u __attribute__((ext_vector_type(2)));
__device__ __forceinline__ float bf2f(bf16 u) { return __builtin_bit_cast(float, (unsigned)u << 16); }
__device__ __forceinline__ float bflo(unsigned u) { return __builtin_bit_cast(float, u << 16); }
__device__ __forceinline__ float bfhi(unsigned u) { return __builtin_bit_cast(float, u & 0xffff0000u); }
__device__ __forceinline__ float sigmoidf_(float x) { return 1.0f / (1.0f + __expf(-x)); }
__device__ __forceinline__ float wave_sum(float v) {
#pragma unroll
    for (int o = 1; o < 64; o <<= 1) v += __shfl_xor(v, o);
    return v;
}

namespace pg8 {
struct EpiInProj {
    static constexpr bool PERM = true, AFTER_DRAIN = false;
    bf16_t *za, *zr, *zg;
    __device__ __forceinline__ void operator()(const f32x4 (&acc)[2][2][4][2], const Unit& u, int wr, int wc, int fr, int fq) const {
        bf16_t* base; int ld, colt; bool sig = false;
        if (u.pn < 9) { base = za; ld = 2304; colt = u.pn * 256; }
        else if (u.pn < 16) { base = zr; ld = 1792; colt = (u.pn - 9) * 256; }
        else { base = zg; ld = 2048; colt = (u.pn - 16) * 256; sig = true; }
        const int row0 = u.pm * BM + wr * 64 + fr, col0 = colt + wc * 32 + 8 * fq;
#pragma unroll
        for (int ai = 0; ai < 2; ++ai)
#pragma unroll
            for (int m = 0; m < 4; ++m) { bf16_t* rowp = base + (size_t)(row0 + ai * HALF + m * 16) * ld + col0;
#pragma unroll
                for (int bj = 0; bj < 2; ++bj) { f32x4 v0 = acc[ai][bj][m][0], v1 = acc[ai][bj][m][1];
                    if (sig) {
#pragma unroll
                        for (int k = 0; k < 4; ++k) { v0[k] = 1.0f / (1.0f + __expf(-v0[k])); v1[k] = 1.0f / (1.0f + __expf(-v1[k])); } }
                    u32x4 w; w.x = cvt_pk_bf16(v0[0], v0[1]); w.y = cvt_pk_bf16(v0[2], v0[3]); w.z = cvt_pk_bf16(v1[0], v1[1]); w.w = cvt_pk_bf16(v1[2], v1[3]);
                    *(u32x4*)(rowp + bj * HALF) = w; } }
    }
};
struct EpiGateF32 {
    static constexpr bool PERM = false, AFTER_DRAIN = false;
    float* out; const bf16_t* gate; int gld, gcol0;
    __device__ __forceinline__ void operator()(const f32x4 (&acc)[2][2][4][2], const Unit& u, int wr, int wc, int fr, int fq) const {
        const int col0 = u.pn * BM + wc * 32 + 4 * fq;
#pragma unroll
        for (int ai = 0; ai < 2; ++ai)
#pragma unroll
            for (int m = 0; m < 4; ++m) { const int r = u.pm * BM + ai * HALF + wr * 64 + m * 16 + fr;
#pragma unroll
                for (int bj = 0; bj < 2; ++bj)
#pragma unroll
                    for (int n = 0; n < 2; ++n) { const int c = col0 + bj * HALF + n * 16;
                        const unsigned long long gq = *(const unsigned long long*)(gate + (size_t)r * gld + gcol0 + c);
                        const unsigned g0 = (unsigned)gq, g1 = (unsigned)(gq >> 32);
                        f32x4 a = acc[ai][bj][m][n];
                        a[0] *= __builtin_bit_cast(float, g0 << 16); a[1] *= __builtin_bit_cast(float, g0 & 0xffff0000u);
                        a[2] *= __builtin_bit_cast(float, g1 << 16); a[3] *= __builtin_bit_cast(float, g1 & 0xffff0000u);
                        *(f32x4*)(out + (size_t)r * 1024 + c) = a; } }
    }
};
struct EpiMerge {
    static constexpr bool PERM = true, AFTER_DRAIN = false;
    const float* tmp; const bf16_t* gate; int gld, gcol0; bf16_t* out;
    __device__ __forceinline__ void operator()(const f32x4 (&acc)[2][2][4][2], const Unit& u, int wr, int wc, int fr, int fq) const {
        const int row0 = u.pm * BM + wr * 64 + fr, col0 = u.pn * BM + wc * 32 + 8 * fq;
#pragma unroll
        for (int ai = 0; ai < 2; ++ai)
#pragma unroll
            for (int m = 0; m < 4; ++m) { const int r = row0 + ai * HALF + m * 16;
#pragma unroll
                for (int bj = 0; bj < 2; ++bj) { const int c = col0 + bj * HALF;
                    const u32x4 gq = *(const u32x4*)(gate + (size_t)r * gld + gcol0 + c);
                    const f32x4 t0 = *(const f32x4*)(tmp + (size_t)r * 1024 + c), t1 = *(const f32x4*)(tmp + (size_t)r * 1024 + c + 4);
                    f32x4 v0 = acc[ai][bj][m][0], v1 = acc[ai][bj][m][1];
                    v0[0] = t0[0] + v0[0] * __builtin_bit_cast(float, gq.x << 16); v0[1] = t0[1] + v0[1] * __builtin_bit_cast(float, gq.x & 0xffff0000u);
                    v0[2] = t0[2] + v0[2] * __builtin_bit_cast(float, gq.y << 16); v0[3] = t0[3] + v0[3] * __builtin_bit_cast(float, gq.y & 0xffff0000u);
                    v1[0] = t1[0] + v1[0] * __builtin_bit_cast(float, gq.z << 16); v1[1] = t1[1] + v1[1] * __builtin_bit_cast(float, gq.z & 0xffff0000u);
                    v1[2] = t1[2] + v1[2] * __builtin_bit_cast(float, gq.w << 16); v1[3] = t1[3] + v1[3] * __builtin_bit_cast(float, gq.w & 0xffff0000u);
                    u32x4 w; w.x = cvt_pk_bf16(v0[0], v0[1]); w.y = cvt_pk_bf16(v0[2], v0[3]); w.z = cvt_pk_bf16(v1[0], v1[1]); w.w = cvt_pk_bf16(v1[2], v1[3]);
                    *(u32x4*)(out + (size_t)r * 1024 + c) = w; } }
    }
};
template <int MODE> struct EpiF32 {
    static constexpr bool PERM = false, AFTER_DRAIN = false;
    float* out;
    __device__ __forceinline__ void operator()(const f32x4 (&acc)[2][2][4][2], const Unit& u, int wr, int wc, int fr, int fq) const {
        const int col0 = u.pn * BM + wc * 32 + 4 * fq;
#pragma unroll
        for (int ai = 0; ai < 2; ++ai)
#pragma unroll
            for (int m = 0; m < 4; ++m) { const int r = u.pm * BM + ai * HALF + wr * 64 + m * 16 + fr;
#pragma unroll
                for (int bj = 0; bj < 2; ++bj)
#pragma unroll
                    for (int n = 0; n < 2; ++n) { float* p = out + (size_t)r * 1024 + col0 + bj * HALF + n * 16; f32x4 a = acc[ai][bj][m][n];
                        if (MODE == 1) { const f32x4 e = *(const f32x4*)p;
#pragma unroll
                            for (int k = 0; k < 4; ++k) a[k] = e[k] / (1.0f + __expf(-a[k])); }
                        *(f32x4*)p = a; } }
    }
};
struct EpiRelu2 {
    static constexpr bool PERM = true, AFTER_DRAIN = false;
    bf16_t* out;
    __device__ __forceinline__ void operator()(const f32x4 (&acc)[2][2][4][2], const Unit& u, int wr, int wc, int fr, int fq) const {
        const int row0 = u.pm * BM + wr * 64 + fr, col0 = u.pn * BM + wc * 32 + 8 * fq;
#pragma unroll
        for (int ai = 0; ai < 2; ++ai)
#pragma unroll
            for (int m = 0; m < 4; ++m) { bf16_t* rowp = out + (size_t)(row0 + ai * HALF + m * 16) * 4096 + col0;
#pragma unroll
                for (int bj = 0; bj < 2; ++bj) { f32x4 v0 = acc[ai][bj][m][0], v1 = acc[ai][bj][m][1];
#pragma unroll
                    for (int k = 0; k < 4; ++k) { const float a = fmaxf(v0[k], 0.f), b = fmaxf(v1[k], 0.f); v0[k] = a * a; v1[k] = b * b; }
                    u32x4 w; w.x = cvt_pk_bf16(v0[0], v0[1]); w.y = cvt_pk_bf16(v0[2], v0[3]); w.z = cvt_pk_bf16(v1[0], v1[1]); w.w = cvt_pk_bf16(v1[2], v1[3]);
                    *(u32x4*)(rowp + bj * HALF) = w; } }
    }
};
}

__device__ __forceinline__ void p0_transpose_item(const float* W, int K, int N, bf16* WT, int row_off, LAS float* scr, int item, int lane) {
    const int nblk = N / 32, kb = item / nblk, nb = item % nblk, k0 = 64 * kb, n0 = 32 * nb;
#pragma unroll 8
    for (int i = 0; i < 32; ++i) { const int kk = 2 * i + (lane >> 5); scr[kk * 33 + (lane & 31)] = W[(size_t)(k0 + kk) * N + n0 + (lane & 31)]; }
    LDS_WAIT(); asm volatile("" ::: "memory");
    const int c = lane & 7;
#pragma unroll
    for (int j = 0; j < 4; ++j) { const int n = (lane >> 3) + 8 * j; const LAS float* s = scr + (8 * c) * 33 + n;
        v4u o; o.x = pk2(s[0 * 33], s[1 * 33]); o.y = pk2(s[2 * 33], s[3 * 33]); o.z = pk2(s[4 * 33], s[5 * 33]); o.w = pk2(s[6 * 33], s[7 * 33]);
        *(GAS v4u*)(WT + (size_t)(row_off + n0 + n) * K + k0 + 8 * c) = o; }
    LDS_WAIT(); asm volatile("" ::: "memory");
}
__device__ __forceinline__ void rms_row_to_bf16(const float* xrow, const float* g, bf16* orow, int lane) {
    const GAS f32x4* xr = (const GAS f32x4*)xrow + lane; const GAS f32x4* gr = (const GAS f32x4*)g + lane;
    f32x4 v[4]; float s = 0.f;
#pragma unroll
    for (int j = 0; j < 4; ++j) { v[j] = xr[64 * j]; s += (v[j].x * v[j].x + v[j].y * v[j].y) + (v[j].z * v[j].z + v[j].w * v[j].w); }
    const float rs = 1.f / sqrtf(wave_sum(s) * (1.f / D) + NORM_EPS);
    GAS unsigned long long* o8 = (GAS unsigned long long*)orow + lane;
#pragma unroll
    for (int j = 0; j < 4; ++j) { const f32x4 gg = gr[64 * j];
        o8[64 * j] = (unsigned long long)pk2(v[j].x * rs * gg.x, v[j].y * rs * gg.y) | ((unsigned long long)pk2(v[j].z * rs * gg.z, v[j].w * rs * gg.w) << 32); }
}

struct Args { const float* in[26]; float* out; unsigned char* ws; int ph_lo, ph_hi, li, pad; };

__global__ void __launch_bounds__(NWAVES * 64, 2) skel_fwd(Args args) {
    extern __shared__ __attribute__((aligned(16))) unsigned char lds_raw[];
    LAS unsigned char* const lds = (LAS unsigned char*)lds_raw;
    volatile LAS unsigned* const MISC = (volatile LAS unsigned*)(lds + MISC_OFF);
    const int tid = threadIdx.x, lane = tid & 63, wave = __builtin_amdgcn_readfirstlane(tid >> 6);
    const int G = gridDim.x; int vcu; { const int bx = blockIdx.x; vcu = (G % 8 == 0) ? (bx % 8) * (G / 8) + bx / 8 : bx; }
    unsigned char* const ws = args.ws;
    gu32* const ctl = (gu32*)(ws + WS_CTL);
    for (int u = tid; u < (LDS_BYTES - LDSCTL_OFF) / 4; u += NWAVES * 64) ((LAS unsigned*)(lds + LDSCTL_OFF))[u] = 0u;
    __syncthreads();
    XcdBarrier bar; bar.bar = (unsigned*)(ctl + CW_BAR); bar.x = 0; bar.st = nullptr;
    if (!MK_PER_PHASE) bar = xcd_barrier_post((unsigned*)(ctl + CW_BAR), MISC + 8);
#define GRID_BAR() do { if (MK_PER_PHASE) { if (tid == 0) __hip_atomic_store(ctl + CW_TMO, 0xBADBA0u, RLX_AGENT); } else { xcd_barrier(bar); } } while (0)
    const int lo = args.ph_lo, hi = args.ph_hi;
#ifndef PH_MASK
#define PH_MASK 0xFFFFFFFFu
#endif
#define IN(k) (((PH_MASK >> (k)) & 1u) && lo <= (k) && (k) < hi)
#define BOTH(k) (IN(k) && IN((k) + 1))
    const int gw = vcu * NWAVES + wave, NGW = G * NWAVES;
    const int gt = vcu * (NWAVES * 64) + tid, NGT = G * NWAVES * 64;

    const float* const x = args.in[0]; const float* const pin = args.in[1];
    float* const out = args.out;
    bf16* const WinT = (bf16*)(ws + WS_WIN); bf16* const WfiT = (bf16*)(ws + WS_WFI); bf16* const WfoT = (bf16*)(ws + WS_WFO);
    bf16* const WoT = (bf16*)(ws + WS_WO); bf16* const WpgT = (bf16*)(ws + WS_WPG); bf16* const WpleT = (bf16*)(ws + WS_WPLE);
    bf16* const WauT = (bf16*)(ws + WS_WAU); bf16* const WruT = (bf16*)(ws + WS_WRU);
    bf16* const XN = (bf16*)(ws + WS_XN); bf16* const PB = (bf16*)(ws + WS_PB);
    bf16* const ZA = (bf16*)(ws + WS_ZA); bf16* const ZR = (bf16*)(ws + WS_ZR); bf16* const ZG = (bf16*)(ws + WS_ZG);
    float2* const CS = (float2*)(ws + WS_CS);

    if (IN(PH_PRO)) {
        LAS float* scr = (LAS float*)(lds + RING_OFF + wave * 16384);
        constexpr int I_IN = (D / 64) * (6048 / 32), I_FI = (D / 64) * (FF / 32), I_FO = (FF / 64) * (D / 32), I_O = (D / 64) * (D / 32), I_PG = I_O;
        constexpr int I_PLE = (PLE / 64) * (D / 32), I_AU = (256 / 64) * (D / 32), I_RU = (512 / 64) * (D / 32);
        constexpr int NITEMS = I_IN + I_FI + I_FO + I_O + I_PG + I_PLE + I_AU + I_RU;
        for (int it = gw; it < NITEMS; it += NGW) {
            int r = it;
            if (r < I_IN) { const int nb = r % (6048 / 32); p0_transpose_item(args.in[3], D, 6048, WinT, (nb * 32 >= 4000) ? 96 : 0, scr, r, lane); continue; } r -= I_IN;
            if (r < I_FI) { p0_transpose_item(args.in[20], D, FF, WfiT, 0, scr, r, lane); continue; } r -= I_FI;
            if (r < I_FO) { p0_transpose_item(args.in[21], FF, D, WfoT, 0, scr, r, lane); continue; } r -= I_FO;
            if (r < I_O) { p0_transpose_item(args.in[17], D, D, WoT, 0, scr, r, lane); continue; } r -= I_O;
            if (r < I_PG) { p0_transpose_item(args.in[24], D, D, WpgT, 0, scr, r, lane); continue; } r -= I_PG;
            if (r < I_PLE) { p0_transpose_item(args.in[23], PLE, D, WpleT, 0, scr, r, lane); continue; } r -= I_PLE;
            if (r < I_AU) { p0_transpose_item(args.in[15], 256, D, WauT, 0, scr, r, lane); continue; } r -= I_AU;
            p0_transpose_item(args.in[16], 512, D, WruT, 0, scr, r, lane);
        }
        for (int i = gt; i < 96 * 1024 / 8; i += NGT) ((GAS v4u*)(WinT + (size_t)4000 * 1024))[i] = (v4u){0u, 0u, 0u, 0u};
        for (int m = gw; m < T; m += NGW) rms_row_to_bf16(x + (size_t)m * D, args.in[2], XN + (size_t)m * D, lane);
        for (int m = gw; m < T; m += NGW) { const f32x4 v = ((const GAS f32x4*)(pin + (size_t)m * PLE))[lane];
            ((GAS unsigned long long*)(PB + (size_t)m * PLE))[lane] = (unsigned long long)pk2(v.x, v.y) | ((unsigned long long)pk2(v.z, v.w) << 32); }
        for (int i = gt; i < SEQ * 32; i += NGT) { const int pos = i >> 5, fi = i & 31;
            const float inv = (float)exp(-(double)fi * (1.0 / 32.0) * 9.210340371976184);
            const float ang = (float)pos * inv;
            const double a = (double)ang; const double kq = rint(a * 0.15915494309189535); const double rr = a - kq * 6.283185307179586;
            const float rf = (float)rr; CS[i] = make_float2(cosf(rf), sinf(rf)); }
        if (BOTH(PH_PRO)) GRID_BAR();
    }

    if (IN(PH_INPROJ)) {
        pg8::Gemm g{XN, WinT, T, NIN, D}; pg8::StaticOrder S; S.init(T, NIN, G, (int)blockIdx.x);
        pg8::EpiInProj E{ZA, ZR, ZG};
        pg8::gemm_phase<pg8::EpiInProj, pg8::StaticOrder, PG8_ALIGN, PG8_SP2>(lds + RING_OFF, g, S, E);
        if (BOTH(PH_INPROJ)) GRID_BAR();
    }

    if (IN(PH_ATT)) {
        bf16* const OG = (bf16*)(ws + WS_OG); float* const LSE = (float*)(ws + WS_LSE);
        LAS float* Ks = (LAS float*)(lds + RING_OFF); LAS float* Vs = Ks + 192 * 68;
        const int qi = tid >> 3, part = tid & 7;
        for (int unit = vcu; unit < BATCH * 3 * 4 * 128; unit += G) {
            const int tau = unit & 127, h = (unit >> 7) & 3, g = (unit >> 9) % 3, b = unit / (128 * 4 * 3);
            const int dl = (g == 0) ? 1 : (g == 1) ? 4 : 16;
            const int rho = tau % dl, it = tau / dl, i0 = it * 64;
            const int colq = g * 256 + h * 64, colk = 768 + colq, colv = 1536 + colq;
            for (int idx = tid; idx < 192 * 32; idx += 512) {
                const int lr = idx >> 5, dd = idx & 31, ik = i0 - 128 + lr;
                float k1 = 0.f, k2 = 0.f, v1 = 0.f, v2 = 0.f;
                if (ik >= 0) { const int t = ik * dl + rho; const bf16* row = ZA + (size_t)(b * SEQ + t) * ZA_LD;
                    const float x1 = bf2f(row[colk + dd]), x2 = bf2f(row[colk + dd + 32]); const float2 cs = CS[t * 32 + dd];
                    k1 = x1 * cs.x - x2 * cs.y; k2 = x2 * cs.x + x1 * cs.y; v1 = bf2f(row[colv + dd]); v2 = bf2f(row[colv + dd + 32]); }
                Ks[lr * 68 + dd] = k1; Ks[lr * 68 + dd + 32] = k2; Vs[lr * 68 + dd] = v1; Vs[lr * 68 + dd + 32] = v2;
            }
            const int tq = (i0 + qi) * dl + rho; const bf16* qrow = ZA + (size_t)(b * SEQ + tq) * ZA_LD + colq;
            float q[64];
#pragma unroll
            for (int dd = 0; dd < 32; ++dd) { const float x1 = bf2f(qrow[dd]), x2 = bf2f(qrow[dd + 32]); const float2 cs = CS[tq * 32 + dd];
                q[dd] = (x1 * cs.x - x2 * cs.y) * 0.125f; q[dd + 32] = (x2 * cs.x + x1 * cs.y) * 0.125f; }
            __syncthreads();
            float m = -INFINITY, l = 0.f; float o[64];
#pragma unroll
            for (int c = 0; c < 64; ++c) o[c] = 0.f;
#pragma unroll 1
            for (int jj = 0; jj < 17; ++jj) { const int off = part + 8 * jj; const int lr = qi + off; const bool valid = (off <= 128) && (i0 - 128 + lr >= 0);
                if (!valid) continue;
                const LAS f32x4* kr = (const LAS f32x4*)(Ks + lr * 68); float d0 = 0.f;
#pragma unroll
                for (int c = 0; c < 16; ++c) { const f32x4 kv = kr[c]; d0 += q[4 * c] * kv.x + q[4 * c + 1] * kv.y + q[4 * c + 2] * kv.z + q[4 * c + 3] * kv.w; }
                const float mn = fmaxf(m, d0); const float sc = __expf(m - mn), pj = __expf(d0 - mn); m = mn; l = l * sc + pj;
                const LAS f32x4* vr = (const LAS f32x4*)(Vs + lr * 68);
#pragma unroll
                for (int c = 0; c < 16; ++c) { const f32x4 vv = vr[c]; o[4 * c] = o[4 * c] * sc + pj * vv.x; o[4 * c + 1] = o[4 * c + 1] * sc + pj * vv.y; o[4 * c + 2] = o[4 * c + 2] * sc + pj * vv.z; o[4 * c + 3] = o[4 * c + 3] * sc + pj * vv.w; } }
            { float mm = fmaxf(m, __shfl_xor(m, 1)); mm = fmaxf(mm, __shfl_xor(mm, 2)); mm = fmaxf(mm, __shfl_xor(mm, 4));
              const float sc = __expf(m - mm); m = mm; l *= sc;
#pragma unroll
              for (int c = 0; c < 64; ++c) o[c] *= sc; }
            l += __shfl_xor(l, 1); l += __shfl_xor(l, 2); l += __shfl_xor(l, 4);
            float o32[32], o16[16], o8[8];
            { const bool up = (part & 4) != 0;
#pragma unroll
              for (int c = 0; c < 32; ++c) { const float send = up ? o[c] : o[c + 32]; const float recv = __shfl_xor(send, 4); o32[c] = (up ? o[c + 32] : o[c]) + recv; } }
            { const bool up = (part & 2) != 0;
#pragma unroll
              for (int c = 0; c < 16; ++c) { const float send = up ? o32[c] : o32[c + 16]; const float recv = __shfl_xor(send, 2); o16[c] = (up ? o32[c + 16] : o32[c]) + recv; } }
            { const bool up = (part & 1) != 0;
#pragma unroll
              for (int c = 0; c < 8; ++c) { const float send = up ? o16[c] : o16[c + 8]; const float recv = __shfl_xor(send, 1); o8[c] = (up ? o16[c + 8] : o16[c]) + recv; } }
            const float il = 1.0f / l; const size_t trow = (size_t)(b * SEQ + tq);
            v4u w; w.x = pk2(o8[0] * il, o8[1] * il); w.y = pk2(o8[2] * il, o8[3] * il); w.z = pk2(o8[4] * il, o8[5] * il); w.w = pk2(o8[6] * il, o8[7] * il);
            *(GAS v4u*)(OG + ((size_t)g * T + trow) * 256 + h * 64 + 8 * part) = w;
            if (part == 0) LSE[((size_t)g * T + trow) * 4 + h] = m + __logf(l);
            __syncthreads();
        }
        if (BOTH(PH_ATT)) GRID_BAR();
    }

    if (IN(PH_PREP)) {
        {
            const bf16* const OG = (const bf16*)(ws + WS_OG); const float* const LSE = (const float*)(ws + WS_LSE); bf16* const OA = (bf16*)(ws + WS_OA);
            for (int i = gt; i < T * 32; i += NGT) { const int t = i >> 5, h = (i >> 3) & 3, c8 = i & 7;
                const float l0 = LSE[((size_t)0 * T + t) * 4 + h], l1 = LSE[((size_t)1 * T + t) * 4 + h], l2 = LSE[((size_t)2 * T + t) * 4 + h];
                const float mx = fmaxf(l0, fmaxf(l1, l2)); const float e0 = __expf(l0 - mx), e1 = __expf(l1 - mx), e2 = __expf(l2 - mx); const float inv = 1.0f / (e0 + e1 + e2);
                const float a0 = e0 * inv, a1 = e1 * inv, a2 = e2 * inv;
                const v4u x0 = *(const GAS v4u*)(OG + ((size_t)0 * T + t) * 256 + h * 64 + 8 * c8), x1 = *(const GAS v4u*)(OG + ((size_t)1 * T + t) * 256 + h * 64 + 8 * c8), x2 = *(const GAS v4u*)(OG + ((size_t)2 * T + t) * 256 + h * 64 + 8 * c8);
                v4u w;
                w.x = pk2(a0 * bflo(x0.x) + a1 * bflo(x1.x) + a2 * bflo(x2.x), a0 * bfhi(x0.x) + a1 * bfhi(x1.x) + a2 * bfhi(x2.x));
                w.y = pk2(a0 * bflo(x0.y) + a1 * bflo(x1.y) + a2 * bflo(x2.y), a0 * bfhi(x0.y) + a1 * bfhi(x1.y) + a2 * bfhi(x2.y));
                w.z = pk2(a0 * bflo(x0.z) + a1 * bflo(x1.z) + a2 * bflo(x2.z), a0 * bfhi(x0.z) + a1 * bfhi(x1.z) + a2 * bfhi(x2.z));
                w.w = pk2(a0 * bflo(x0.w) + a1 * bflo(x1.w) + a2 * bflo(x2.w), a0 * bfhi(x0.w) + a1 * bfhi(x1.w) + a2 * bfhi(x2.w));
                *(GAS v4u*)(OA + (size_t)t * 256 + h * 64 + 8 * c8) = w; }
        }
        {
            const float* const mu = args.in[4]; const float* const w0 = args.in[5]; const float* const w2 = args.in[6]; const float* const a0 = args.in[7];
            const float* const a2 = args.in[8]; const float* const g2 = args.in[9]; const float* const k_k = args.in[10]; const float* const k_a = args.in[11]; const float* const r_k = args.in[12];
            bf16* const Rb = (bf16*)(ws + WS_R); bf16* const Kb = (bf16*)(ws + WS_KP); bf16* const Vb = (bf16*)(ws + WS_V); bf16* const AVb = (bf16*)(ws + WS_AV);
            float* const DEC = (float*)((unsigned char*)out + DO_DEC);   bf16* const BVb = (bf16*)((unsigned char*)out + DO_BV); bf16* const GTb = (bf16*)((unsigned char*)out + DO_GT);
            float* const BONUS = (float*)(ws + WS_BONUS);
            const int c = tid;
            float w2c[32], a2c[32]; unsigned g2c[48];
#pragma unroll
            for (int j = 0; j < 32; ++j) { w2c[j] = w2[j * RW + c]; a2c[j] = a2[j * RW + c]; }
#pragma unroll
            for (int j = 0; j < 48; ++j) g2c[j] = pk2(g2[(2 * j) * RW + c], g2[(2 * j + 1) * RW + c]);
            const float mu_r = mu[c], mu_k = mu[512 + c], mu_v = mu[1024 + c], w0c = w0[c], a0c = a0[c], kkc = k_k[c], kac = k_a[c], rkc = r_k[c];
            LAS float* L = (LAS float*)(lds + RING_OFF);
            for (int tile = vcu; tile < T / 16; tile += G) {
                const int t0 = tile * 16;
                for (int idx = tid; idx < 16 * 160; idx += 512) { const int tok = idx / 160, j = idx - tok * 160, t = t0 + tok;
                    const float z = bf2f(ZR[(size_t)t * ZR_LD + 1536 + j]); const float zp = ((t & (SEQ - 1)) == 0) ? 0.f : bf2f(ZR[(size_t)(t - 1) * ZR_LD + 1536 + j]);
                    const float xx = z + (zp - z) * mu[1536 + j];
                    L[idx] = (j < 32) ? tanhf(xx) : (j < 64) ? xx : sigmoidf_(xx); }
                __syncthreads();
                float pr = 0.f, pk = 0.f, pv = 0.f;
                if ((t0 & (SEQ - 1)) != 0) { const bf16* zp = ZR + (size_t)(t0 - 1) * ZR_LD; pr = bf2f(zp[c]); pk = bf2f(zp[512 + c]); pv = bf2f(zp[1024 + c]); }
                for (int tok = 0; tok < 16; ++tok) { const int t = t0 + tok; const bf16* zc = ZR + (size_t)t * ZR_LD;
                    const float zr = bf2f(zc[c]), zk = bf2f(zc[512 + c]), zv = bf2f(zc[1024 + c]);
                    const float r = zr + (pr - zr) * mu_r; float k = zk + (pk - zk) * mu_k; const float v = zv + (pv - zv) * mu_v; pr = zr; pk = zk; pv = zv;
                    const LAS f32x4* Lt = (const LAS f32x4*)(L + tok * 160);
                    float wl = 0.f, al = 0.f, gl = 0.f;
#pragma unroll
                    for (int j = 0; j < 8; ++j) { const f32x4 a = Lt[j]; wl += a.x * w2c[4 * j] + a.y * w2c[4 * j + 1] + a.z * w2c[4 * j + 2] + a.w * w2c[4 * j + 3]; }
#pragma unroll
                    for (int j = 0; j < 8; ++j) { const f32x4 a = Lt[8 + j]; al += a.x * a2c[4 * j] + a.y * a2c[4 * j + 1] + a.z * a2c[4 * j + 2] + a.w * a2c[4 * j + 3]; }
#pragma unroll
                    for (int j = 0; j < 24; ++j) { const f32x4 a = Lt[16 + j]; gl += a.x * bflo(g2c[2 * j]) + a.y * bfhi(g2c[2 * j]) + a.z * bflo(g2c[2 * j + 1]) + a.w * bfhi(g2c[2 * j + 1]); }
                    const float wv = w0c + wl; const float nx = -wv;
                    const float sp = fmaxf(nx, 0.f) + log1pf(__expf(-fabsf(nx)));
                    const float dec = -__expf(-sp - 0.5f);
                    const float a = sigmoidf_(a0c + al);
                    float kk = k * kkc; const float ss = wave_sum(kk * kk); kk = kk / fmaxf(sqrtf(ss), 1e-12f);
                    k = k * (1.0f + (a - 1.0f) * kac);
                    const float bon = wave_sum(r * k * rkc);
                    const size_t o = (size_t)t * RW + c;
                    Rb[o] = (bf16)f2bf(r); Kb[o] = (bf16)f2bf(k); Vb[o] = (bf16)f2bf(v); AVb[o] = (bf16)f2bf(-kk); BVb[o] = (bf16)f2bf(kk * a); GTb[o] = (bf16)f2bf(gl); DEC[o] = dec;
                    if (lane == 0) BONUS[(size_t)t * 8 + wave] = bon;
                }
                __syncthreads();
            }
        }
        if (BOTH(PH_PREP)) GRID_BAR();
    }

    if (IN(PH_CHUNK)) {
        constexpr int LS = 72, FS = 68;
        bf16* const Rb = (bf16*)(ws + WS_R); bf16* const Kb = (bf16*)(ws + WS_KP); const bf16* const Vb = (const bf16*)(ws + WS_V); bf16* const AVb = (bf16*)(ws + WS_AV);
        float* const LW = (float*)((unsigned char*)out + DO_DEC); bf16* const BVb = (bf16*)((unsigned char*)out + DO_BV);
        bf16* const YLT = (bf16*)(ws + WS_YLT); float* const GC = (float*)(ws + WS_GC);
        LAS bf16* const At = (LAS bf16*)(lds + 0); LAS bf16* const Rt = (LAS bf16*)(lds + 9216); LAS bf16* const Bt = (LAS bf16*)(lds + 18432); LAS bf16* const Kt = (LAS bf16*)(lds + 27648);
        LAS bf16* const VmT = (LAS bf16*)(lds + 36864); LAS bf16* const KhT = (LAS bf16*)(lds + 46080); LAS bf16* const Lak = (LAS bf16*)(lds + 55296); LAS bf16* const Mrb = (LAS bf16*)(lds + 64512);
        LAS bf16* const Mrk = (LAS bf16*)(lds + 73728); LAS bf16* const BhT = (LAS bf16*)(lds + 82944); LAS float* const LabF = (LAS float*)(lds + 92160); LAS float* const X1F = (LAS float*)(lds + 109568);
        LAS bf16* const ApT = Bt; LAS bf16* const WT2 = Kt; LAS float* const cum = X1F;
        const int lr = lane & 15, lq = lane >> 4;
        for (int unit = vcu; unit < BATCH * 8 * (SEQ / 64); unit += G) {
            const int ch = unit & 127, h = (unit >> 7) & 7, b = unit >> 10;
            const size_t t0 = (size_t)b * SEQ + (size_t)ch * 64;
            const int c = tid >> 3, kq = tid & 7;
            const size_t goff = (t0 + c) * RW + h * 64 + kq * 8;
            const v4u r8 = *(const GAS v4u*)(Rb + goff), k8 = *(const GAS v4u*)(Kb + goff), v8 = *(const GAS v4u*)(Vb + goff), a8 = *(const GAS v4u*)(AVb + goff), b8 = *(const GAS v4u*)(BVb + goff);
            const f32x4 lw0 = *(const GAS f32x4*)(LW + goff), lw1 = *(const GAS f32x4*)(LW + goff + 4);
            float lwv[8] = {lw0.x, lw0.y, lw0.z, lw0.w, lw1.x, lw1.y, lw1.z, lw1.w};
#pragma unroll
            for (int i = 0; i < 8; ++i) cum[c * 65 + kq * 8 + i] = lwv[i];
            __syncthreads();
#pragma unroll
            for (int i = 0; i < 8; ++i) { const int chn = 8 * wave + i; float xx = cum[lane * 65 + chn];
#pragma unroll
                for (int o = 1; o < 64; o <<= 1) { const float yy = __shfl_up(xx, o); if (lane >= o) xx += yy; }
                cum[lane * 65 + chn] = xx; }
            __syncthreads();
            {
                float rr[8], kk8[8], vv[8], aa[8], bb[8];
                rr[0] = bflo(r8.x); rr[1] = bfhi(r8.x); rr[2] = bflo(r8.y); rr[3] = bfhi(r8.y); rr[4] = bflo(r8.z); rr[5] = bfhi(r8.z); rr[6] = bflo(r8.w); rr[7] = bfhi(r8.w);
                kk8[0] = bflo(k8.x); kk8[1] = bfhi(k8.x); kk8[2] = bflo(k8.y); kk8[3] = bfhi(k8.y); kk8[4] = bflo(k8.z); kk8[5] = bfhi(k8.z); kk8[6] = bflo(k8.w); kk8[7] = bfhi(k8.w);
                vv[0] = bflo(v8.x); vv[1] = bfhi(v8.x); vv[2] = bflo(v8.y); vv[3] = bfhi(v8.y); vv[4] = bflo(v8.z); vv[5] = bfhi(v8.z); vv[6] = bflo(v8.w); vv[7] = bfhi(v8.w);
                aa[0] = bflo(a8.x); aa[1] = bfhi(a8.x); aa[2] = bflo(a8.y); aa[3] = bfhi(a8.y); aa[4] = bflo(a8.z); aa[5] = bfhi(a8.z); aa[6] = bflo(a8.w); aa[7] = bfhi(a8.w);
                bb[0] = bflo(b8.x); bb[1] = bfhi(b8.x); bb[2] = bflo(b8.y); bb[3] = bfhi(b8.y); bb[4] = bflo(b8.z); bb[5] = bfhi(b8.z); bb[6] = bflo(b8.w); bb[7] = bfhi(b8.w);
                float at[8], rt[8], bt[8], kt[8];
#pragma unroll
                for (int i = 0; i < 8; ++i) { const float cu = cum[c * 65 + kq * 8 + i], cC = cum[63 * 65 + kq * 8 + i];
                    const float ep = __expf(cu), em = __expf(-cu), epv = __expf(cu - lwv[i]), eh = __expf(cC - cu);
                    at[i] = aa[i] * epv; rt[i] = rr[i] * ep; bt[i] = bb[i] * em; kt[i] = kk8[i] * em;
                    const int kk_ = kq * 8 + i;
                    VmT[kk_ * LS + c] = (bf16)f2bf(vv[i]); KhT[kk_ * LS + c] = (bf16)f2bf(kk8[i] * eh); BhT[kk_ * LS + c] = (bf16)f2bf(bb[i] * eh);
                    if (c == 63) GC[(size_t)unit * 64 + kk_] = __expf(cC); }
                *(LAS v4u*)(At + c * LS + kq * 8) = (v4u){pk2(at[0], at[1]), pk2(at[2], at[3]), pk2(at[4], at[5]), pk2(at[6], at[7])};
                *(LAS v4u*)(Rt + c * LS + kq * 8) = (v4u){pk2(rt[0], rt[1]), pk2(rt[2], rt[3]), pk2(rt[4], rt[5]), pk2(rt[6], rt[7])};
                *(LAS v4u*)(Bt + c * LS + kq * 8) = (v4u){pk2(bt[0], bt[1]), pk2(bt[2], bt[3]), pk2(bt[4], bt[5]), pk2(bt[6], bt[7])};
                *(LAS v4u*)(Kt + c * LS + kq * 8) = (v4u){pk2(kt[0], kt[1]), pk2(kt[2], kt[3]), pk2(kt[4], kt[5]), pk2(kt[6], kt[7])};
            }
            __syncthreads();
            {
                const int p = wave >> 1; const LAS bf16* Ab = (p < 2) ? At : Rt; const LAS bf16* Bb = (p & 1) ? Kt : Bt;
                LAS bf16* dstb = (p == 1) ? Lak : (p == 2) ? Mrb : Mrk;
#pragma unroll 1
                for (int tl = (wave & 1) * 8; tl < (wave & 1) * 8 + 8; ++tl) { const int mt = tl >> 2, nt = tl & 3;
                    f32x4 acc = {0.f, 0.f, 0.f, 0.f};
                    if (nt <= mt) {
#pragma unroll
                        for (int ks = 0; ks < 2; ++ks) { const bf16x8 a = *(const LAS bf16x8*)(Ab + (16 * mt + lr) * LS + 32 * ks + 8 * lq), bq = *(const LAS bf16x8*)(Bb + (16 * nt + lr) * LS + 32 * ks + 8 * lq);
                            acc = __builtin_amdgcn_mfma_f32_16x16x32_bf16(a, bq, acc, 0, 0, 0); } }
                    const int col = 16 * nt + lr;
#pragma unroll
                    for (int i = 0; i < 4; ++i) { const int row = 16 * mt + 4 * lq + i; const bool keep = (p < 2) ? (col < row) : (col <= row); const float val = keep ? acc[i] : 0.f;
                        if (p == 0) LabF[row * FS + (col & 3) * 16 + (col >> 2)] = val; else dstb[row * LS + col] = (bf16)f2bf(val); } }
            }
            __syncthreads();
#pragma unroll 1
            for (int tl = wave * 2; tl < wave * 2 + 2; ++tl) { const int mt = tl >> 2, nt = tl & 3; f32x4 acc = {0.f, 0.f, 0.f, 0.f};
#pragma unroll
                for (int ks = 0; ks < 2; ++ks) { const bf16x8 a = *(const LAS bf16x8*)(Lak + (16 * mt + lr) * LS + 32 * ks + 8 * lq), bq = *(const LAS bf16x8*)(VmT + (16 * nt + lr) * LS + 32 * ks + 8 * lq);
                    acc = __builtin_amdgcn_mfma_f32_16x16x32_bf16(a, bq, acc, 0, 0, 0); }
#pragma unroll
                for (int i = 0; i < 4; ++i) X1F[(16 * mt + 4 * lq + i) * FS + 16 * nt + lr] = acc[i]; }
            __syncthreads();
            {
                const int jl = lane & 15, part = lane >> 4, j = 16 * (wave & 3) + jl;
                float xp[16];
                if (wave < 4) {
#pragma unroll
                    for (int m = 0; m < 16; ++m) xp[m] = bf2f(At[(4 * m + part) * LS + j]);
                } else {
#pragma unroll
                    for (int m = 0; m < 16; ++m) xp[m] = X1F[(4 * m + part) * FS + j];
                }
                int lpo = part * 16;
#pragma unroll
                for (int t = 1; t < 64; ++t) { const int tm = t >> 2, tp = t & 3; float sum = 0.f;
#pragma unroll
                    for (int m4 = 0; m4 <= tm / 4; ++m4) { const f32x4 L4 = *(const LAS f32x4*)(LabF + lpo + t * FS + 4 * m4);
                        sum += L4.x * xp[4 * m4]; if (4 * m4 + 1 <= tm) sum += L4.y * xp[4 * m4 + 1]; if (4 * m4 + 2 <= tm) sum += L4.z * xp[4 * m4 + 2]; if (4 * m4 + 3 <= tm) sum += L4.w * xp[4 * m4 + 3]; }
                    sum += __shfl_xor(sum, 16); sum += __shfl_xor(sum, 32);
                    xp[tm] = (part == tp) ? xp[tm] + sum : xp[tm]; asm volatile("" : "+v"(lpo) : "v"(xp[tm])); }
                LAS bf16* dl = (wave < 4) ? ApT : WT2;
#pragma unroll
                for (int m = 0; m < 16; ++m) dl[j * LS + 4 * m + part] = (bf16)f2bf(xp[m]);
            }
            __syncthreads();
#pragma unroll 1
            for (int tl = wave * 6; tl < wave * 6 + 6; ++tl) { const int kind = tl >> 4, mt = (tl >> 2) & 3, nt = tl & 3; f32x4 acc = {0.f, 0.f, 0.f, 0.f};
                if (kind == 0) {
#pragma unroll
                    for (int ks = 0; ks < 2; ++ks) { const bf16x8 a = *(const LAS bf16x8*)(Mrb + (16 * mt + lr) * LS + 32 * ks + 8 * lq), bq = *(const LAS bf16x8*)(ApT + (16 * nt + lr) * LS + 32 * ks + 8 * lq);
                        acc = __builtin_amdgcn_mfma_f32_16x16x32_bf16(a, bq, acc, 0, 0, 0); }
#pragma unroll
                    for (int i = 0; i < 4; ++i) { const int row = 16 * mt + 4 * lq + i, col = 16 * nt + lr; Kb[(t0 + row) * RW + h * 64 + col] = (bf16)f2bf(acc[i] + bf2f(Rt[row * LS + col])); }
                } else if (kind == 1) {
#pragma unroll
                    for (int ks = 0; ks < 2; ++ks) { const bf16x8 a = *(const LAS bf16x8*)(Mrb + (16 * mt + lr) * LS + 32 * ks + 8 * lq), bq = *(const LAS bf16x8*)(WT2 + (16 * nt + lr) * LS + 32 * ks + 8 * lq);
                        acc = __builtin_amdgcn_mfma_f32_16x16x32_bf16(a, bq, acc, 0, 0, 0);
                        const bf16x8 a2 = *(const LAS bf16x8*)(Mrk + (16 * mt + lr) * LS + 32 * ks + 8 * lq), b2 = *(const LAS bf16x8*)(VmT + (16 * nt + lr) * LS + 32 * ks + 8 * lq);
                        acc = __builtin_amdgcn_mfma_f32_16x16x32_bf16(a2, b2, acc, 0, 0, 0); }
                    *(GAS unsigned long long*)(YLT + (t0 + 16 * nt + lr) * RW + h * 64 + 16 * mt + 4 * lq) = (unsigned long long)pk2(acc[0], acc[1]) | ((unsigned long long)pk2(acc[2], acc[3]) << 32);
                } else {
#pragma unroll
                    for (int ks = 0; ks < 2; ++ks) { const bf16x8 a = *(const LAS bf16x8*)(VmT + (16 * mt + lr) * LS + 32 * ks + 8 * lq), bq = *(const LAS bf16x8*)(KhT + (16 * nt + lr) * LS + 32 * ks + 8 * lq);
                        acc = __builtin_amdgcn_mfma_f32_16x16x32_bf16(a, bq, acc, 0, 0, 0); }
                    *(GAS unsigned long long*)((bf16*)(LW + (t0 + 16 * nt + lr) * RW + h * 64) + 16 * mt + 4 * lq) = (unsigned long long)pk2(acc[0], acc[1]) | ((unsigned long long)pk2(acc[2], acc[3]) << 32);
                } }
            *(GAS v4u*)(AVb + (t0 + c) * RW + h * 64 + kq * 8) = *(const LAS v4u*)(BhT + c * LS + kq * 8);
            *(GAS v4u*)(BVb + (t0 + c) * RW + h * 64 + kq * 8) = *(const LAS v4u*)(WT2 + c * LS + kq * 8);
            { unsigned short e[8];
#pragma unroll
              for (int i = 0; i < 8; ++i) e[i] = ApT[(kq * 8 + i) * LS + c];
              *(GAS v4u*)(Rb + (t0 + c) * RW + h * 64 + kq * 8) = (v4u){(unsigned)e[0] | ((unsigned)e[1] << 16), (unsigned)e[2] | ((unsigned)e[3] << 16), (unsigned)e[4] | ((unsigned)e[5] << 16), (unsigned)e[6] | ((unsigned)e[7] << 16)}; }
            __syncthreads();
        }
        if (BOTH(PH_CHUNK)) GRID_BAR();
    }

    if (IN(PH_SEQ)) {
        if (vcu < BATCH * 8) {
            constexpr int LS = 72; constexpr int BUFB = 56320;
            const bf16* const APg = (const bf16*)(ws + WS_R); const bf16* const RPg = (const bf16*)(ws + WS_KP); const bf16* const BHg = (const bf16*)(ws + WS_AV);
            const bf16* const WTg = (const bf16*)((unsigned char*)out + DO_BV); const float* const GTg = (const float*)((unsigned char*)out + DO_DEC);
            const bf16* const YLT = (const bf16*)(ws + WS_YLT); const float* const GC = (const float*)(ws + WS_GC);
            float* const Y = (float*)(ws + WS_Y);
            const int b = vcu >> 3, h = vcu & 7;
            LAS bf16* const Sbf = (LAS bf16*)(lds + 2 * BUFB); LAS bf16* const UT = (LAS bf16*)(lds + 2 * BUFB + 9216);
            const int row = tid >> 3, piece = tid & 7, lr = lane & 15, lq = lane >> 4, q = wave;
            for (int i = tid; i < 9216 / 4; i += 512) ((LAS unsigned*)Sbf)[i] = 0u;
            f32x4 st[4];
#pragma unroll
            for (int kt = 0; kt < 4; ++kt) st[kt] = (f32x4){0.f, 0.f, 0.f, 0.f};
            v4u pre[6]; v4u pgc = {0u, 0u, 0u, 0u};
#define SEQ_LOAD(ck) do { const size_t go = ((size_t)b * SEQ + (size_t)(ck) * 64 + row) * RW + h * 64 + piece * 8; \
        pre[0] = *(const GAS v4u*)(APg + go); pre[1] = *(const GAS v4u*)(RPg + go); pre[2] = *(const GAS v4u*)(BHg + go); pre[3] = *(const GAS v4u*)(WTg + go); pre[4] = *(const GAS v4u*)(YLT + go); \
        pre[5] = *(const GAS v4u*)((const bf16*)(GTg + ((size_t)b * SEQ + (size_t)(ck) * 64 + row) * RW + h * 64) + piece * 8); \
        if (tid < 16) pgc = *(const GAS v4u*)(GC + ((size_t)((b * 8 + h) * 128 + (ck))) * 64 + tid * 4); } while (0)
#define SEQ_STORE(bi) do { LAS unsigned char* bb_ = lds + (bi) * BUFB; _Pragma("unroll") for (int a_ = 0; a_ < 6; ++a_) *(LAS v4u*)(bb_ + a_ * 9216 + (row * LS + piece * 8) * 2) = pre[a_]; \
        if (tid < 16) *(LAS v4u*)(bb_ + 55296 + tid * 16) = pgc; } while (0)
            SEQ_LOAD(0); SEQ_STORE(0); __syncthreads();
            for (int ck = 0; ck < SEQ / 64; ++ck) {
                if (ck + 1 < SEQ / 64) SEQ_LOAD(ck + 1);
                if (wave < 4) {
                    const LAS unsigned char* bb = lds + (ck & 1) * BUFB;
                    const LAS bf16* AP = (const LAS bf16*)(bb); const LAS bf16* RP = (const LAS bf16*)(bb + 9216); const LAS bf16* BH = (const LAS bf16*)(bb + 18432);
                    const LAS bf16* WT = (const LAS bf16*)(bb + 27648); const LAS bf16* YL = (const LAS bf16*)(bb + 36864); const LAS bf16* GT = (const LAS bf16*)(bb + 46080);
                    const LAS float* GCl = (const LAS float*)(bb + 55296);
                    const bf16x8 s0 = *(const LAS bf16x8*)(Sbf + (16 * q + lr) * LS + 8 * lq), s1 = *(const LAS bf16x8*)(Sbf + (16 * q + lr) * LS + 32 + 8 * lq);
                    f32x4 u[4], y[4];
#pragma unroll
                    for (int ct = 0; ct < 4; ++ct) {
                        const v2u w4 = *(const LAS v2u*)(WT + (16 * q + lr) * LS + 16 * ct + 4 * lq), y4 = *(const LAS v2u*)(YL + (16 * q + lr) * LS + 16 * ct + 4 * lq);
                        u[ct] = (f32x4){bflo(w4.x), bfhi(w4.x), bflo(w4.y), bfhi(w4.y)}; y[ct] = (f32x4){bflo(y4.x), bfhi(y4.x), bflo(y4.y), bfhi(y4.y)};
                        const bf16x8 a0 = *(const LAS bf16x8*)(AP + (16 * ct + lr) * LS + 8 * lq), a1 = *(const LAS bf16x8*)(AP + (16 * ct + lr) * LS + 32 + 8 * lq);
                        const bf16x8 r0 = *(const LAS bf16x8*)(RP + (16 * ct + lr) * LS + 8 * lq), r1 = *(const LAS bf16x8*)(RP + (16 * ct + lr) * LS + 32 + 8 * lq);
                        u[ct] = __builtin_amdgcn_mfma_f32_16x16x32_bf16(a0, s0, u[ct], 0, 0, 0); u[ct] = __builtin_amdgcn_mfma_f32_16x16x32_bf16(a1, s1, u[ct], 0, 0, 0);
                        y[ct] = __builtin_amdgcn_mfma_f32_16x16x32_bf16(r0, s0, y[ct], 0, 0, 0); y[ct] = __builtin_amdgcn_mfma_f32_16x16x32_bf16(r1, s1, y[ct], 0, 0, 0);
                    }
#pragma unroll
                    for (int ct = 0; ct < 4; ++ct) {
                        *(LAS v2u*)(UT + (16 * q + lr) * LS + 16 * ct + 4 * lq) = (v2u){pk2(u[ct][0], u[ct][1]), pk2(u[ct][2], u[ct][3])};
#pragma unroll
                        for (int i = 0; i < 4; ++i) Y[((size_t)b * SEQ + (size_t)ck * 64 + 16 * ct + 4 * lq + i) * RW + h * 64 + 16 * q + lr] = y[ct][i];
                    }
                    const bf16x8 ua = *(const LAS bf16x8*)(UT + (16 * q + lr) * LS + 8 * lq), ub = *(const LAS bf16x8*)(UT + (16 * q + lr) * LS + 32 + 8 * lq);
#pragma unroll
                    for (int kt = 0; kt < 4; ++kt) {
                        const v2u g4 = *(const LAS v2u*)(GT + (16 * kt + lr) * LS + 16 * q + 4 * lq); const float gam = GCl[16 * kt + lr];
                        st[kt] = st[kt] * gam + (f32x4){bflo(g4.x), bfhi(g4.x), bflo(g4.y), bfhi(g4.y)};
                        const bf16x8 b0 = *(const LAS bf16x8*)(BH + (16 * kt + lr) * LS + 8 * lq), b1 = *(const LAS bf16x8*)(BH + (16 * kt + lr) * LS + 32 + 8 * lq);
                        st[kt] = __builtin_amdgcn_mfma_f32_16x16x32_bf16(ua, b0, st[kt], 0, 0, 0); st[kt] = __builtin_amdgcn_mfma_f32_16x16x32_bf16(ub, b1, st[kt], 0, 0, 0);
#pragma unroll
                        for (int i = 0; i < 4; ++i) Sbf[(16 * q + 4 * lq + i) * LS + 16 * kt + lr] = (bf16)f2bf(st[kt][i]);
                    }
                }
                if (ck + 1 < SEQ / 64) SEQ_STORE((ck + 1) & 1);
                __syncthreads();
            }
#undef SEQ_LOAD
#undef SEQ_STORE
        }
        if (BOTH(PH_SEQ)) GRID_BAR();
    }

    if (IN(PH_POST)) {
        const float* const Y = (const float*)(ws + WS_Y); const bf16* const Vb = (const bf16*)(ws + WS_V); const bf16* const GTb = (const bf16*)((unsigned char*)out + DO_GT);
        const float* const BONUS = (const float*)(ws + WS_BONUS); bf16* const ORW = (bf16*)(ws + WS_ORW);
        const float lnw = args.in[13][tid], lnb = args.in[14][tid];
        for (int t = vcu; t < T; t += G) { const size_t o = (size_t)t * RW + tid;
            const float y = Y[o]; const float mean = wave_sum(y) * (1.f / 64.f); const float dy = y - mean; const float var = wave_sum(dy * dy) * (1.f / 64.f);
            const float yn = dy * (1.f / sqrtf(var + GN_EPS)) * lnw + lnb;
            const float res = (yn + BONUS[(size_t)t * 8 + wave] * bf2f(Vb[o])) * bf2f(GTb[o]);
            ORW[o] = (bf16)f2bf(res); }
        if (BOTH(PH_POST)) GRID_BAR();
    }

    if (IN(PH_UPA)) {
        pg8::Gemm g{(const bf16*)(ws + WS_OA), WauT, T, D, 256}; pg8::StaticOrder S; S.init(T, D, G, (int)blockIdx.x);
        pg8::EpiGateF32 E{out, ZG, ZG_LD, 0};
        pg8::gemm_phase<pg8::EpiGateF32, pg8::StaticOrder, PG8_ALIGN, PG8_SP2>(lds + RING_OFF, g, S, E);
        if (BOTH(PH_UPA)) GRID_BAR();
    }
    if (IN(PH_UPR)) {
        pg8::Gemm g{(const bf16*)(ws + WS_ORW), WruT, T, D, 512}; pg8::StaticOrder S; S.init(T, D, G, (int)blockIdx.x);
        pg8::EpiMerge E{out, ZG, ZG_LD, 1024, (bf16*)(ws + WS_M1)};
        pg8::gemm_phase<pg8::EpiMerge, pg8::StaticOrder, PG8_ALIGN, PG8_SP2>(lds + RING_OFF, g, S, E);
        if (BOTH(PH_UPR)) GRID_BAR();
    }
    if (IN(PH_WO)) {
        pg8::Gemm g{(const bf16*)(ws + WS_M1), WoT, T, D, D}; pg8::StaticOrder S; S.init(T, D, G, (int)blockIdx.x);
        pg8::EpiF32<0> E{(float*)(ws + WS_TMP2A)};
        pg8::gemm_phase<pg8::EpiF32<0>, pg8::StaticOrder, PG8_ALIGN, PG8_SP2>(lds + RING_OFF, g, S, E);
        if (BOTH(PH_WO)) GRID_BAR();
    }
    if (IN(PH_ROWA)) {
        const float* const tmp = (const float*)(ws + WS_TMP2A); const float* const g1 = args.in[18]; const float* const g2 = args.in[19];
        for (int m = gw; m < T; m += NGW) {
            const GAS f32x4* tr = (const GAS f32x4*)(tmp + (size_t)m * D) + lane; const GAS f32x4* xr = (const GAS f32x4*)(x + (size_t)m * D) + lane;
            f32x4 v[4]; float s = 0.f;
#pragma unroll
            for (int j = 0; j < 4; ++j) { v[j] = tr[64 * j]; s += (v[j].x * v[j].x + v[j].y * v[j].y) + (v[j].z * v[j].z + v[j].w * v[j].w); }
            const float rs = 1.f / sqrtf(wave_sum(s) * (1.f / D) + NORM_EPS); float s2 = 0.f;
#pragma unroll
            for (int j = 0; j < 4; ++j) { const f32x4 gg = ((const GAS f32x4*)g1)[lane + 64 * j]; const f32x4 xx = xr[64 * j];
                v[j].x = xx.x + v[j].x * rs * gg.x; v[j].y = xx.y + v[j].y * rs * gg.y; v[j].z = xx.z + v[j].z * rs * gg.z; v[j].w = xx.w + v[j].w * rs * gg.w;
                ((GAS f32x4*)(out + (size_t)m * D))[lane + 64 * j] = v[j];
                s2 += (v[j].x * v[j].x + v[j].y * v[j].y) + (v[j].z * v[j].z + v[j].w * v[j].w); }
            const float rs2 = 1.f / sqrtf(wave_sum(s2) * (1.f / D) + NORM_EPS);
            GAS unsigned long long* o8 = (GAS unsigned long long*)(XN + (size_t)m * D) + lane;
#pragma unroll
            for (int j = 0; j < 4; ++j) { const f32x4 gg = ((const GAS f32x4*)g2)[lane + 64 * j];
                o8[64 * j] = (unsigned long long)pk2(v[j].x * rs2 * gg.x, v[j].y * rs2 * gg.y) | ((unsigned long long)pk2(v[j].z * rs2 * gg.z, v[j].w * rs2 * gg.w) << 32); }
        }
        if (BOTH(PH_ROWA)) GRID_BAR();
    }
    if (IN(PH_FFI)) {
        pg8::Gemm g{XN, WfiT, T, FF, D}; pg8::StaticOrder S; S.init(T, FF, G, (int)blockIdx.x);
        pg8::EpiRelu2 E{(bf16*)(ws + WS_H)};
        pg8::gemm_phase<pg8::EpiRelu2, pg8::StaticOrder, PG8_ALIGN, PG8_SP2>(lds + RING_OFF, g, S, E);
        if (BOTH(PH_FFI)) GRID_BAR();
    }
    if (IN(PH_FFO)) {
        pg8::Gemm g{(const bf16*)(ws + WS_H), WfoT, T, D, FF}; pg8::StaticOrder S; S.init(T, D, G, (int)blockIdx.x);
        pg8::EpiF32<0> E{(float*)(ws + WS_TMP2B)};
        pg8::gemm_phase<pg8::EpiF32<0>, pg8::StaticOrder, PG8_ALIGN, PG8_SP2>(lds + RING_OFF, g, S, E);
        if (BOTH(PH_FFO)) GRID_BAR();
    }
    if (IN(PH_ROWB)) {
        const float* const tmp = (const float*)(ws + WS_TMP2B); const float* const g1 = args.in[22];
        for (int m = gw; m < T; m += NGW) {
            const GAS f32x4* tr = (const GAS f32x4*)(tmp + (size_t)m * D) + lane; GAS f32x4* hr = (GAS f32x4*)(out + (size_t)m * D) + lane;
            f32x4 v[4]; float s = 0.f;
#pragma unroll
            for (int j = 0; j < 4; ++j) { v[j] = tr[64 * j]; s += (v[j].x * v[j].x + v[j].y * v[j].y) + (v[j].z * v[j].z + v[j].w * v[j].w); }
            const float rs = 1.f / sqrtf(wave_sum(s) * (1.f / D) + NORM_EPS);
            GAS unsigned long long* o8 = (GAS unsigned long long*)(XN + (size_t)m * D) + lane;
#pragma unroll
            for (int j = 0; j < 4; ++j) { const f32x4 gg = ((const GAS f32x4*)g1)[lane + 64 * j]; const f32x4 hh = hr[64 * j];
                v[j].x = hh.x + v[j].x * rs * gg.x; v[j].y = hh.y + v[j].y * rs * gg.y; v[j].z = hh.z + v[j].z * rs * gg.z; v[j].w = hh.w + v[j].w * rs * gg.w;
                hr[64 * j] = v[j];
                o8[64 * j] = (unsigned long long)pk2(v[j].x, v[j].y) | ((unsigned long long)pk2(v[j].z, v[j].w) << 32); }
        }
        if (BOTH(PH_ROWB)) GRID_BAR();
    }
    if (IN(PH_PLE)) {
        pg8::Gemm g{PB, WpleT, T, D, PLE}; pg8::StaticOrder S; S.init(T, D, G, (int)blockIdx.x);
        pg8::EpiF32<0> E{(float*)(ws + WS_E)};
        pg8::gemm_phase<pg8::EpiF32<0>, pg8::StaticOrder, PG8_ALIGN, PG8_SP2>(lds + RING_OFF, g, S, E);
        if (BOTH(PH_PLE)) GRID_BAR();
    }
    if (IN(PH_PLEG)) {
        pg8::Gemm g{XN, WpgT, T, D, D}; pg8::StaticOrder S; S.init(T, D, G, (int)blockIdx.x);
        pg8::EpiF32<1> E{(float*)(ws + WS_E)};
        pg8::gemm_phase<pg8::EpiF32<1>, pg8::StaticOrder, PG8_ALIGN, PG8_SP2>(lds + RING_OFF, g, S, E);
        if (BOTH(PH_PLEG)) GRID_BAR();
    }
    if (IN(PH_ROWC)) {
        const float* const tmp = (const float*)(ws + WS_E); const float* const g1 = args.in[25];
        for (int m = gw; m < T; m += NGW) {
            const GAS f32x4* tr = (const GAS f32x4*)(tmp + (size_t)m * D) + lane; GAS f32x4* hr = (GAS f32x4*)(out + (size_t)m * D) + lane;
            f32x4 v[4]; float s = 0.f;
#pragma unroll
            for (int j = 0; j < 4; ++j) { v[j] = tr[64 * j]; s += (v[j].x * v[j].x + v[j].y * v[j].y) + (v[j].z * v[j].z + v[j].w * v[j].w); }
            const float rs = 1.f / sqrtf(wave_sum(s) * (1.f / D) + NORM_EPS);
#pragma unroll
            for (int j = 0; j < 4; ++j) { const f32x4 gg = ((const GAS f32x4*)g1)[lane + 64 * j]; const f32x4 hh = hr[64 * j];
                v[j].x = hh.x + v[j].x * rs * gg.x; v[j].y = hh.y + v[j].y * rs * gg.y; v[j].z = hh.z + v[j].z * rs * gg.z; v[j].w = hh.w + v[j].w * rs * gg.w;
                hr[64 * j] = v[j]; }
        }
    }
#undef IN
#undef BOTH
}

extern "C" void kernel_launch(void* const* d_in, const int* in_sizes, int n_in, void* d_out, int out_size, void* d_ws, size_t ws_size, hipStream_t stream) {
    static int grid = 0;
    if (grid == 0) {
        if (n_in != 26 || in_sizes[0] != T * D || out_size != T * D || ws_size < WS_END) { fprintf(stderr, "kernel_launch: shape/workspace mismatch (n_in %d, in0 %d, out %d, ws %zu)\n", n_in, n_in > 0 ? in_sizes[0] : -1, out_size, ws_size); grid = -1; return; }
        int dev = 0, cus = 0, per_cu = 0;
        if (hipGetDevice(&dev) != hipSuccess || hipDeviceGetAttribute(&cus, hipDeviceAttributeMultiprocessorCount, dev) != hipSuccess) { grid = -1; return; }
        if (hipFuncSetAttribute((const void*)skel_fwd, hipFuncAttributeMaxDynamicSharedMemorySize, LDS_BYTES) != hipSuccess) { fprintf(stderr, "kernel_launch: hipFuncSetAttribute failed\n"); grid = -1; return; }
        if (hipOccupancyMaxActiveBlocksPerMultiprocessor(&per_cu, (const void*)skel_fwd, NWAVES * 64, LDS_BYTES) != hipSuccess || per_cu < 1) { fprintf(stderr, "kernel_launch: occupancy query says %d\n", per_cu); }
        (void)hipGetLastError();
        grid = cus;
    }
    if (grid < 0) return;
    if (hipMemsetAsync((char*)d_ws + WS_CTL, 0, CTL_ZERO_BYTES, stream) != hipSuccess) return;
    Args a{};
    for (int i = 0; i < 26; ++i) a.in[i] = (const float*)d_in[i];
    a.out = (float*)d_out; a.ws = (unsigned char*)d_ws;
#if MK_PER_PHASE
    for (int li = 0; li < N_PHASES; ++li) { a.ph_lo = li; a.ph_hi = li + 1; a.li = li; hipLaunchKernelGGL(skel_fwd, dim3(grid), dim3(NWAVES * 64), LDS_BYTES, stream, a); }
#else
    a.ph_lo = 0; a.ph_hi = N_PHASES; a.li = 0; hipLaunchKernelGGL(skel_fwd, dim3(grid), dim3(NWAVES * 64), LDS_BYTES, stream, a);
#endif
}
```

```cpp
#include <hip/hip_runtime.h>
#include <cstdio>
#include <cstdint>
namespace pg8 {
#define PG8_LAS __attribute__((address_space(3)))
typedef unsigned short bf16_t;
typedef short bf16x8 __attribute__((ext_vector_type(8)));
typedef float f32x4 __attribute__((ext_vector_type(4)));
typedef unsigned u32x4 __attribute__((ext_vector_type(4)));
constexpr int BM = 256, BK = 64, HALF = 128, HTB = HALF * BK * 2  , STAGE_BYTES = 8 * HTB, NXCD = 8, WGM = 8;

__host__ __device__ __forceinline__ int lds_byte(int r, int c) { const int st = (r >> 4) * 2 + (c >> 5), rr = r & 15, cc = c & 31, ob = rr * 64 + cc * 2; return st * 1024 + (ob ^ (((ob >> 9) & 1) << 5)); }
__host__ __device__ __forceinline__ void stage_rc(int b, int& R, int& C) { const int st = b / 1024, sb = b % 1024, swz = sb ^ (((sb >> 9) & 1) << 5); R = (st >> 1) * 16 + swz / 64; C = (st & 1) * 32 + (swz % 64) / 2; }
__host__ __device__ __forceinline__ int perm32(int rho) { const int n = rho >> 4, i = rho & 15; return 8 * (i >> 2) + 4 * n + (i & 3); }

struct Unit { int pm, pn; };
struct Gemm { const bf16_t* A; const bf16_t* Bt; int M, N, K; };

struct StaticOrder {
    int nM, nN, nwg, G, c;
    __host__ __device__ void init(int M, int N, int G_, int c_) { nM = M / BM; nN = N / BM; nwg = nM * nN; G = G_; c = c_; }
    __host__ __device__ bool next(int i, Unit& u) const {
        const long L = (long)i * G + c; if (L >= nwg) return false;
        int wgid = (int)L; { const int q = nwg / NXCD, r = nwg % NXCD, xcd = wgid % NXCD, off = wgid / NXCD; wgid = (xcd < r ? xcd * (q + 1) : r * (q + 1) + (xcd - r) * q) + off; }
        const int nig = WGM * nN, gid = wgid / nig, fm = gid * WGM, gsz = (nM - fm) < WGM ? (nM - fm) : WGM;
        u.pm = fm + ((wgid % nig) % gsz); u.pn = (wgid % nig) / gsz; return true;
    }
    __device__ __forceinline__ void a_ready(const Unit&) const {}
    __device__ __forceinline__ void done(const Unit&) const {}
};

__device__ __forceinline__ unsigned cvt_pk_bf16(float lo, float hi) { unsigned r; asm volatile("v_cvt_pk_bf16_f32 %0, %1, %2" : "=v"(r) : "v"(lo), "v"(hi)); return r; }
typedef float f32x2 __attribute__((ext_vector_type(2)));
__device__ __forceinline__ f32x2 gelu_pk(f32x2 v) {
    const f32x2 av = __builtin_elementwise_abs(v), d = av * 0.2316418882f + 1.0f;
    f32x2 t; t.x = __builtin_amdgcn_rcpf(d.x); t.y = __builtin_amdgcn_rcpf(d.y);
    f32x2 q = t * 0.5307027145f + (-0.7265760135f); q = q * t + 0.7107068705f; q = q * t + (-0.142248368f); q = q * t + 0.127414796f; q = q * t;
    const f32x2 s = (v * v) * (-0.72134752044f);
    f32x2 e; e.x = __builtin_amdgcn_exp2f(s.x); e.y = __builtin_amdgcn_exp2f(s.y);
    const f32x2 m = v * (q * e), r = v - m;
    f32x2 o; o.x = v.x < 0.f ? m.x : r.x; o.y = v.y < 0.f ? m.y : r.y; return o;
}

template <int ACT  > struct EpiBf16 {
    static constexpr bool PERM = true, AFTER_DRAIN = false; static_assert(ACT == 0 || ACT == 1, "EpiBf16: ACT is 0 (none) or 1 (gelu_pk)");
    bf16_t* O; int ldc; const float* bias; int split_cols; size_t split_stride; float scale0;
    __device__ __forceinline__ void operator()(const f32x4 (&acc)[2][2][4][2], const Unit& u, int wr, int wc, int fr, int fq) const {
        const int row0 = u.pm * BM + wr * 64 + fr; int colt = u.pn * BM; bf16_t* base = O;
        float sc = 1.f; if (split_cols) { const int t = colt / split_cols; base += (size_t)t * split_stride; colt -= t * split_cols; if (t == 0) sc = scale0; }
        const int col0 = colt + wc * 32 + 8 * fq, bcol0 = u.pn * BM + wc * 32 + 8 * fq;
        f32x4 bv[2][2];
#pragma unroll
        for (int bj = 0; bj < 2; ++bj)
#pragma unroll
            for (int n = 0; n < 2; ++n) bv[bj][n] = bias ? *(const f32x4*)(bias + bcol0 + bj * HALF + 4 * n) : (f32x4){0.f, 0.f, 0.f, 0.f};
#pragma unroll
        for (int ai = 0; ai < 2; ++ai)
#pragma unroll
            for (int m = 0; m < 4; ++m) { bf16_t* rowp = base + (size_t)(row0 + ai * HALF + m * 16) * ldc + col0;
#pragma unroll
                for (int bj = 0; bj < 2; ++bj) { f32x4 v0 = acc[ai][bj][m][0] + bv[bj][0], v1 = acc[ai][bj][m][1] + bv[bj][1];
                    if (ACT == 1) { f32x2 a = gelu_pk((f32x2){v0[0], v0[1]}), b = gelu_pk((f32x2){v0[2], v0[3]}), c = gelu_pk((f32x2){v1[0], v1[1]}), d = gelu_pk((f32x2){v1[2], v1[3]});
                        v0 = (f32x4){a.x, a.y, b.x, b.y}; v1 = (f32x4){c.x, c.y, d.x, d.y}; }
                    v0 = v0 * sc; v1 = v1 * sc; u32x4 w; w.x = cvt_pk_bf16(v0[0], v0[1]); w.y = cvt_pk_bf16(v0[2], v0[3]); w.z = cvt_pk_bf16(v1[0], v1[1]); w.w = cvt_pk_bf16(v1[2], v1[3]);
                    *(u32x4*)(rowp + bj * HALF) = w; } }
    }
};
template <class Epi, class Sched, bool ALIGN_EPI = false, bool SP2 = false>
__device__ __forceinline__ void gemm_phase(PG8_LAS unsigned char* lds, const Gemm g, const Sched& S, const Epi& E) {
    const int tid = threadIdx.x, wid = __builtin_amdgcn_readfirstlane(tid >> 6), lane = tid & 63, wr = wid >> 2, wc = wid & 3, fr = lane & 15, fq = lane >> 4;
    const int K = g.K, nt = K / BK;
    unsigned voffA[2], voffB[2];
#pragma unroll
    for (int i = 0; i < 2; ++i) { int R, C; stage_rc(tid * 16 + i * 8192, R, C); const int Rb = Epi::PERM ? ((R & ~31) + perm32(R & 31)) : R;
        voffA[i] = (unsigned)(R * K + C) * 2u; voffB[i] = (unsigned)(Rb * K + C) * 2u; }
    const size_t kstep = (size_t)(BK * 2);
    const size_t hstep = (size_t)HALF * K * 2;
    const size_t tstep = 2 * hstep;
    const unsigned ldsw = (unsigned)wid * 1024u;
    const int aoff = lds_byte(wr * 64 + fr, fq * 8), boff = lds_byte(wc * 32 + fr, fq * 8);
#define PG8_SA(b, h) (((b) * 2 + (h)) * HTB)
#define PG8_SB(b, h) ((4 + (b) * 2 + (h)) * HTB)
#define PG8_STAGE(bufoff, gbase, voff) do { _Pragma("unroll") for (int _i = 0; _i < 2; ++_i) \
        __builtin_amdgcn_global_load_lds((const unsigned*)((const char*)(gbase) + (voff)[_i]), (PG8_LAS unsigned*)(lds + (bufoff) + ldsw + _i * 8192), 16, 0, 0); } while (0)
#define PG8_LDA(dst, b, h) do { _Pragma("unroll") for (int m = 0; m < 4; ++m) _Pragma("unroll") for (int k = 0; k < 2; ++k) dst[m][k] = *(const PG8_LAS bf16x8*)(lds + PG8_SA(b, h) + aoff + m * 2048 + k * 1024); } while (0)
#define PG8_LDB(dst, b, h) do { _Pragma("unroll") for (int n = 0; n < 2; ++n) _Pragma("unroll") for (int k = 0; k < 2; ++k) dst[n][k] = *(const PG8_LAS bf16x8*)(lds + PG8_SB(b, h) + boff + n * 2048 + k * 1024); } while (0)
#define PG8_MMA(ai, bj, At, Bt) do { __builtin_amdgcn_s_setprio(1); _Pragma("unroll") for (int m = 0; m < 4; ++m) _Pragma("unroll") for (int n = 0; n < 2; ++n) _Pragma("unroll") for (int k = 0; k < 2; ++k) \
        acc[ai][bj][m][n] = __builtin_amdgcn_mfma_f32_16x16x32_bf16(Bt[n][k], At[m][k], acc[ai][bj][m][n], 0, 0, 0); __builtin_amdgcn_s_setprio(0); } while (0)
#define PG8_WAIT_V(n) asm volatile("s_waitcnt vmcnt(" #n ")" ::: "memory")
#define PG8_WAIT_L(n) asm volatile("s_waitcnt lgkmcnt(" #n ")" ::: "memory")
#define PG8_BAR __builtin_amdgcn_s_barrier()
#define PG8_SCHED __builtin_amdgcn_sched_barrier(0)
    Unit cur, nxt; int ui = 0;
    if (!S.next(0, cur)) return;
    f32x4 acc[2][2][4][2];
#pragma unroll
    for (int a = 0; a < 2; ++a)
#pragma unroll
        for (int b = 0; b < 2; ++b)
#pragma unroll
            for (int m = 0; m < 4; ++m)
#pragma unroll
                for (int n = 0; n < 2; ++n) acc[a][b][m][n] = (f32x4){0.f, 0.f, 0.f, 0.f};
    bf16x8 At[4][2], B0[2][2], B1[2][2];
    const char* cA = (const char*)g.A + (size_t)cur.pm * tstep; const char* cB = (const char*)g.Bt + (size_t)cur.pn * tstep;
    S.a_ready(cur);
    if constexpr (SP2) {
        PG8_STAGE(PG8_SB(0, 0), cB, voffB); PG8_STAGE(PG8_SB(0, 1), cB + hstep, voffB); PG8_STAGE(PG8_SA(0, 0), cA, voffA); PG8_STAGE(PG8_SA(0, 1), cA + hstep, voffA);
        if (wr == 1) PG8_BAR;
        PG8_WAIT_V(2); PG8_BAR;
        PG8_STAGE(PG8_SB(1, 0), cB + kstep, voffB); PG8_STAGE(PG8_SA(1, 0), cA + kstep, voffA); PG8_STAGE(PG8_SB(1, 1), cB + hstep + kstep, voffB);
        PG8_WAIT_V(6); PG8_BAR;
    } else {
        PG8_STAGE(PG8_SB(0, 0), cB, voffB); PG8_STAGE(PG8_SA(0, 0), cA, voffA); PG8_STAGE(PG8_SB(0, 1), cB + hstep, voffB); PG8_STAGE(PG8_SA(0, 1), cA + hstep, voffA);
        if (wr == 1) PG8_BAR;
        PG8_WAIT_V(4); PG8_BAR;
        PG8_STAGE(PG8_SB(1, 0), cB + kstep, voffB); PG8_STAGE(PG8_SA(1, 0), cA + kstep, voffA); PG8_STAGE(PG8_SB(1, 1), cB + hstep + kstep, voffB);
        PG8_WAIT_V(6); PG8_BAR;
    }
    for (;;) {
        const bool has_next = S.next(ui + 1, nxt);
        const char* nA = has_next ? (const char*)g.A + (size_t)nxt.pm * tstep : cA; const char* nB = has_next ? (const char*)g.Bt + (size_t)nxt.pn * tstep : cB;
        for (int t = 0; t < nt; t += 2) {
            const bool last = (t == nt - 2);
            const char* a1 = cA + (size_t)(t + 1) * kstep;
            const char* a2 = last ? nA : cA + (size_t)(t + 2) * kstep; const char* b2 = last ? nB : cB + (size_t)(t + 2) * kstep;
            const char* a3 = a2 + kstep; const char* b3 = b2 + kstep;
            if (last && has_next) S.a_ready(nxt);
            if constexpr (SP2) {
            PG8_LDB(B0, 0, 0); PG8_LDB(B1, 0, 1); PG8_SCHED; PG8_LDA(At, 0, 0); PG8_STAGE(PG8_SA(1, 1), a1 + hstep, voffA);
            PG8_WAIT_V(8); PG8_WAIT_L(0); PG8_BAR; PG8_MMA(0, 0, At, B0); PG8_MMA(0, 1, At, B1); PG8_BAR; PG8_SCHED;
            PG8_LDA(At, 0, 1); PG8_STAGE(PG8_SB(0, 0), b2, voffB); PG8_STAGE(PG8_SB(0, 1), b2 + hstep, voffB); PG8_STAGE(PG8_SA(0, 0), a2, voffA);
            PG8_WAIT_V(8); PG8_WAIT_L(0); PG8_BAR; PG8_MMA(1, 0, At, B0); PG8_MMA(1, 1, At, B1); PG8_BAR; PG8_SCHED;
            PG8_LDB(B0, 1, 0); PG8_LDB(B1, 1, 1); PG8_SCHED; PG8_LDA(At, 1, 0); PG8_STAGE(PG8_SA(0, 1), a2 + hstep, voffA);
            PG8_WAIT_V(8); PG8_WAIT_L(0); PG8_BAR; PG8_MMA(0, 0, At, B0); PG8_MMA(0, 1, At, B1); PG8_BAR; PG8_SCHED;
            PG8_LDA(At, 1, 1); PG8_STAGE(PG8_SB(1, 0), b3, voffB); PG8_STAGE(PG8_SB(1, 1), b3 + hstep, voffB); PG8_STAGE(PG8_SA(1, 0), a3, voffA);
            PG8_WAIT_V(8); PG8_WAIT_L(0); PG8_BAR; PG8_MMA(1, 0, At, B0); PG8_MMA(1, 1, At, B1); PG8_BAR; PG8_SCHED;
            } else {
            PG8_LDB(B0, 0, 0); PG8_SCHED; PG8_LDA(At, 0, 0); PG8_STAGE(PG8_SA(1, 1), a1 + hstep, voffA);
            PG8_WAIT_L(8); PG8_BAR; PG8_WAIT_L(0); PG8_MMA(0, 0, At, B0); PG8_BAR; PG8_SCHED;
            PG8_LDB(B1, 0, 1); PG8_STAGE(PG8_SB(0, 0), b2, voffB);
            PG8_BAR; PG8_WAIT_L(0); PG8_MMA(0, 1, At, B1); PG8_BAR;
            PG8_LDA(At, 0, 1); PG8_STAGE(PG8_SA(0, 0), a2, voffA);
            PG8_BAR; PG8_WAIT_L(0); PG8_MMA(1, 0, At, B0); PG8_BAR; PG8_SCHED;
            PG8_STAGE(PG8_SB(0, 1), b2 + hstep, voffB);
            PG8_WAIT_V(6); PG8_BAR; PG8_MMA(1, 1, At, B1); PG8_BAR;
            PG8_LDB(B0, 1, 0); PG8_SCHED; PG8_LDA(At, 1, 0); PG8_STAGE(PG8_SA(0, 1), a2 + hstep, voffA);
            PG8_WAIT_L(8); PG8_BAR; PG8_WAIT_L(0); PG8_MMA(0, 0, At, B0); PG8_BAR; PG8_SCHED;
            PG8_LDB(B1, 1, 1); PG8_STAGE(PG8_SB(1, 0), b3, voffB);
            PG8_BAR; PG8_WAIT_L(0); PG8_MMA(0, 1, At, B1); PG8_BAR;
            PG8_LDA(At, 1, 1); PG8_STAGE(PG8_SA(1, 0), a3, voffA);
            PG8_BAR; PG8_WAIT_L(0); PG8_MMA(1, 0, At, B0); PG8_BAR; PG8_SCHED;
            PG8_STAGE(PG8_SB(1, 1), b3 + hstep, voffB);
            PG8_WAIT_V(6); PG8_BAR; PG8_MMA(1, 1, At, B1); PG8_BAR;
            }
        }
        if constexpr (ALIGN_EPI) { if (wr == 0) PG8_BAR; }
        if constexpr (!Epi::AFTER_DRAIN) { E(acc, cur, wr, wc, fr, fq); S.done(cur); }
        if (!has_next) break;
#pragma unroll
        for (int a = 0; a < 2; ++a)
#pragma unroll
            for (int b = 0; b < 2; ++b)
#pragma unroll
                for (int m = 0; m < 4; ++m)
#pragma unroll
                    for (int n = 0; n < 2; ++n) acc[a][b][m][n] = (f32x4){0.f, 0.f, 0.f, 0.f};
        cur = nxt; cA = nA; cB = nB; ++ui;
        if constexpr (ALIGN_EPI) { if (wr == 1) PG8_BAR; }
    }
    PG8_WAIT_V(0);
    if constexpr (!ALIGN_EPI) { if (wr == 0) PG8_BAR; }
    PG8_BAR;
    if constexpr (Epi::AFTER_DRAIN) { E.fused(acc, cur, wr, wc, fr, fq, lds, wid, lane); S.done(cur); }
#undef PG8_SA
#undef PG8_SB
#undef PG8_STAGE
#undef PG8_LDA
#undef PG8_LDB
#undef PG8_MMA
#undef PG8_WAIT_V
#undef PG8_WAIT_L
#undef PG8_BAR
#undef PG8_SCHED
}
}
#define GAS __attribute__((address_space(1)))
#define LAS __attribute__((address_space(3)))
typedef unsigned short bf16;
typedef unsigned v4u __attribute__((ext_vector_type(4)));
typedef float f32x4 __attribute__((ext_vector_type(4)));
typedef short bf16x8 __attribute__((ext_vector_type(8)));
typedef GAS unsigned gu32;
typedef GAS unsigned long long gu64;
#define RLX_AGENT __ATOMIC_RELAXED, __HIP_MEMORY_SCOPE_AGENT
#define LDS_WAIT() asm volatile("s_waitcnt lgkmcnt(0)" ::: "memory")
#define VM_WAIT() asm volatile("s_waitcnt vmcnt(0)" ::: "memory")
__device__ __forceinline__ unsigned long long rt() { return __builtin_amdgcn_s_memrealtime(); }
__device__ __forceinline__ unsigned f2bf(float f) { unsigned u = __builtin_bit_cast(unsigned, f); return (u + 0x7fffu + ((u >> 16) & 1u)) >> 16; }
__device__ __forceinline__ unsigned pk2(float lo, float hi) { return f2bf(lo) | (f2bf(hi) << 16); }

#define XB_TMO      128
#define XB_XCNT(j)  (256  + 64 * (j))
#define XB_XSUB(j)  (1280 + 64 * (j))
#define XB_XGEN(j)  (2304 + 64 * (j))
#define XB_TOP      3328
#define XB_TOPGEN   3392
#define XCD_BAR_WORDS 3456
#define XB_SPIN_CAP (1u << 18)

__device__ __forceinline__ unsigned xb_ld(unsigned* p)              { return __hip_atomic_load(p, __ATOMIC_RELAXED, __HIP_MEMORY_SCOPE_AGENT); }
__device__ __forceinline__ unsigned xb_add(unsigned* p, unsigned v) { return __hip_atomic_fetch_add(p, v, __ATOMIC_RELAXED, __HIP_MEMORY_SCOPE_AGENT); }
__device__ __forceinline__ unsigned xb_xcc_id() { return (unsigned)__builtin_amdgcn_s_getreg((3 << 11) | 20) & 0xFu; }
#define XB_SPIN(cond, bar) do { unsigned _sp = 0; while (cond) { __builtin_amdgcn_s_sleep(1); \
    if ((++_sp & 255u) == 0u) { if (xb_ld(&(bar)[XB_TMO])) break; if (_sp > XB_SPIN_CAP) { atomicAdd(&(bar)[XB_TMO], 1u); break; } } } } while (0)

struct XcdBarrier {
    unsigned* bar; unsigned x;
    volatile LAS unsigned* st;
};

__device__ __forceinline__ XcdBarrier xcd_barrier_post(unsigned* bar, volatile LAS unsigned* st) {
    XcdBarrier b; b.bar = bar; b.x = xb_xcc_id(); b.st = st;
    if (threadIdx.x == 0) (void)xb_add(&bar[XB_XCNT(b.x)], 1u);
    return b;
}
__device__ __forceinline__ void xcd_barrier_complete(unsigned* bar, unsigned x, unsigned& nloc, unsigned& nx) {
    const unsigned G = gridDim.x * gridDim.y * gridDim.z;
    unsigned sum, cnt, mine, sp = 0u;
    for (;;) {
        sum = 0u; cnt = 0u; mine = 0u;
#pragma unroll
        for (unsigned j = 0; j < 16; ++j) { const unsigned c = xb_ld(&bar[XB_XCNT(j)]); sum += c; cnt += (c > 0u) ? 1u : 0u; mine = (j == x) ? c : mine; }
        if (sum == G) break;
        __builtin_amdgcn_s_sleep(1);
        if ((++sp & 255u) == 0u) { if (xb_ld(&bar[XB_TMO])) break; if (sp > XB_SPIN_CAP) { atomicAdd(&bar[XB_TMO], 1u); break; } }
    }
    nloc = mine > 0u ? mine : 1u; nx = cnt > 0u ? cnt : 1u;
}

__device__ __forceinline__ void xcd_barrier(const XcdBarrier& b) {
    asm volatile("s_waitcnt vmcnt(0)" ::: "memory");
    __syncthreads();
    if (threadIdx.x == 0) {
        unsigned* bar = b.bar;
        __builtin_amdgcn_s_waitcnt(0);
        unsigned nloc = b.st[0], nx = b.st[1];
        if (nloc == 0u) { xcd_barrier_complete(bar, b.x, nloc, nx); b.st[0] = nloc; b.st[1] = nx; }
        const unsigned old = xb_add(&bar[XB_XSUB(b.x)], 1u);
        const unsigned gen = old / nloc;
        if (old + 1u == (gen + 1u) * nloc) {
            __builtin_amdgcn_fence(__ATOMIC_RELEASE, "agent");
            asm volatile("s_waitcnt vmcnt(0)" ::: "memory");
            const unsigned og = xb_add(&bar[XB_TOP], 1u);
            const unsigned tg = og / nx;
            if (og + 1u == (tg + 1u) * nx) xb_add(&bar[XB_TOPGEN], 1u);
            else XB_SPIN(xb_ld(&bar[XB_TOPGEN]) == tg, bar);
            __builtin_amdgcn_fence(__ATOMIC_ACQUIRE, "agent");
            xb_add(&bar[XB_XGEN(b.x)], 1u);
            asm volatile("s_waitcnt vmcnt(0)" ::: "memory");
        } else {
            XB_SPIN(xb_ld(&bar[XB_XGEN(b.x)]) == gen, bar);
            __builtin_amdgcn_fence(__ATOMIC_ACQUIRE, "agent");
            asm volatile("s_waitcnt vmcnt(0)" ::: "memory");
        }
    }
    __syncthreads();
}
#define PG8_SP2 true
#define PG8_ALIGN true

constexpr int NWAVES = 8;
constexpr int BATCH = 4, SEQ = 8192, D = 1024, T = BATCH * SEQ, HD = 64;
constexpr int NIN = 6144;
constexpr int FF = 4096, PLE = 256;
constexpr int ZA_LD = 2304, ZR_LD = 1792, ZG_LD = 2048;
constexpr int RW = 512;
constexpr float NORM_EPS = 1e-6f, GN_EPS = 64e-5f;
#ifndef MK_PER_PHASE
#define MK_PER_PHASE 0
#endif
enum { PH_PRO = 0, PH_INPROJ, PH_ATT, PH_PREP, PH_CHUNK, PH_SEQ, PH_POST, PH_UPA, PH_UPR, PH_WO, PH_ROWA, PH_FFI, PH_FFO, PH_ROWB, PH_PLE, PH_PLEG, PH_ROWC, N_PHASES };

constexpr size_t MiB = 1u << 20;
constexpr size_t WS_CTL = 0, CTL_ZERO_BYTES = 1 * MiB;
constexpr size_t WS_CS = 1 * MiB;
constexpr size_t WS_BONUS = 3 * MiB;
constexpr size_t WS_LSE = 4 * MiB;
constexpr size_t WS_WIN = 6 * MiB, WS_WFI = 18 * MiB, WS_WFO = 26 * MiB, WS_WO = 34 * MiB, WS_WPG = 36 * MiB;
constexpr size_t WS_WPLE = 38 * MiB, WS_WAU = 38 * MiB + 512 * 1024, WS_WRU = 39 * MiB;
constexpr size_t WS_XN = 40 * MiB;
constexpr size_t WS_PB = 104 * MiB;
constexpr size_t WS_ZA = 120 * MiB;
constexpr size_t WS_ZR = 264 * MiB;
constexpr size_t WS_ZG = 376 * MiB;
constexpr size_t WS_END = 512 * MiB;
constexpr size_t WS_OA = WS_XN;
constexpr size_t WS_R = WS_ZA, WS_KP = WS_ZA + 32 * MiB, WS_V = WS_ZA + 64 * MiB, WS_AV = WS_ZA + 96 * MiB;
constexpr size_t WS_Y = WS_ZR;
constexpr size_t WS_ORW = WS_ZR + 64 * MiB;
constexpr size_t WS_M1 = WS_ZA;
constexpr size_t WS_TMP2A = 184 * MiB;
constexpr size_t WS_H = WS_ZA;
constexpr size_t WS_TMP2B = WS_ZG;
constexpr size_t WS_E = WS_ZA;
constexpr size_t WS_OG = WS_XN + 16 * MiB;
constexpr size_t DO_DEC = 0;
constexpr size_t DO_BV = 64 * MiB, DO_GT = 96 * MiB;
constexpr size_t WS_YLT = WS_XN + 16 * MiB;
constexpr size_t WS_GC = 504 * MiB;
constexpr int CW_TMO = 0, CW_CODE = 1, CW_BAR = 4096;

constexpr int RING_OFF = 0, RING_BYTES = 131072;
constexpr int LDSCTL_OFF = RING_BYTES, MISC_OFF = LDSCTL_OFF + 320;
constexpr int LDS_BYTES = 147456;

typedef unsigned v2u __attribute__((ext_vector_type(2)));
__device__ __forceinline__ float bf2f(bf16 u) { return __builtin_bit_cast(float, (unsigned)u << 16); }
__device__ __forceinline__ float bflo(unsigned u) { return __builtin_bit_cast(float, u << 16); }
__device__ __forceinline__ float bfhi(unsigned u) { return __builtin_bit_cast(float, u & 0xffff0000u); }
__device__ __forceinline__ float sigmoidf_(float x) { return 1.0f / (1.0f + __expf(-x)); }
__device__ __forceinline__ float wave_sum(float v) {
#pragma unroll
    for (int o = 1; o < 64; o <<= 1) v += __shfl_xor(v, o);
    return v;
}

namespace pg8 {
struct EpiInProj {
    static constexpr bool PERM = true, AFTER_DRAIN = false;
    bf16_t *za, *zr, *zg;
    __device__ __forceinline__ void operator()(const f32x4 (&acc)[2][2][4][2], const Unit& u, int wr, int wc, int fr, int fq) const {
        bf16_t* base; int ld, colt; bool sig = false;
        if (u.pn < 9) { base = za; ld = 2304; colt = u.pn * 256; }
        else if (u.pn < 16) { base = zr; ld = 1792; colt = (u.pn - 9) * 256; }
        else { base = zg; ld = 2048; colt = (u.pn - 16) * 256; sig = true; }
        const int row0 = u.pm * BM + wr * 64 + fr, col0 = colt + wc * 32 + 8 * fq;
#pragma unroll
        for (int ai = 0; ai < 2; ++ai)
#pragma unroll
            for (int m = 0; m < 4; ++m) { bf16_t* rowp = base + (size_t)(row0 + ai * HALF + m * 16) * ld + col0;
#pragma unroll
                for (int bj = 0; bj < 2; ++bj) { f32x4 v0 = acc[ai][bj][m][0], v1 = acc[ai][bj][m][1];
                    if (sig) {
#pragma unroll
                        for (int k = 0; k < 4; ++k) { v0[k] = 1.0f / (1.0f + __expf(-v0[k])); v1[k] = 1.0f / (1.0f + __expf(-v1[k])); } }
                    u32x4 w; w.x = cvt_pk_bf16(v0[0], v0[1]); w.y = cvt_pk_bf16(v0[2], v0[3]); w.z = cvt_pk_bf16(v1[0], v1[1]); w.w = cvt_pk_bf16(v1[2], v1[3]);
                    *(u32x4*)(rowp + bj * HALF) = w; } }
    }
};
struct EpiGateF32 {
    static constexpr bool PERM = false, AFTER_DRAIN = false;
    float* out; const bf16_t* gate; int gld, gcol0;
    __device__ __forceinline__ void operator()(const f32x4 (&acc)[2][2][4][2], const Unit& u, int wr, int wc, int fr, int fq) const {
        const int col0 = u.pn * BM + wc * 32 + 4 * fq;
#pragma unroll
        for (int ai = 0; ai < 2; ++ai)
#pragma unroll
            for (int m = 0; m < 4; ++m) { const int r = u.pm * BM + ai * HALF + wr * 64 + m * 16 + fr;
#pragma unroll
                for (int bj = 0; bj < 2; ++bj)
#pragma unroll
                    for (int n = 0; n < 2; ++n) { const int c = col0 + bj * HALF + n * 16;
                        const unsigned long long gq = *(const unsigned long long*)(gate + (size_t)r * gld + gcol0 + c);
                        const unsigned g0 = (unsigned)gq, g1 = (unsigned)(gq >> 32);
                        f32x4 a = acc[ai][bj][m][n];
                        a[0] *= __builtin_bit_cast(float, g0 << 16); a[1] *= __builtin_bit_cast(float, g0 & 0xffff0000u);
                        a[2] *= __builtin_bit_cast(float, g1 << 16); a[3] *= __builtin_bit_cast(float, g1 & 0xffff0000u);
                        *(f32x4*)(out + (size_t)r * 1024 + c) = a; } }
    }
};
struct EpiMerge {
    static constexpr bool PERM = true, AFTER_DRAIN = false;
    const float* tmp; const bf16_t* gate; int gld, gcol0; bf16_t* out;
    __device__ __forceinline__ void operator()(const f32x4 (&acc)[2][2][4][2], const Unit& u, int wr, int wc, int fr, int fq) const {
        const int row0 = u.pm * BM + wr * 64 + fr, col0 = u.pn * BM + wc * 32 + 8 * fq;
#pragma unroll
        for (int ai = 0; ai < 2; ++ai)
#pragma unroll
            for (int m = 0; m < 4; ++m) { const int r = row0 + ai * HALF + m * 16;
#pragma unroll
                for (int bj = 0; bj < 2; ++bj) { const int c = col0 + bj * HALF;
                    const u32x4 gq = *(const u32x4*)(gate + (size_t)r * gld + gcol0 + c);
                    const f32x4 t0 = *(const f32x4*)(tmp + (size_t)r * 1024 + c), t1 = *(const f32x4*)(tmp + (size_t)r * 1024 + c + 4);
                    f32x4 v0 = acc[ai][bj][m][0], v1 = acc[ai][bj][m][1];
                    v0[0] = t0[0] + v0[0] * __builtin_bit_cast(float, gq.x << 16); v0[1] = t0[1] + v0[1] * __builtin_bit_cast(float, gq.x & 0xffff0000u);
                    v0[2] = t0[2] + v0[2] * __builtin_bit_cast(float, gq.y << 16); v0[3] = t0[3] + v0[3] * __builtin_bit_cast(float, gq.y & 0xffff0000u);
                    v1[0] = t1[0] + v1[0] * __builtin_bit_cast(float, gq.z << 16); v1[1] = t1[1] + v1[1] * __builtin_bit_cast(float, gq.z & 0xffff0000u);
                    v1[2] = t1[2] + v1[2] * __builtin_bit_cast(float, gq.w << 16); v1[3] = t1[3] + v1[3] * __builtin_bit_cast(float, gq.w & 0xffff0000u);
                    u32x4 w; w.x = cvt_pk_bf16(v0[0], v0[1]); w.y = cvt_pk_bf16(v0[2], v0[3]); w.z = cvt_pk_bf16(v1[0], v1[1]); w.w = cvt_pk_bf16(v1[2], v1[3]);
                    *(u32x4*)(out + (size_t)r * 1024 + c) = w; } }
    }
};
template <int MODE> struct EpiF32 {
    static constexpr bool PERM = false, AFTER_DRAIN = false;
    float* out;
    __device__ __forceinline__ void operator()(const f32x4 (&acc)[2][2][4][2], const Unit& u, int wr, int wc, int fr, int fq) const {
        const int col0 = u.pn * BM + wc * 32 + 4 * fq;
#pragma unroll
        for (int ai = 0; ai < 2; ++ai)
#pragma unroll
            for (int m = 0; m < 4; ++m) { const int r = u.pm * BM + ai * HALF + wr * 64 + m * 16 + fr;
#pragma unroll
                for (int bj = 0; bj < 2; ++bj)
#pragma unroll
                    for (int n = 0; n < 2; ++n) { float* p = out + (size_t)r * 1024 + col0 + bj * HALF + n * 16; f32x4 a = acc[ai][bj][m][n];
                        if (MODE == 1) { const f32x4 e = *(const f32x4*)p;
#pragma unroll
                            for (int k = 0; k < 4; ++k) a[k] = e[k] / (1.0f + __expf(-a[k])); }
                        *(f32x4*)p = a; } }
    }
};
struct EpiRelu2 {
    static constexpr bool PERM = true, AFTER_DRAIN = false;
    bf16_t* out;
    __device__ __forceinline__ void operator()(const f32x4 (&acc)[2][2][4][2], const Unit& u, int wr, int wc, int fr, int fq) const {
        const int row0 = u.pm * BM + wr * 64 + fr, col0 = u.pn * BM + wc * 32 + 8 * fq;
#pragma unroll
        for (int ai = 0; ai < 2; ++ai)
#pragma unroll
            for (int m = 0; m < 4; ++m) { bf16_t* rowp = out + (size_t)(row0 + ai * HALF + m * 16) * 4096 + col0;
#pragma unroll
                for (int bj = 0; bj < 2; ++bj) { f32x4 v0 = acc[ai][bj][m][0], v1 = acc[ai][bj][m][1];
#pragma unroll
                    for (int k = 0; k < 4; ++k) { const float a = fmaxf(v0[k], 0.f), b = fmaxf(v1[k], 0.f); v0[k] = a * a; v1[k] = b * b; }
                    u32x4 w; w.x = cvt_pk_bf16(v0[0], v0[1]); w.y = cvt_pk_bf16(v0[2], v0[3]); w.z = cvt_pk_bf16(v1[0], v1[1]); w.w = cvt_pk_bf16(v1[2], v1[3]);
                    *(u32x4*)(rowp + bj * HALF) = w; } }
    }
};
}

__device__ __forceinline__ void p0_transpose_item(const float* W, int K, int N, bf16* WT, int row_off, LAS float* scr, int item, int lane) {
    const int nblk = N / 32, kb = item / nblk, nb = item % nblk, k0 = 64 * kb, n0 = 32 * nb;
#pragma unroll 8
    for (int i = 0; i < 32; ++i) { const int kk = 2 * i + (lane >> 5); scr[kk * 33 + (lane & 31)] = W[(size_t)(k0 + kk) * N + n0 + (lane & 31)]; }
    LDS_WAIT(); asm volatile("" ::: "memory");
    const int c = lane & 7;
#pragma unroll
    for (int j = 0; j < 4; ++j) { const int n = (lane >> 3) + 8 * j; const LAS float* s = scr + (8 * c) * 33 + n;
        v4u o; o.x = pk2(s[0 * 33], s[1 * 33]); o.y = pk2(s[2 * 33], s[3 * 33]); o.z = pk2(s[4 * 33], s[5 * 33]); o.w = pk2(s[6 * 33], s[7 * 33]);
        *(GAS v4u*)(WT + (size_t)(row_off + n0 + n) * K + k0 + 8 * c) = o; }
    LDS_WAIT(); asm volatile("" ::: "memory");
}
__device__ __forceinline__ void rms_row_to_bf16(const float* xrow, const float* g, bf16* orow, int lane) {
    const GAS f32x4* xr = (const GAS f32x4*)xrow + lane; const GAS f32x4* gr = (const GAS f32x4*)g + lane;
    f32x4 v[4]; float s = 0.f;
#pragma unroll
    for (int j = 0; j < 4; ++j) { v[j] = xr[64 * j]; s += (v[j].x * v[j].x + v[j].y * v[j].y) + (v[j].z * v[j].z + v[j].w * v[j].w); }
    const float rs = 1.f / sqrtf(wave_sum(s) * (1.f / D) + NORM_EPS);
    GAS unsigned long long* o8 = (GAS unsigned long long*)orow + lane;
#pragma unroll
    for (int j = 0; j < 4; ++j) { const f32x4 gg = gr[64 * j];
        o8[64 * j] = (unsigned long long)pk2(v[j].x * rs * gg.x, v[j].y * rs * gg.y) | ((unsigned long long)pk2(v[j].z * rs * gg.z, v[j].w * rs * gg.w) << 32); }
}

struct Args { const float* in[26]; float* out; unsigned char* ws; int ph_lo, ph_hi, li, pad; };

__global__ void __launch_bounds__(NWAVES * 64, 2) skel_fwd(Args args) {
    extern __shared__ __attribute__((aligned(16))) unsigned char lds_raw[];
    LAS unsigned char* const lds = (LAS unsigned char*)lds_raw;
    volatile LAS unsigned* const MISC = (volatile LAS unsigned*)(lds + MISC_OFF);
    const int tid = threadIdx.x, lane = tid & 63, wave = __builtin_amdgcn_readfirstlane(tid >> 6);
    const int G = gridDim.x; int vcu; { const int bx = blockIdx.x; vcu = (G % 8 == 0) ? (bx % 8) * (G / 8) + bx / 8 : bx; }
    unsigned char* const ws = args.ws;
    gu32* const ctl = (gu32*)(ws + WS_CTL);
    for (int u = tid; u < (LDS_BYTES - LDSCTL_OFF) / 4; u += NWAVES * 64) ((LAS unsigned*)(lds + LDSCTL_OFF))[u] = 0u;
    __syncthreads();
    XcdBarrier bar; bar.bar = (unsigned*)(ctl + CW_BAR); bar.x = 0; bar.st = nullptr;
    if (!MK_PER_PHASE) bar = xcd_barrier_post((unsigned*)(ctl + CW_BAR), MISC + 8);
#define GRID_BAR() do { if (MK_PER_PHASE) { if (tid == 0) __hip_atomic_store(ctl + CW_TMO, 0xBADBA0u, RLX_AGENT); } else { xcd_barrier(bar); } } while (0)
    const int lo = args.ph_lo, hi = args.ph_hi;
#ifndef PH_MASK
#define PH_MASK 0xFFFFFFFFu
#endif
#define IN(k) (((PH_MASK >> (k)) & 1u) && lo <= (k) && (k) < hi)
#define BOTH(k) (IN(k) && IN((k) + 1))
    const int gw = vcu * NWAVES + wave, NGW = G * NWAVES;
    const int gt = vcu * (NWAVES * 64) + tid, NGT = G * NWAVES * 64;

    const float* const x = args.in[0]; const float* const pin = args.in[1];
    float* const out = args.out;
    bf16* const WinT = (bf16*)(ws + WS_WIN); bf16* const WfiT = (bf16*)(ws + WS_WFI); bf16* const WfoT = (bf16*)(ws + WS_WFO);
    bf16* const WoT = (bf16*)(ws + WS_WO); bf16* const WpgT = (bf16*)(ws + WS_WPG); bf16* const WpleT = (bf16*)(ws + WS_WPLE);
    bf16* const WauT = (bf16*)(ws + WS_WAU); bf16* const WruT = (bf16*)(ws + WS_WRU);
    bf16* const XN = (bf16*)(ws + WS_XN); bf16* const PB = (bf16*)(ws + WS_PB);
    bf16* const ZA = (bf16*)(ws + WS_ZA); bf16* const ZR = (bf16*)(ws + WS_ZR); bf16* const ZG = (bf16*)(ws + WS_ZG);
    float2* const CS = (float2*)(ws + WS_CS);

    if (IN(PH_PRO)) {
        LAS float* scr = (LAS float*)(lds + RING_OFF + wave * 16384);
        constexpr int I_IN = (D / 64) * (6048 / 32), I_FI = (D / 64) * (FF / 32), I_FO = (FF / 64) * (D / 32), I_O = (D / 64) * (D / 32), I_PG = I_O;
        constexpr int I_PLE = (PLE / 64) * (D / 32), I_AU = (256 / 64) * (D / 32), I_RU = (512 / 64) * (D / 32);
        constexpr int NITEMS = I_IN + I_FI + I_FO + I_O + I_PG + I_PLE + I_AU + I_RU;
        for (int it = gw; it < NITEMS; it += NGW) {
            int r = it;
            if (r < I_IN) { const int nb = r % (6048 / 32); p0_transpose_item(args.in[3], D, 6048, WinT, (nb * 32 >= 4000) ? 96 : 0, scr, r, lane); continue; } r -= I_IN;
            if (r < I_FI) { p0_transpose_item(args.in[20], D, FF, WfiT, 0, scr, r, lane); continue; } r -= I_FI;
            if (r < I_FO) { p0_transpose_item(args.in[21], FF, D, WfoT, 0, scr, r, lane); continue; } r -= I_FO;
            if (r < I_O) { p0_transpose_item(args.in[17], D, D, WoT, 0, scr, r, lane); continue; } r -= I_O;
            if (r < I_PG) { p0_transpose_item(args.in[24], D, D, WpgT, 0, scr, r, lane); continue; } r -= I_PG;
            if (r < I_PLE) { p0_transpose_item(args.in[23], PLE, D, WpleT, 0, scr, r, lane); continue; } r -= I_PLE;
            if (r < I_AU) { p0_transpose_item(args.in[15], 256, D, WauT, 0, scr, r, lane); continue; } r -= I_AU;
            p0_transpose_item(args.in[16], 512, D, WruT, 0, scr, r, lane);
        }
        for (int i = gt; i < 96 * 1024 / 8; i += NGT) ((GAS v4u*)(WinT + (size_t)4000 * 1024))[i] = (v4u){0u, 0u, 0u, 0u};
        for (int m = gw; m < T; m += NGW) rms_row_to_bf16(x + (size_t)m * D, args.in[2], XN + (size_t)m * D, lane);
        for (int m = gw; m < T; m += NGW) { const f32x4 v = ((const GAS f32x4*)(pin + (size_t)m * PLE))[lane];
            ((GAS unsigned long long*)(PB + (size_t)m * PLE))[lane] = (unsigned long long)pk2(v.x, v.y) | ((unsigned long long)pk2(v.z, v.w) << 32); }
        for (int i = gt; i < SEQ * 32; i += NGT) { const int pos = i >> 5, fi = i & 31;
            const float inv = (float)exp(-(double)fi * (1.0 / 32.0) * 9.210340371976184);
            const float ang = (float)pos * inv;
            const double a = (double)ang; const double kq = rint(a * 0.15915494309189535); const double rr = a - kq * 6.283185307179586;
            const float rf = (float)rr; CS[i] = make_float2(cosf(rf), sinf(rf)); }
        if (BOTH(PH_PRO)) GRID_BAR();
    }

    if (IN(PH_INPROJ)) {
        pg8::Gemm g{XN, WinT, T, NIN, D}; pg8::StaticOrder S; S.init(T, NIN, G, (int)blockIdx.x);
        pg8::EpiInProj E{ZA, ZR, ZG};
        pg8::gemm_phase<pg8::EpiInProj, pg8::StaticOrder, PG8_ALIGN, PG8_SP2>(lds + RING_OFF, g, S, E);
        if (BOTH(PH_INPROJ)) GRID_BAR();
    }

    if (IN(PH_ATT)) {
        constexpr int KS = 72, VS = 264;
        bf16* const OG = (bf16*)(ws + WS_OG); float* const LSE = (float*)(ws + WS_LSE);
        LAS bf16* const Kl = (LAS bf16*)(lds + RING_OFF); LAS bf16* const VT = (LAS bf16*)(lds + RING_OFF + 36864);
        const int lr = lane & 15, lq = lane >> 4;
        for (int unit = vcu; unit < BATCH * 3 * 4 * 64; unit += G) {
            const int tau = unit & 63, h = (unit >> 6) & 3, g = (unit >> 8) % 3, b = unit / (64 * 4 * 3);
            const int dl = (g == 0) ? 1 : (g == 1) ? 4 : 16;
            const int rho = tau % dl, it = tau / dl, i0 = it * 128;
            const int colq = g * 256 + h * 64, colk = 768 + colq, colv = 1536 + colq;
#pragma unroll
            for (int r2 = 0; r2 < 2; ++r2) { const int idx = tid + 512 * r2, key = idx >> 2, p = idx & 3, ik = i0 - 128 + key;
                v4u lo = {0u, 0u, 0u, 0u}, hi = {0u, 0u, 0u, 0u};
                if (ik >= 0) { const int t = ik * dl + rho; const bf16* rowp = ZA + (size_t)(b * SEQ + t) * ZA_LD + colk + 8 * p;
                    const v4u x1 = *(const GAS v4u*)rowp, x2 = *(const GAS v4u*)(rowp + 32);
                    const GAS f32x4* cs = (const GAS f32x4*)(CS + t * 32 + 8 * p); const f32x4 c0 = cs[0], c1 = cs[1], c2 = cs[2], c3 = cs[3];
                    float a1[8] = {bflo(x1.x), bfhi(x1.x), bflo(x1.y), bfhi(x1.y), bflo(x1.z), bfhi(x1.z), bflo(x1.w), bfhi(x1.w)};
                    float a2[8] = {bflo(x2.x), bfhi(x2.x), bflo(x2.y), bfhi(x2.y), bflo(x2.z), bfhi(x2.z), bflo(x2.w), bfhi(x2.w)};
                    float cc[8] = {c0.x, c0.z, c1.x, c1.z, c2.x, c2.z, c3.x, c3.z}, ss[8] = {c0.y, c0.w, c1.y, c1.w, c2.y, c2.w, c3.y, c3.w};
                    float o1[8], o2[8];
#pragma unroll
                    for (int e = 0; e < 8; ++e) { o1[e] = a1[e] * cc[e] - a2[e] * ss[e]; o2[e] = a2[e] * cc[e] + a1[e] * ss[e]; }
                    lo = (v4u){pk2(o1[0], o1[1]), pk2(o1[2], o1[3]), pk2(o1[4], o1[5]), pk2(o1[6], o1[7])}; hi = (v4u){pk2(o2[0], o2[1]), pk2(o2[2], o2[3]), pk2(o2[4], o2[5]), pk2(o2[6], o2[7])}; }
                *(LAS v4u*)(Kl + key * KS + 8 * p) = lo; *(LAS v4u*)(Kl + key * KS + 32 + 8 * p) = hi; }
#pragma unroll
            for (int r4 = 0; r4 < 4; ++r4) { const int idx = tid + 512 * r4, key = idx >> 3, pc = idx & 7, ik = i0 - 128 + key;
                v4u x = {0u, 0u, 0u, 0u};
                if (ik >= 0) { const int t = ik * dl + rho; x = *(const GAS v4u*)(ZA + (size_t)(b * SEQ + t) * ZA_LD + colv + 8 * pc); }
                LAS bf16* vp = VT + (8 * pc) * VS + key;
                vp[0] = (bf16)(x.x & 0xffffu); vp[VS] = (bf16)(x.x >> 16); vp[2 * VS] = (bf16)(x.y & 0xffffu); vp[3 * VS] = (bf16)(x.y >> 16);
                vp[4 * VS] = (bf16)(x.z & 0xffffu); vp[5 * VS] = (bf16)(x.z >> 16); vp[6 * VS] = (bf16)(x.w & 0xffffu); vp[7 * VS] = (bf16)(x.w >> 16); }
            const int tq = (i0 + 16 * wave + lr) * dl + rho; const size_t trow = (size_t)(b * SEQ + tq);
            bf16x8 qf0, qf1;
            { const bf16* rowp = ZA + trow * ZA_LD + colq + 8 * lq; const v4u x1 = *(const GAS v4u*)rowp, x2 = *(const GAS v4u*)(rowp + 32);
              const GAS f32x4* cs = (const GAS f32x4*)(CS + tq * 32 + 8 * lq); const f32x4 c0 = cs[0], c1 = cs[1], c2 = cs[2], c3 = cs[3];
              float a1[8] = {bflo(x1.x), bfhi(x1.x), bflo(x1.y), bfhi(x1.y), bflo(x1.z), bfhi(x1.z), bflo(x1.w), bfhi(x1.w)};
              float a2[8] = {bflo(x2.x), bfhi(x2.x), bflo(x2.y), bfhi(x2.y), bflo(x2.z), bfhi(x2.z), bflo(x2.w), bfhi(x2.w)};
              float cc[8] = {c0.x, c0.z, c1.x, c1.z, c2.x, c2.z, c3.x, c3.z}, ss[8] = {c0.y, c0.w, c1.y, c1.w, c2.y, c2.w, c3.y, c3.w};
              const float qs = 0.125f * 1.4426950408889634f; float o1[8], o2[8];
#pragma unroll
              for (int e = 0; e < 8; ++e) { o1[e] = (a1[e] * cc[e] - a2[e] * ss[e]) * qs; o2[e] = (a2[e] * cc[e] + a1[e] * ss[e]) * qs; }
              const v4u lo = {pk2(o1[0], o1[1]), pk2(o1[2], o1[3]), pk2(o1[4], o1[5]), pk2(o1[6], o1[7])}, hi = {pk2(o2[0], o2[1]), pk2(o2[2], o2[3]), pk2(o2[4], o2[5]), pk2(o2[6], o2[7])};
              qf0 = __builtin_bit_cast(bf16x8, lo); qf1 = __builtin_bit_cast(bf16x8, hi); }
            __syncthreads();
            f32x4 sc[9]; float m = -INFINITY;
#pragma unroll
            for (int kt = 0; kt < 9; ++kt) { const LAS bf16* kp = Kl + (16 * wave + 16 * kt + lr) * KS + 8 * lq;
                const bf16x8 a0 = *(const LAS bf16x8*)kp, a1 = *(const LAS bf16x8*)(kp + 32);
                f32x4 acc = {0.f, 0.f, 0.f, 0.f};
                acc = __builtin_amdgcn_mfma_f32_16x16x32_bf16(a0, qf0, acc, 0, 0, 0); acc = __builtin_amdgcn_mfma_f32_16x16x32_bf16(a1, qf1, acc, 0, 0, 0);
#pragma unroll
                for (int i = 0; i < 4; ++i) { const int ko = 4 * lq + i; const int ik = i0 - 128 + 16 * wave + 16 * kt + ko;
                    const bool valid = (ik >= 0) && (kt > 0 || ko >= lr) && (kt < 8 || ko <= lr);
                    acc[i] = valid ? acc[i] : -INFINITY; m = fmaxf(m, acc[i]); }
                sc[kt] = acc; }
            m = fmaxf(m, __shfl_xor(m, 16)); m = fmaxf(m, __shfl_xor(m, 32));
            float l = 0.f;
#pragma unroll
            for (int kt = 0; kt < 9; ++kt)
#pragma unroll
                for (int i = 0; i < 4; ++i) { const float pj = __builtin_amdgcn_exp2f(sc[kt][i] - m); sc[kt][i] = pj; l += pj; }
            l += __shfl_xor(l, 16); l += __shfl_xor(l, 32);
            bf16x8 pb[5];
#pragma unroll
            for (int st = 0; st < 5; ++st) { const f32x4 t0v = sc[2 * st]; const f32x4 t1v = (st < 4) ? sc[2 * st + 1] : (f32x4){0.f, 0.f, 0.f, 0.f};
                const v4u pk = {pk2(t0v[0], t0v[1]), pk2(t0v[2], t0v[3]), pk2(t1v[0], t1v[1]), pk2(t1v[2], t1v[3])}; pb[st] = __builtin_bit_cast(bf16x8, pk); }
            const float il = 1.0f / l;
#pragma unroll
            for (int dt = 0; dt < 4; ++dt) { f32x4 acc = {0.f, 0.f, 0.f, 0.f};
#pragma unroll
                for (int st = 0; st < 5; ++st) { const LAS bf16* vp = VT + (16 * dt + lr) * VS + 16 * wave + 32 * st + 4 * lq;
                    const v2u v0 = *(const LAS v2u*)vp; const v2u v1 = (st < 4) ? *(const LAS v2u*)(vp + 16) : (v2u){0u, 0u};
                    const v4u av = {v0.x, v0.y, v1.x, v1.y};
                    acc = __builtin_amdgcn_mfma_f32_16x16x32_bf16(__builtin_bit_cast(bf16x8, av), pb[st], acc, 0, 0, 0); }
                *(GAS unsigned long long*)(OG + ((size_t)g * T + trow) * 256 + h * 64 + 16 * dt + 4 * lq) = (unsigned long long)pk2(acc[0] * il, acc[1] * il) | ((unsigned long long)pk2(acc[2] * il, acc[3] * il) << 32); }
            if (lq == 0) LSE[((size_t)g * T + trow) * 4 + h] = (m + __builtin_amdgcn_logf(l)) * 0.6931471805599453f;
            __syncthreads();
        }
        if (BOTH(PH_ATT)) GRID_BAR();
    }

    if (IN(PH_PREP)) {
        {
            const bf16* const OG = (const bf16*)(ws + WS_OG); const float* const LSE = (const float*)(ws + WS_LSE); bf16* const OA = (bf16*)(ws + WS_OA);
            for (int i = gt; i < T * 32; i += NGT) { const int t = i >> 5, h = (i >> 3) & 3, c8 = i & 7;
                const float l0 = LSE[((size_t)0 * T + t) * 4 + h], l1 = LSE[((size_t)1 * T + t) * 4 + h], l2 = LSE[((size_t)2 * T + t) * 4 + h];
                const float mx = fmaxf(l0, fmaxf(l1, l2)); const float e0 = __expf(l0 - mx), e1 = __expf(l1 - mx), e2 = __expf(l2 - mx); const float inv = 1.0f / (e0 + e1 + e2);
                const float a0 = e0 * inv, a1 = e1 * inv, a2 = e2 * inv;
                const v4u x0 = *(const GAS v4u*)(OG + ((size_t)0 * T + t) * 256 + h * 64 + 8 * c8), x1 = *(const GAS v4u*)(OG + ((size_t)1 * T + t) * 256 + h * 64 + 8 * c8), x2 = *(const GAS v4u*)(OG + ((size_t)2 * T + t) * 256 + h * 64 + 8 * c8);
                v4u w;
                w.x = pk2(a0 * bflo(x0.x) + a1 * bflo(x1.x) + a2 * bflo(x2.x), a0 * bfhi(x0.x) + a1 * bfhi(x1.x) + a2 * bfhi(x2.x));
                w.y = pk2(a0 * bflo(x0.y) + a1 * bflo(x1.y) + a2 * bflo(x2.y), a0 * bfhi(x0.y) + a1 * bfhi(x1.y) + a2 * bfhi(x2.y));
                w.z = pk2(a0 * bflo(x0.z) + a1 * bflo(x1.z) + a2 * bflo(x2.z), a0 * bfhi(x0.z) + a1 * bfhi(x1.z) + a2 * bfhi(x2.z));
                w.w = pk2(a0 * bflo(x0.w) + a1 * bflo(x1.w) + a2 * bflo(x2.w), a0 * bfhi(x0.w) + a1 * bfhi(x1.w) + a2 * bfhi(x2.w));
                *(GAS v4u*)(OA + (size_t)t * 256 + h * 64 + 8 * c8) = w; }
        }
        {
            const float* const mu = args.in[4]; const float* const w0 = args.in[5]; const float* const w2 = args.in[6]; const float* const a0 = args.in[7];
            const float* const a2 = args.in[8]; const float* const g2 = args.in[9]; const float* const k_k = args.in[10]; const float* const k_a = args.in[11]; const float* const r_k = args.in[12];
            bf16* const Rb = (bf16*)(ws + WS_R); bf16* const Kb = (bf16*)(ws + WS_KP); bf16* const Vb = (bf16*)(ws + WS_V); bf16* const AVb = (bf16*)(ws + WS_AV);
            float* const DEC = (float*)((unsigned char*)out + DO_DEC);   bf16* const BVb = (bf16*)((unsigned char*)out + DO_BV); bf16* const GTb = (bf16*)((unsigned char*)out + DO_GT);
            float* const BONUS = (float*)(ws + WS_BONUS);
            const int c = tid;
            float w2c[32], a2c[32]; unsigned g2c[48];
#pragma unroll
            for (int j = 0; j < 32; ++j) { w2c[j] = w2[j * RW + c]; a2c[j] = a2[j * RW + c]; }
#pragma unroll
            for (int j = 0; j < 48; ++j) g2c[j] = pk2(g2[(2 * j) * RW + c], g2[(2 * j + 1) * RW + c]);
            const float mu_r = mu[c], mu_k = mu[512 + c], mu_v = mu[1024 + c], w0c = w0[c], a0c = a0[c], kkc = k_k[c], kac = k_a[c], rkc = r_k[c];
            LAS float* L = (LAS float*)(lds + RING_OFF);
            for (int tile = vcu; tile < T / 16; tile += G) {
                const int t0 = tile * 16;
                for (int idx = tid; idx < 16 * 160; idx += 512) { const int tok = idx / 160, j = idx - tok * 160, t = t0 + tok;
                    const float z = bf2f(ZR[(size_t)t * ZR_LD + 1536 + j]); const float zp = ((t & (SEQ - 1)) == 0) ? 0.f : bf2f(ZR[(size_t)(t - 1) * ZR_LD + 1536 + j]);
                    const float xx = z + (zp - z) * mu[1536 + j];
                    L[idx] = (j < 32) ? tanhf(xx) : (j < 64) ? xx : sigmoidf_(xx); }
                __syncthreads();
                float pr = 0.f, pk = 0.f, pv = 0.f;
                if ((t0 & (SEQ - 1)) != 0) { const bf16* zp = ZR + (size_t)(t0 - 1) * ZR_LD; pr = bf2f(zp[c]); pk = bf2f(zp[512 + c]); pv = bf2f(zp[1024 + c]); }
                for (int tok = 0; tok < 16; ++tok) { const int t = t0 + tok; const bf16* zc = ZR + (size_t)t * ZR_LD;
                    const float zr = bf2f(zc[c]), zk = bf2f(zc[512 + c]), zv = bf2f(zc[1024 + c]);
                    const float r = zr + (pr - zr) * mu_r; float k = zk + (pk - zk) * mu_k; const float v = zv + (pv - zv) * mu_v; pr = zr; pk = zk; pv = zv;
                    const LAS f32x4* Lt = (const LAS f32x4*)(L + tok * 160);
                    float wl = 0.f, al = 0.f, gl = 0.f;
#pragma unroll
                    for (int j = 0; j < 8; ++j) { const f32x4 a = Lt[j]; wl += a.x * w2c[4 * j] + a.y * w2c[4 * j + 1] + a.z * w2c[4 * j + 2] + a.w * w2c[4 * j + 3]; }
#pragma unroll
                    for (int j = 0; j < 8; ++j) { const f32x4 a = Lt[8 + j]; al += a.x * a2c[4 * j] + a.y * a2c[4 * j + 1] + a.z * a2c[4 * j + 2] + a.w * a2c[4 * j + 3]; }
#pragma unroll
                    for (int j = 0; j < 24; ++j) { const f32x4 a = Lt[16 + j]; gl += a.x * bflo(g2c[2 * j]) + a.y * bfhi(g2c[2 * j]) + a.z * bflo(g2c[2 * j + 1]) + a.w * bfhi(g2c[2 * j + 1]); }
                    const float wv = w0c + wl; const float nx = -wv;
                    const float sp = fmaxf(nx, 0.f) + log1pf(__expf(-fabsf(nx)));
                    const float dec = -__expf(-sp - 0.5f);
                    const float a = sigmoidf_(a0c + al);
                    float kk = k * kkc; const float ss = wave_sum(kk * kk); kk = kk / fmaxf(sqrtf(ss), 1e-12f);
                    k = k * (1.0f + (a - 1.0f) * kac);
                    const float bon = wave_sum(r * k * rkc);
                    const size_t o = (size_t)t * RW + c;
                    Rb[o] = (bf16)f2bf(r); Kb[o] = (bf16)f2bf(k); Vb[o] = (bf16)f2bf(v); AVb[o] = (bf16)f2bf(-kk); BVb[o] = (bf16)f2bf(kk * a); GTb[o] = (bf16)f2bf(gl); DEC[o] = dec;
                    if (lane == 0) BONUS[(size_t)t * 8 + wave] = bon;
                }
                __syncthreads();
            }
        }
        if (BOTH(PH_PREP)) GRID_BAR();
    }

    if (IN(PH_CHUNK)) {
        constexpr int LS = 72, FS = 68;
        bf16* const Rb = (bf16*)(ws + WS_R); bf16* const Kb = (bf16*)(ws + WS_KP); const bf16* const Vb = (const bf16*)(ws + WS_V); bf16* const AVb = (bf16*)(ws + WS_AV);
        float* const LW = (float*)((unsigned char*)out + DO_DEC); bf16* const BVb = (bf16*)((unsigned char*)out + DO_BV);
        bf16* const YLT = (bf16*)(ws + WS_YLT); float* const GC = (float*)(ws + WS_GC);
        LAS bf16* const At = (LAS bf16*)(lds + 0); LAS bf16* const Rt = (LAS bf16*)(lds + 9216); LAS bf16* const Bt = (LAS bf16*)(lds + 18432); LAS bf16* const Kt = (LAS bf16*)(lds + 27648);
        LAS bf16* const VmT = (LAS bf16*)(lds + 36864); LAS bf16* const KhT = (LAS bf16*)(lds + 46080); LAS bf16* const Lak = (LAS bf16*)(lds + 55296); LAS bf16* const Mrb = (LAS bf16*)(lds + 64512);
        LAS bf16* const Mrk = (LAS bf16*)(lds + 73728); LAS bf16* const BhT = (LAS bf16*)(lds + 82944); LAS float* const LabF = (LAS float*)(lds + 92160); LAS float* const X1F = (LAS float*)(lds + 109568);
        LAS bf16* const ApT = Bt; LAS bf16* const WT2 = Kt; LAS float* const cum = X1F;
        const int lr = lane & 15, lq = lane >> 4;
        for (int unit = vcu; unit < BATCH * 8 * (SEQ / 64); unit += G) {
            const int ch = unit & 127, h = (unit >> 7) & 7, b = unit >> 10;
            const size_t t0 = (size_t)b * SEQ + (size_t)ch * 64;
            const int c = tid >> 3, kq = tid & 7;
            const size_t goff = (t0 + c) * RW + h * 64 + kq * 8;
            const v4u r8 = *(const GAS v4u*)(Rb + goff), k8 = *(const GAS v4u*)(Kb + goff), v8 = *(const GAS v4u*)(Vb + goff), a8 = *(const GAS v4u*)(AVb + goff), b8 = *(const GAS v4u*)(BVb + goff);
            const f32x4 lw0 = *(const GAS f32x4*)(LW + goff), lw1 = *(const GAS f32x4*)(LW + goff + 4);
            float lwv[8] = {lw0.x, lw0.y, lw0.z, lw0.w, lw1.x, lw1.y, lw1.z, lw1.w};
#pragma unroll
            for (int i = 0; i < 8; ++i) cum[c * 65 + kq * 8 + i] = lwv[i];
            __syncthreads();
#pragma unroll
            for (int i = 0; i < 8; ++i) { const int chn = 8 * wave + i; float xx = cum[lane * 65 + chn];
#pragma unroll
                for (int o = 1; o < 64; o <<= 1) { const float yy = __shfl_up(xx, o); if (lane >= o) xx += yy; }
                cum[lane * 65 + chn] = xx; }
            __syncthreads();
            {
                float rr[8], kk8[8], vv[8], aa[8], bb[8];
                rr[0] = bflo(r8.x); rr[1] = bfhi(r8.x); rr[2] = bflo(r8.y); rr[3] = bfhi(r8.y); rr[4] = bflo(r8.z); rr[5] = bfhi(r8.z); rr[6] = bflo(r8.w); rr[7] = bfhi(r8.w);
                kk8[0] = bflo(k8.x); kk8[1] = bfhi(k8.x); kk8[2] = bflo(k8.y); kk8[3] = bfhi(k8.y); kk8[4] = bflo(k8.z); kk8[5] = bfhi(k8.z); kk8[6] = bflo(k8.w); kk8[7] = bfhi(k8.w);
                vv[0] = bflo(v8.x); vv[1] = bfhi(v8.x); vv[2] = bflo(v8.y); vv[3] = bfhi(v8.y); vv[4] = bflo(v8.z); vv[5] = bfhi(v8.z); vv[6] = bflo(v8.w); vv[7] = bfhi(v8.w);
                aa[0] = bflo(a8.x); aa[1] = bfhi(a8.x); aa[2] = bflo(a8.y); aa[3] = bfhi(a8.y); aa[4] = bflo(a8.z); aa[5] = bfhi(a8.z); aa[6] = bflo(a8.w); aa[7] = bfhi(a8.w);
                bb[0] = bflo(b8.x); bb[1] = bfhi(b8.x); bb[2] = bflo(b8.y); bb[3] = bfhi(b8.y); bb[4] = bflo(b8.z); bb[5] = bfhi(b8.z); bb[6] = bflo(b8.w); bb[7] = bfhi(b8.w);
                float at[8], rt[8], bt[8], kt[8];
#pragma unroll
                for (int i = 0; i < 8; ++i) { const float cu = cum[c * 65 + kq * 8 + i], cC = cum[63 * 65 + kq * 8 + i];
                    const float ep = __expf(cu), em = __expf(-cu), epv = __expf(cu - lwv[i]), eh = __expf(cC - cu);
                    at[i] = aa[i] * epv; rt[i] = rr[i] * ep; bt[i] = bb[i] * em; kt[i] = kk8[i] * em;
                    const int kk_ = kq * 8 + i;
                    VmT[kk_ * LS + c] = (bf16)f2bf(vv[i]); KhT[kk_ * LS + c] = (bf16)f2bf(kk8[i] * eh); BhT[kk_ * LS + c] = (bf16)f2bf(bb[i] * eh);
                    if (c == 63) GC[(size_t)unit * 64 + kk_] = __expf(cC); }
                *(LAS v4u*)(At + c * LS + kq * 8) = (v4u){pk2(at[0], at[1]), pk2(at[2], at[3]), pk2(at[4], at[5]), pk2(at[6], at[7])};
                *(LAS v4u*)(Rt + c * LS + kq * 8) = (v4u){pk2(rt[0], rt[1]), pk2(rt[2], rt[3]), pk2(rt[4], rt[5]), pk2(rt[6], rt[7])};
                *(LAS v4u*)(Bt + c * LS + kq * 8) = (v4u){pk2(bt[0], bt[1]), pk2(bt[2], bt[3]), pk2(bt[4], bt[5]), pk2(bt[6], bt[7])};
                *(LAS v4u*)(Kt + c * LS + kq * 8) = (v4u){pk2(kt[0], kt[1]), pk2(kt[2], kt[3]), pk2(kt[4], kt[5]), pk2(kt[6], kt[7])};
            }
            __syncthreads();
            {
                const int p = wave >> 1; const LAS bf16* Ab = (p < 2) ? At : Rt; const LAS bf16* Bb = (p & 1) ? Kt : Bt;
                LAS bf16* dstb = (p == 1) ? Lak : (p == 2) ? Mrb : Mrk;
#pragma unroll 1
                for (int tl = (wave & 1) * 8; tl < (wave & 1) * 8 + 8; ++tl) { const int mt = tl >> 2, nt = tl & 3;
                    f32x4 acc = {0.f, 0.f, 0.f, 0.f};
                    if (nt <= mt) {
#pragma unroll
                        for (int ks = 0; ks < 2; ++ks) { const bf16x8 a = *(const LAS bf16x8*)(Ab + (16 * mt + lr) * LS + 32 * ks + 8 * lq), bq = *(const LAS bf16x8*)(Bb + (16 * nt + lr) * LS + 32 * ks + 8 * lq);
                            acc = __builtin_amdgcn_mfma_f32_16x16x32_bf16(a, bq, acc, 0, 0, 0); } }
                    const int col = 16 * nt + lr;
#pragma unroll
                    for (int i = 0; i < 4; ++i) { const int row = 16 * mt + 4 * lq + i; const bool keep = (p < 2) ? (col < row) : (col <= row); const float val = keep ? acc[i] : 0.f;
                        if (p == 0) LabF[row * FS + (col & 3) * 16 + (col >> 2)] = val; else dstb[row * LS + col] = (bf16)f2bf(val); } }
            }
            __syncthreads();
#pragma unroll 1
            for (int tl = wave * 2; tl < wave * 2 + 2; ++tl) { const int mt = tl >> 2, nt = tl & 3; f32x4 acc = {0.f, 0.f, 0.f, 0.f};
#pragma unroll
                for (int ks = 0; ks < 2; ++ks) { const bf16x8 a = *(const LAS bf16x8*)(Lak + (16 * mt + lr) * LS + 32 * ks + 8 * lq), bq = *(const LAS bf16x8*)(VmT + (16 * nt + lr) * LS + 32 * ks + 8 * lq);
                    acc = __builtin_amdgcn_mfma_f32_16x16x32_bf16(a, bq, acc, 0, 0, 0); }
#pragma unroll
                for (int i = 0; i < 4; ++i) X1F[(16 * mt + 4 * lq + i) * FS + 16 * nt + lr] = acc[i]; }
            __syncthreads();
            {
                const int jl = lane & 15, part = lane >> 4, j = 16 * (wave & 3) + jl;
                float xp[16];
                if (wave < 4) {
#pragma unroll
                    for (int m = 0; m < 16; ++m) xp[m] = bf2f(At[(4 * m + part) * LS + j]);
                } else {
#pragma unroll
                    for (int m = 0; m < 16; ++m) xp[m] = X1F[(4 * m + part) * FS + j];
                }
                int lpo = part * 16;
#pragma unroll
                for (int t = 1; t < 64; ++t) { const int tm = t >> 2, tp = t & 3; float sum = 0.f;
#pragma unroll
                    for (int m4 = 0; m4 <= tm / 4; ++m4) { const f32x4 L4 = *(const LAS f32x4*)(LabF + lpo + t * FS + 4 * m4);
                        sum += L4.x * xp[4 * m4]; if (4 * m4 + 1 <= tm) sum += L4.y * xp[4 * m4 + 1]; if (4 * m4 + 2 <= tm) sum += L4.z * xp[4 * m4 + 2]; if (4 * m4 + 3 <= tm) sum += L4.w * xp[4 * m4 + 3]; }
                    sum += __shfl_xor(sum, 16); sum += __shfl_xor(sum, 32);
                    xp[tm] = (part == tp) ? xp[tm] + sum : xp[tm]; asm volatile("" : "+v"(lpo) : "v"(xp[tm])); }
                LAS bf16* dl = (wave < 4) ? ApT : WT2;
#pragma unroll
                for (int m = 0; m < 16; ++m) dl[j * LS + 4 * m + part] = (bf16)f2bf(xp[m]);
            }
            __syncthreads();
#pragma unroll 1
            for (int tl = wave * 6; tl < wave * 6 + 6; ++tl) { const int kind = tl >> 4, mt = (tl >> 2) & 3, nt = tl & 3; f32x4 acc = {0.f, 0.f, 0.f, 0.f};
                if (kind == 0) {
#pragma unroll
                    for (int ks = 0; ks < 2; ++ks) { const bf16x8 a = *(const LAS bf16x8*)(Mrb + (16 * mt + lr) * LS + 32 * ks + 8 * lq), bq = *(const LAS bf16x8*)(ApT + (16 * nt + lr) * LS + 32 * ks + 8 * lq);
                        acc = __builtin_amdgcn_mfma_f32_16x16x32_bf16(a, bq, acc, 0, 0, 0); }
#pragma unroll
                    for (int i = 0; i < 4; ++i) { const int row = 16 * mt + 4 * lq + i, col = 16 * nt + lr; Kb[(t0 + row) * RW + h * 64 + col] = (bf16)f2bf(acc[i] + bf2f(Rt[row * LS + col])); }
                } else if (kind == 1) {
#pragma unroll
                    for (int ks = 0; ks < 2; ++ks) { const bf16x8 a = *(const LAS bf16x8*)(Mrb + (16 * mt + lr) * LS + 32 * ks + 8 * lq), bq = *(const LAS bf16x8*)(WT2 + (16 * nt + lr) * LS + 32 * ks + 8 * lq);
                        acc = __builtin_amdgcn_mfma_f32_16x16x32_bf16(a, bq, acc, 0, 0, 0);
                        const bf16x8 a2 = *(const LAS bf16x8*)(Mrk + (16 * mt + lr) * LS + 32 * ks + 8 * lq), b2 = *(const LAS bf16x8*)(VmT + (16 * nt + lr) * LS + 32 * ks + 8 * lq);
                        acc = __builtin_amdgcn_mfma_f32_16x16x32_bf16(a2, b2, acc, 0, 0, 0); }
                    *(GAS unsigned long long*)(YLT + (t0 + 16 * nt + lr) * RW + h * 64 + 16 * mt + 4 * lq) = (unsigned long long)pk2(acc[0], acc[1]) | ((unsigned long long)pk2(acc[2], acc[3]) << 32);
                } else {
#pragma unroll
                    for (int ks = 0; ks < 2; ++ks) { const bf16x8 a = *(const LAS bf16x8*)(VmT + (16 * mt + lr) * LS + 32 * ks + 8 * lq), bq = *(const LAS bf16x8*)(KhT + (16 * nt + lr) * LS + 32 * ks + 8 * lq);
                        acc = __builtin_amdgcn_mfma_f32_16x16x32_bf16(a, bq, acc, 0, 0, 0); }
                    *(GAS unsigned long long*)((bf16*)(LW + (t0 + 16 * nt + lr) * RW + h * 64) + 16 * mt + 4 * lq) = (unsigned long long)pk2(acc[0], acc[1]) | ((unsigned long long)pk2(acc[2], acc[3]) << 32);
                } }
            *(GAS v4u*)(AVb + (t0 + c) * RW + h * 64 + kq * 8) = *(const LAS v4u*)(BhT + c * LS + kq * 8);
            *(GAS v4u*)(BVb + (t0 + c) * RW + h * 64 + kq * 8) = *(const LAS v4u*)(WT2 + c * LS + kq * 8);
            { unsigned short e[8];
#pragma unroll
              for (int i = 0; i < 8; ++i) e[i] = ApT[(kq * 8 + i) * LS + c];
              *(GAS v4u*)(Rb + (t0 + c) * RW + h * 64 + kq * 8) = (v4u){(unsigned)e[0] | ((unsigned)e[1] << 16), (unsigned)e[2] | ((unsigned)e[3] << 16), (unsigned)e[4] | ((unsigned)e[5] << 16), (unsigned)e[6] | ((unsigned)e[7] << 16)}; }
            __syncthreads();
        }
        if (BOTH(PH_CHUNK)) GRID_BAR();
    }

    if (IN(PH_SEQ)) {
        if (vcu < BATCH * 8) {
            constexpr int LS = 72; constexpr int BUFB = 56320;
            const bf16* const APg = (const bf16*)(ws + WS_R); const bf16* const RPg = (const bf16*)(ws + WS_KP); const bf16* const BHg = (const bf16*)(ws + WS_AV);
            const bf16* const WTg = (const bf16*)((unsigned char*)out + DO_BV); const float* const GTg = (const float*)((unsigned char*)out + DO_DEC);
            const bf16* const YLT = (const bf16*)(ws + WS_YLT); const float* const GC = (const float*)(ws + WS_GC);
            float* const Y = (float*)(ws + WS_Y);
            const int b = vcu >> 3, h = vcu & 7;
            LAS bf16* const Sbf = (LAS bf16*)(lds + 2 * BUFB); LAS bf16* const UT = (LAS bf16*)(lds + 2 * BUFB + 9216);
            const int row = tid >> 3, piece = tid & 7, lr = lane & 15, lq = lane >> 4, q = wave;
            for (int i = tid; i < 9216 / 4; i += 512) ((LAS unsigned*)Sbf)[i] = 0u;
            f32x4 st[4];
#pragma unroll
            for (int kt = 0; kt < 4; ++kt) st[kt] = (f32x4){0.f, 0.f, 0.f, 0.f};
            v4u pre[6]; v4u pgc = {0u, 0u, 0u, 0u};
#define SEQ_LOAD(ck) do { const size_t go = ((size_t)b * SEQ + (size_t)(ck) * 64 + row) * RW + h * 64 + piece * 8; \
        pre[0] = *(const GAS v4u*)(APg + go); pre[1] = *(const GAS v4u*)(RPg + go); pre[2] = *(const GAS v4u*)(BHg + go); pre[3] = *(const GAS v4u*)(WTg + go); pre[4] = *(const GAS v4u*)(YLT + go); \
        pre[5] = *(const GAS v4u*)((const bf16*)(GTg + ((size_t)b * SEQ + (size_t)(ck) * 64 + row) * RW + h * 64) + piece * 8); \
        if (tid < 16) pgc = *(const GAS v4u*)(GC + ((size_t)((b * 8 + h) * 128 + (ck))) * 64 + tid * 4); } while (0)
#define SEQ_STORE(bi) do { LAS unsigned char* bb_ = lds + (bi) * BUFB; _Pragma("unroll") for (int a_ = 0; a_ < 6; ++a_) *(LAS v4u*)(bb_ + a_ * 9216 + (row * LS + piece * 8) * 2) = pre[a_]; \
        if (tid < 16) *(LAS v4u*)(bb_ + 55296 + tid * 16) = pgc; } while (0)
            SEQ_LOAD(0); SEQ_STORE(0); __syncthreads();
            for (int ck = 0; ck < SEQ / 64; ++ck) {
                if (ck + 1 < SEQ / 64) SEQ_LOAD(ck + 1);
                if (wave < 4) {
                    const LAS unsigned char* bb = lds + (ck & 1) * BUFB;
                    const LAS bf16* AP = (const LAS bf16*)(bb); const LAS bf16* RP = (const LAS bf16*)(bb + 9216); const LAS bf16* BH = (const LAS bf16*)(bb + 18432);
                    const LAS bf16* WT = (const LAS bf16*)(bb + 27648); const LAS bf16* YL = (const LAS bf16*)(bb + 36864); const LAS bf16* GT = (const LAS bf16*)(bb + 46080);
                    const LAS float* GCl = (const LAS float*)(bb + 55296);
                    const bf16x8 s0 = *(const LAS bf16x8*)(Sbf + (16 * q + lr) * LS + 8 * lq), s1 = *(const LAS bf16x8*)(Sbf + (16 * q + lr) * LS + 32 + 8 * lq);
                    f32x4 u[4], y[4];
#pragma unroll
                    for (int ct = 0; ct < 4; ++ct) {
                        const v2u w4 = *(const LAS v2u*)(WT + (16 * q + lr) * LS + 16 * ct + 4 * lq), y4 = *(const LAS v2u*)(YL + (16 * q + lr) * LS + 16 * ct + 4 * lq);
                        u[ct] = (f32x4){bflo(w4.x), bfhi(w4.x), bflo(w4.y), bfhi(w4.y)}; y[ct] = (f32x4){bflo(y4.x), bfhi(y4.x), bflo(y4.y), bfhi(y4.y)};
                        const bf16x8 a0 = *(const LAS bf16x8*)(AP + (16 * ct + lr) * LS + 8 * lq), a1 = *(const LAS bf16x8*)(AP + (16 * ct + lr) * LS + 32 + 8 * lq);
                        const bf16x8 r0 = *(const LAS bf16x8*)(RP + (16 * ct + lr) * LS + 8 * lq), r1 = *(const LAS bf16x8*)(RP + (16 * ct + lr) * LS + 32 + 8 * lq);
                        u[ct] = __builtin_amdgcn_mfma_f32_16x16x32_bf16(a0, s0, u[ct], 0, 0, 0); u[ct] = __builtin_amdgcn_mfma_f32_16x16x32_bf16(a1, s1, u[ct], 0, 0, 0);
                        y[ct] = __builtin_amdgcn_mfma_f32_16x16x32_bf16(r0, s0, y[ct], 0, 0, 0); y[ct] = __builtin_amdgcn_mfma_f32_16x16x32_bf16(r1, s1, y[ct], 0, 0, 0);
                    }
#pragma unroll
                    for (int ct = 0; ct < 4; ++ct) {
                        *(LAS v2u*)(UT + (16 * q + lr) * LS + 16 * ct + 4 * lq) = (v2u){pk2(u[ct][0], u[ct][1]), pk2(u[ct][2], u[ct][3])};
#pragma unroll
                        for (int i = 0; i < 4; ++i) Y[((size_t)b * SEQ + (size_t)ck * 64 + 16 * ct + 4 * lq + i) * RW + h * 64 + 16 * q + lr] = y[ct][i];
                    }
                    const bf16x8 ua = *(const LAS bf16x8*)(UT + (16 * q + lr) * LS + 8 * lq), ub = *(const LAS bf16x8*)(UT + (16 * q + lr) * LS + 32 + 8 * lq);
#pragma unroll
                    for (int kt = 0; kt < 4; ++kt) {
                        const v2u g4 = *(const LAS v2u*)(GT + (16 * kt + lr) * LS + 16 * q + 4 * lq); const float gam = GCl[16 * kt + lr];
                        st[kt] = st[kt] * gam + (f32x4){bflo(g4.x), bfhi(g4.x), bflo(g4.y), bfhi(g4.y)};
                        const bf16x8 b0 = *(const LAS bf16x8*)(BH + (16 * kt + lr) * LS + 8 * lq), b1 = *(const LAS bf16x8*)(BH + (16 * kt + lr) * LS + 32 + 8 * lq);
                        st[kt] = __builtin_amdgcn_mfma_f32_16x16x32_bf16(ua, b0, st[kt], 0, 0, 0); st[kt] = __builtin_amdgcn_mfma_f32_16x16x32_bf16(ub, b1, st[kt], 0, 0, 0);
#pragma unroll
                        for (int i = 0; i < 4; ++i) Sbf[(16 * q + 4 * lq + i) * LS + 16 * kt + lr] = (bf16)f2bf(st[kt][i]);
                    }
                }
                if (ck + 1 < SEQ / 64) SEQ_STORE((ck + 1) & 1);
                __syncthreads();
            }
#undef SEQ_LOAD
#undef SEQ_STORE
        }
        if (BOTH(PH_SEQ)) GRID_BAR();
    }

    if (IN(PH_POST)) {
        const float* const Y = (const float*)(ws + WS_Y); const bf16* const Vb = (const bf16*)(ws + WS_V); const bf16* const GTb = (const bf16*)((unsigned char*)out + DO_GT);
        const float* const BONUS = (const float*)(ws + WS_BONUS); bf16* const ORW = (bf16*)(ws + WS_ORW);
        const float lnw = args.in[13][tid], lnb = args.in[14][tid];
        for (int t = vcu; t < T; t += G) { const size_t o = (size_t)t * RW + tid;
            const float y = Y[o]; const float mean = wave_sum(y) * (1.f / 64.f); const float dy = y - mean; const float var = wave_sum(dy * dy) * (1.f / 64.f);
            const float yn = dy * (1.f / sqrtf(var + GN_EPS)) * lnw + lnb;
            const float res = (yn + BONUS[(size_t)t * 8 + wave] * bf2f(Vb[o])) * bf2f(GTb[o]);
            ORW[o] = (bf16)f2bf(res); }
        if (BOTH(PH_POST)) GRID_BAR();
    }

    if (IN(PH_UPA)) {
        pg8::Gemm g{(const bf16*)(ws + WS_OA), WauT, T, D, 256}; pg8::StaticOrder S; S.init(T, D, G, (int)blockIdx.x);
        pg8::EpiGateF32 E{out, ZG, ZG_LD, 0};
        pg8::gemm_phase<pg8::EpiGateF32, pg8::StaticOrder, PG8_ALIGN, PG8_SP2>(lds + RING_OFF, g, S, E);
        if (BOTH(PH_UPA)) GRID_BAR();
    }
    if (IN(PH_UPR)) {
        pg8::Gemm g{(const bf16*)(ws + WS_ORW), WruT, T, D, 512}; pg8::StaticOrder S; S.init(T, D, G, (int)blockIdx.x);
        pg8::EpiMerge E{out, ZG, ZG_LD, 1024, (bf16*)(ws + WS_M1)};
        pg8::gemm_phase<pg8::EpiMerge, pg8::StaticOrder, PG8_ALIGN, PG8_SP2>(lds + RING_OFF, g, S, E);
        if (BOTH(PH_UPR)) GRID_BAR();
    }
    if (IN(PH_WO)) {
        pg8::Gemm g{(const bf16*)(ws + WS_M1), WoT, T, D, D}; pg8::StaticOrder S; S.init(T, D, G, (int)blockIdx.x);
        pg8::EpiF32<0> E{(float*)(ws + WS_TMP2A)};
        pg8::gemm_phase<pg8::EpiF32<0>, pg8::StaticOrder, PG8_ALIGN, PG8_SP2>(lds + RING_OFF, g, S, E);
        if (BOTH(PH_WO)) GRID_BAR();
    }
    if (IN(PH_ROWA)) {
        const float* const tmp = (const float*)(ws + WS_TMP2A); const float* const g1 = args.in[18]; const float* const g2 = args.in[19];
        for (int m = gw; m < T; m += NGW) {
            const GAS f32x4* tr = (const GAS f32x4*)(tmp + (size_t)m * D) + lane; const GAS f32x4* xr = (const GAS f32x4*)(x + (size_t)m * D) + lane;
            f32x4 v[4]; float s = 0.f;
#pragma unroll
            for (int j = 0; j < 4; ++j) { v[j] = tr[64 * j]; s += (v[j].x * v[j].x + v[j].y * v[j].y) + (v[j].z * v[j].z + v[j].w * v[j].w); }
            const float rs = 1.f / sqrtf(wave_sum(s) * (1.f / D) + NORM_EPS); float s2 = 0.f;
#pragma unroll
            for (int j = 0; j < 4; ++j) { const f32x4 gg = ((const GAS f32x4*)g1)[lane + 64 * j]; const f32x4 xx = xr[64 * j];
                v[j].x = xx.x + v[j].x * rs * gg.x; v[j].y = xx.y + v[j].y * rs * gg.y; v[j].z = xx.z + v[j].z * rs * gg.z; v[j].w = xx.w + v[j].w * rs * gg.w;
                ((GAS f32x4*)(out + (size_t)m * D))[lane + 64 * j] = v[j];
                s2 += (v[j].x * v[j].x + v[j].y * v[j].y) + (v[j].z * v[j].z + v[j].w * v[j].w); }
            const float rs2 = 1.f / sqrtf(wave_sum(s2) * (1.f / D) + NORM_EPS);
            GAS unsigned long long* o8 = (GAS unsigned long long*)(XN + (size_t)m * D) + lane;
#pragma unroll
            for (int j = 0; j < 4; ++j) { const f32x4 gg = ((const GAS f32x4*)g2)[lane + 64 * j];
                o8[64 * j] = (unsigned long long)pk2(v[j].x * rs2 * gg.x, v[j].y * rs2 * gg.y) | ((unsigned long long)pk2(v[j].z * rs2 * gg.z, v[j].w * rs2 * gg.w) << 32); }
        }
        if (BOTH(PH_ROWA)) GRID_BAR();
    }
    if (IN(PH_FFI)) {
        pg8::Gemm g{XN, WfiT, T, FF, D}; pg8::StaticOrder S; S.init(T, FF, G, (int)blockIdx.x);
        pg8::EpiRelu2 E{(bf16*)(ws + WS_H)};
        pg8::gemm_phase<pg8::EpiRelu2, pg8::StaticOrder, PG8_ALIGN, PG8_SP2>(lds + RING_OFF, g, S, E);
        if (BOTH(PH_FFI)) GRID_BAR();
    }
    if (IN(PH_FFO)) {
        pg8::Gemm g{(const bf16*)(ws + WS_H), WfoT, T, D, FF}; pg8::StaticOrder S; S.init(T, D, G, (int)blockIdx.x);
        pg8::EpiF32<0> E{(float*)(ws + WS_TMP2B)};
        pg8::gemm_phase<pg8::EpiF32<0>, pg8::StaticOrder, PG8_ALIGN, PG8_SP2>(lds + RING_OFF, g, S, E);
        if (BOTH(PH_FFO)) GRID_BAR();
    }
    if (IN(PH_ROWB)) {
        const float* const tmp = (const float*)(ws + WS_TMP2B); const float* const g1 = args.in[22];
        for (int m = gw; m < T; m += NGW) {
            const GAS f32x4* tr = (const GAS f32x4*)(tmp + (size_t)m * D) + lane; GAS f32x4* hr = (GAS f32x4*)(out + (size_t)m * D) + lane;
            f32x4 v[4]; float s = 0.f;
#pragma unroll
            for (int j = 0; j < 4; ++j) { v[j] = tr[64 * j]; s += (v[j].x * v[j].x + v[j].y * v[j].y) + (v[j].z * v[j].z + v[j].w * v[j].w); }
            const float rs = 1.f / sqrtf(wave_sum(s) * (1.f / D) + NORM_EPS);
            GAS unsigned long long* o8 = (GAS unsigned long long*)(XN + (size_t)m * D) + lane;
#pragma unroll
            for (int j = 0; j < 4; ++j) { const f32x4 gg = ((const GAS f32x4*)g1)[lane + 64 * j]; const f32x4 hh = hr[64 * j];
                v[j].x = hh.x + v[j].x * rs * gg.x; v[j].y = hh.y + v[j].y * rs * gg.y; v[j].z = hh.z + v[j].z * rs * gg.z; v[j].w = hh.w + v[j].w * rs * gg.w;
                hr[64 * j] = v[j];
                o8[64 * j] = (unsigned long long)pk2(v[j].x, v[j].y) | ((unsigned long long)pk2(v[j].z, v[j].w) << 32); }
        }
        if (BOTH(PH_ROWB)) GRID_BAR();
    }
    if (IN(PH_PLE)) {
        pg8::Gemm g{PB, WpleT, T, D, PLE}; pg8::StaticOrder S; S.init(T, D, G, (int)blockIdx.x);
        pg8::EpiF32<0> E{(float*)(ws + WS_E)};
        pg8::gemm_phase<pg8::EpiF32<0>, pg8::StaticOrder, PG8_ALIGN, PG8_SP2>(lds + RING_OFF, g, S, E);
        if (BOTH(PH_PLE)) GRID_BAR();
    }
    if (IN(PH_PLEG)) {
        pg8::Gemm g{XN, WpgT, T, D, D}; pg8::StaticOrder S; S.init(T, D, G, (int)blockIdx.x);
        pg8::EpiF32<1> E{(float*)(ws + WS_E)};
        pg8::gemm_phase<pg8::EpiF32<1>, pg8::StaticOrder, PG8_ALIGN, PG8_SP2>(lds + RING_OFF, g, S, E);
        if (BOTH(PH_PLEG)) GRID_BAR();
    }
    if (IN(PH_ROWC)) {
        const float* const tmp = (const float*)(ws + WS_E); const float* const g1 = args.in[25];
        for (int m = gw; m < T; m += NGW) {
            const GAS f32x4* tr = (const GAS f32x4*)(tmp + (size_t)m * D) + lane; GAS f32x4* hr = (GAS f32x4*)(out + (size_t)m * D) + lane;
            f32x4 v[4]; float s = 0.f;
#pragma unroll
            for (int j = 0; j < 4; ++j) { v[j] = tr[64 * j]; s += (v[j].x * v[j].x + v[j].y * v[j].y) + (v[j].z * v[j].z + v[j].w * v[j].w); }
            const float rs = 1.f / sqrtf(wave_sum(s) * (1.f / D) + NORM_EPS);
#pragma unroll
            for (int j = 0; j < 4; ++j) { const f32x4 gg = ((const GAS f32x4*)g1)[lane + 64 * j]; const f32x4 hh = hr[64 * j];
                v[j].x = hh.x + v[j].x * rs * gg.x; v[j].y = hh.y + v[j].y * rs * gg.y; v[j].z = hh.z + v[j].z * rs * gg.z; v[j].w = hh.w + v[j].w * rs * gg.w;
                hr[64 * j] = v[j]; }
        }
    }
#undef IN
#undef BOTH
}

extern "C" void kernel_launch(void* const* d_in, const int* in_sizes, int n_in, void* d_out, int out_size, void* d_ws, size_t ws_size, hipStream_t stream) {
    static int grid = 0;
    if (grid == 0) {
        if (n_in != 26 || in_sizes[0] != T * D || out_size != T * D || ws_size < WS_END) { fprintf(stderr, "kernel_launch: shape/workspace mismatch (n_in %d, in0 %d, out %d, ws %zu)\n", n_in, n_in > 0 ? in_sizes[0] : -1, out_size, ws_size); grid = -1; return; }
        int dev = 0, cus = 0, per_cu = 0;
        if (hipGetDevice(&dev) != hipSuccess || hipDeviceGetAttribute(&cus, hipDeviceAttributeMultiprocessorCount, dev) != hipSuccess) { grid = -1; return; }
        if (hipFuncSetAttribute((const void*)skel_fwd, hipFuncAttributeMaxDynamicSharedMemorySize, LDS_BYTES) != hipSuccess) { fprintf(stderr, "kernel_launch: hipFuncSetAttribute failed\n"); grid = -1; return; }
        if (hipOccupancyMaxActiveBlocksPerMultiprocessor(&per_cu, (const void*)skel_fwd, NWAVES * 64, LDS_BYTES) != hipSuccess || per_cu < 1) { fprintf(stderr, "kernel_launch: occupancy query says %d\n", per_cu); }
        (void)hipGetLastError();
        grid = cus;
    }
    if (grid < 0) return;
    if (hipMemsetAsync((char*)d_ws + WS_CTL, 0, CTL_ZERO_BYTES, stream) != hipSuccess) return;
    Args a{};
    for (int i = 0; i < 26; ++i) a.in[i] = (const float*)d_in[i];
    a.out = (float*)d_out; a.ws = (unsigned char*)d_ws;
#if MK_PER_PHASE
    for (int li = 0; li < N_PHASES; ++li) { a.ph_lo = li; a.ph_hi = li + 1; a.li = li; hipLaunchKernelGGL(skel_fwd, dim3(grid), dim3(NWAVES * 64), LDS_BYTES, stream, a); }
#else
    a.ph_lo = 0; a.ph_hi = N_PHASES; a.li = 0; hipLaunchKernelGGL(skel_fwd, dim3(grid), dim3(NWAVES * 64), LDS_BYTES, stream, a);
#endif
}
```

```cpp
#include <hip/hip_runtime.h>
#include <cstdio>
#include <cstdint>
namespace pg8 {
#define PG8_LAS __attribute__((address_space(3)))
typedef unsigned short bf16_t;
typedef short bf16x8 __attribute__((ext_vector_type(8)));
typedef float f32x4 __attribute__((ext_vector_type(4)));
typedef unsigned u32x4 __attribute__((ext_vector_type(4)));
constexpr int BM = 256, BK = 64, HALF = 128, HTB = HALF * BK * 2  , STAGE_BYTES = 8 * HTB, NXCD = 8, WGM = 8;

__host__ __device__ __forceinline__ int lds_byte(int r, int c) { const int st = (r >> 4) * 2 + (c >> 5), rr = r & 15, cc = c & 31, ob = rr * 64 + cc * 2; return st * 1024 + (ob ^ (((ob >> 9) & 1) << 5)); }
__host__ __device__ __forceinline__ void stage_rc(int b, int& R, int& C) { const int st = b / 1024, sb = b % 1024, swz = sb ^ (((sb >> 9) & 1) << 5); R = (st >> 1) * 16 + swz / 64; C = (st & 1) * 32 + (swz % 64) / 2; }
__host__ __device__ __forceinline__ int perm32(int rho) { const int n = rho >> 4, i = rho & 15; return 8 * (i >> 2) + 4 * n + (i & 3); }

struct Unit { int pm, pn; };
struct Gemm { const bf16_t* A; const bf16_t* Bt; int M, N, K; };

struct StaticOrder {
    int nM, nN, nwg, G, c;
    __host__ __device__ void init(int M, int N, int G_, int c_) { nM = M / BM; nN = N / BM; nwg = nM * nN; G = G_; c = c_; }
    __host__ __device__ bool next(int i, Unit& u) const {
        const long L = (long)i * G + c; if (L >= nwg) return false;
        int wgid = (int)L; { const int q = nwg / NXCD, r = nwg % NXCD, xcd = wgid % NXCD, off = wgid / NXCD; wgid = (xcd < r ? xcd * (q + 1) : r * (q + 1) + (xcd - r) * q) + off; }
        const int nig = WGM * nN, gid = wgid / nig, fm = gid * WGM, gsz = (nM - fm) < WGM ? (nM - fm) : WGM;
        u.pm = fm + ((wgid % nig) % gsz); u.pn = (wgid % nig) / gsz; return true;
    }
    __device__ __forceinline__ void a_ready(const Unit&) const {}
    __device__ __forceinline__ void done(const Unit&) const {}
};

__device__ __forceinline__ unsigned cvt_pk_bf16(float lo, float hi) { unsigned r; asm volatile("v_cvt_pk_bf16_f32 %0, %1, %2" : "=v"(r) : "v"(lo), "v"(hi)); return r; }
typedef float f32x2 __attribute__((ext_vector_type(2)));
__device__ __forceinline__ f32x2 gelu_pk(f32x2 v) {
    const f32x2 av = __builtin_elementwise_abs(v), d = av * 0.2316418882f + 1.0f;
    f32x2 t; t.x = __builtin_amdgcn_rcpf(d.x); t.y = __builtin_amdgcn_rcpf(d.y);
    f32x2 q = t * 0.5307027145f + (-0.7265760135f); q = q * t + 0.7107068705f; q = q * t + (-0.142248368f); q = q * t + 0.127414796f; q = q * t;
    const f32x2 s = (v * v) * (-0.72134752044f);
    f32x2 e; e.x = __builtin_amdgcn_exp2f(s.x); e.y = __builtin_amdgcn_exp2f(s.y);
    const f32x2 m = v * (q * e), r = v - m;
    f32x2 o; o.x = v.x < 0.f ? m.x : r.x; o.y = v.y < 0.f ? m.y : r.y; return o;
}

template <int ACT  > struct EpiBf16 {
    static constexpr bool PERM = true, AFTER_DRAIN = false; static_assert(ACT == 0 || ACT == 1, "EpiBf16: ACT is 0 (none) or 1 (gelu_pk)");
    bf16_t* O; int ldc; const float* bias; int split_cols; size_t split_stride; float scale0;
    __device__ __forceinline__ void operator()(const f32x4 (&acc)[2][2][4][2], const Unit& u, int wr, int wc, int fr, int fq) const {
        const int row0 = u.pm * BM + wr * 64 + fr; int colt = u.pn * BM; bf16_t* base = O;
        float sc = 1.f; if (split_cols) { const int t = colt / split_cols; base += (size_t)t * split_stride; colt -= t * split_cols; if (t == 0) sc = scale0; }
        const int col0 = colt + wc * 32 + 8 * fq, bcol0 = u.pn * BM + wc * 32 + 8 * fq;
        f32x4 bv[2][2];
#pragma unroll
        for (int bj = 0; bj < 2; ++bj)
#pragma unroll
            for (int n = 0; n < 2; ++n) bv[bj][n] = bias ? *(const f32x4*)(bias + bcol0 + bj * HALF + 4 * n) : (f32x4){0.f, 0.f, 0.f, 0.f};
#pragma unroll
        for (int ai = 0; ai < 2; ++ai)
#pragma unroll
            for (int m = 0; m < 4; ++m) { bf16_t* rowp = base + (size_t)(row0 + ai * HALF + m * 16) * ldc + col0;
#pragma unroll
                for (int bj = 0; bj < 2; ++bj) { f32x4 v0 = acc[ai][bj][m][0] + bv[bj][0], v1 = acc[ai][bj][m][1] + bv[bj][1];
                    if (ACT == 1) { f32x2 a = gelu_pk((f32x2){v0[0], v0[1]}), b = gelu_pk((f32x2){v0[2], v0[3]}), c = gelu_pk((f32x2){v1[0], v1[1]}), d = gelu_pk((f32x2){v1[2], v1[3]});
                        v0 = (f32x4){a.x, a.y, b.x, b.y}; v1 = (f32x4){c.x, c.y, d.x, d.y}; }
                    v0 = v0 * sc; v1 = v1 * sc; u32x4 w; w.x = cvt_pk_bf16(v0[0], v0[1]); w.y = cvt_pk_bf16(v0[2], v0[3]); w.z = cvt_pk_bf16(v1[0], v1[1]); w.w = cvt_pk_bf16(v1[2], v1[3]);
                    *(u32x4*)(rowp + bj * HALF) = w; } }
    }
};
template <class Epi, class Sched, bool ALIGN_EPI = false, bool SP2 = false>
__device__ __forceinline__ void gemm_phase(PG8_LAS unsigned char* lds, const Gemm g, const Sched& S, const Epi& E) {
    const int tid = threadIdx.x, wid = __builtin_amdgcn_readfirstlane(tid >> 6), lane = tid & 63, wr = wid >> 2, wc = wid & 3, fr = lane & 15, fq = lane >> 4;
    const int K = g.K, nt = K / BK;
    unsigned voffA[2], voffB[2];
#pragma unroll
    for (int i = 0; i < 2; ++i) { int R, C; stage_rc(tid * 16 + i * 8192, R, C); const int Rb = Epi::PERM ? ((R & ~31) + perm32(R & 31)) : R;
        voffA[i] = (unsigned)(R * K + C) * 2u; voffB[i] = (unsigned)(Rb * K + C) * 2u; }
    const size_t kstep = (size_t)(BK * 2);
    const size_t hstep = (size_t)HALF * K * 2;
    const size_t tstep = 2 * hstep;
    const unsigned ldsw = (unsigned)wid * 1024u;
    const int aoff = lds_byte(wr * 64 + fr, fq * 8), boff = lds_byte(wc * 32 + fr, fq * 8);
#define PG8_SA(b, h) (((b) * 2 + (h)) * HTB)
#define PG8_SB(b, h) ((4 + (b) * 2 + (h)) * HTB)
#define PG8_STAGE(bufoff, gbase, voff) do { _Pragma("unroll") for (int _i = 0; _i < 2; ++_i) \
        __builtin_amdgcn_global_load_lds((const unsigned*)((const char*)(gbase) + (voff)[_i]), (PG8_LAS unsigned*)(lds + (bufoff) + ldsw + _i * 8192), 16, 0, 0); } while (0)
#define PG8_LDA(dst, b, h) do { _Pragma("unroll") for (int m = 0; m < 4; ++m) _Pragma("unroll") for (int k = 0; k < 2; ++k) dst[m][k] = *(const PG8_LAS bf16x8*)(lds + PG8_SA(b, h) + aoff + m * 2048 + k * 1024); } while (0)
#define PG8_LDB(dst, b, h) do { _Pragma("unroll") for (int n = 0; n < 2; ++n) _Pragma("unroll") for (int k = 0; k < 2; ++k) dst[n][k] = *(const PG8_LAS bf16x8*)(lds + PG8_SB(b, h) + boff + n * 2048 + k * 1024); } while (0)
#define PG8_MMA(ai, bj, At, Bt) do { __builtin_amdgcn_s_setprio(1); _Pragma("unroll") for (int m = 0; m < 4; ++m) _Pragma("unroll") for (int n = 0; n < 2; ++n) _Pragma("unroll") for (int k = 0; k < 2; ++k) \
        acc[ai][bj][m][n] = __builtin_amdgcn_mfma_f32_16x16x32_bf16(Bt[n][k], At[m][k], acc[ai][bj][m][n], 0, 0, 0); __builtin_amdgcn_s_setprio(0); } while (0)
#define PG8_WAIT_V(n) asm volatile("s_waitcnt vmcnt(" #n ")" ::: "memory")
#define PG8_WAIT_L(n) asm volatile("s_waitcnt lgkmcnt(" #n ")" ::: "memory")
#define PG8_BAR __builtin_amdgcn_s_barrier()
#define PG8_SCHED __builtin_amdgcn_sched_barrier(0)
    Unit cur, nxt; int ui = 0;
    if (!S.next(0, cur)) return;
    f32x4 acc[2][2][4][2];
#pragma unroll
    for (int a = 0; a < 2; ++a)
#pragma unroll
        for (int b = 0; b < 2; ++b)
#pragma unroll
            for (int m = 0; m < 4; ++m)
#pragma unroll
                for (int n = 0; n < 2; ++n) acc[a][b][m][n] = (f32x4){0.f, 0.f, 0.f, 0.f};
    bf16x8 At[4][2], B0[2][2], B1[2][2];
    const char* cA = (const char*)g.A + (size_t)cur.pm * tstep; const char* cB = (const char*)g.Bt + (size_t)cur.pn * tstep;
    S.a_ready(cur);
    if constexpr (SP2) {
        PG8_STAGE(PG8_SB(0, 0), cB, voffB); PG8_STAGE(PG8_SB(0, 1), cB + hstep, voffB); PG8_STAGE(PG8_SA(0, 0), cA, voffA); PG8_STAGE(PG8_SA(0, 1), cA + hstep, voffA);
        if (wr == 1) PG8_BAR;
        PG8_WAIT_V(2); PG8_BAR;
        PG8_STAGE(PG8_SB(1, 0), cB + kstep, voffB); PG8_STAGE(PG8_SA(1, 0), cA + kstep, voffA); PG8_STAGE(PG8_SB(1, 1), cB + hstep + kstep, voffB);
        PG8_WAIT_V(6); PG8_BAR;
    } else {
        PG8_STAGE(PG8_SB(0, 0), cB, voffB); PG8_STAGE(PG8_SA(0, 0), cA, voffA); PG8_STAGE(PG8_SB(0, 1), cB + hstep, voffB); PG8_STAGE(PG8_SA(0, 1), cA + hstep, voffA);
        if (wr == 1) PG8_BAR;
        PG8_WAIT_V(4); PG8_BAR;
        PG8_STAGE(PG8_SB(1, 0), cB + kstep, voffB); PG8_STAGE(PG8_SA(1, 0), cA + kstep, voffA); PG8_STAGE(PG8_SB(1, 1), cB + hstep + kstep, voffB);
        PG8_WAIT_V(6); PG8_BAR;
    }
    for (;;) {
        const bool has_next = S.next(ui + 1, nxt);
        const char* nA = has_next ? (const char*)g.A + (size_t)nxt.pm * tstep : cA; const char* nB = has_next ? (const char*)g.Bt + (size_t)nxt.pn * tstep : cB;
        for (int t = 0; t < nt; t += 2) {
            const bool last = (t == nt - 2);
            const char* a1 = cA + (size_t)(t + 1) * kstep;
            const char* a2 = last ? nA : cA + (size_t)(t + 2) * kstep; const char* b2 = last ? nB : cB + (size_t)(t + 2) * kstep;
            const char* a3 = a2 + kstep; const char* b3 = b2 + kstep;
            if (last && has_next) S.a_ready(nxt);
            if constexpr (SP2) {
            PG8_LDB(B0, 0, 0); PG8_LDB(B1, 0, 1); PG8_SCHED; PG8_LDA(At, 0, 0); PG8_STAGE(PG8_SA(1, 1), a1 + hstep, voffA);
            PG8_WAIT_V(8); PG8_WAIT_L(0); PG8_BAR; PG8_MMA(0, 0, At, B0); PG8_MMA(0, 1, At, B1); PG8_BAR; PG8_SCHED;
            PG8_LDA(At, 0, 1); PG8_STAGE(PG8_SB(0, 0), b2, voffB); PG8_STAGE(PG8_SB(0, 1), b2 + hstep, voffB); PG8_STAGE(PG8_SA(0, 0), a2, voffA);
            PG8_WAIT_V(8); PG8_WAIT_L(0); PG8_BAR; PG8_MMA(1, 0, At, B0); PG8_MMA(1, 1, At, B1); PG8_BAR; PG8_SCHED;
            PG8_LDB(B0, 1, 0); PG8_LDB(B1, 1, 1); PG8_SCHED; PG8_LDA(At, 1, 0); PG8_STAGE(PG8_SA(0, 1), a2 + hstep, voffA);
            PG8_WAIT_V(8); PG8_WAIT_L(0); PG8_BAR; PG8_MMA(0, 0, At, B0); PG8_MMA(0, 1, At, B1); PG8_BAR; PG8_SCHED;
            PG8_LDA(At, 1, 1); PG8_STAGE(PG8_SB(1, 0), b3, voffB); PG8_STAGE(PG8_SB(1, 1), b3 + hstep, voffB); PG8_STAGE(PG8_SA(1, 0), a3, voffA);
            PG8_WAIT_V(8); PG8_WAIT_L(0); PG8_BAR; PG8_MMA(1, 0, At, B0); PG8_MMA(1, 1, At, B1); PG8_BAR; PG8_SCHED;
            } else {
            PG8_LDB(B0, 0, 0); PG8_SCHED; PG8_LDA(At, 0, 0); PG8_STAGE(PG8_SA(1, 1), a1 + hstep, voffA);
            PG8_WAIT_L(8); PG8_BAR; PG8_WAIT_L(0); PG8_MMA(0, 0, At, B0); PG8_BAR; PG8_SCHED;
            PG8_LDB(B1, 0, 1); PG8_STAGE(PG8_SB(0, 0), b2, voffB);
            PG8_BAR; PG8_WAIT_L(0); PG8_MMA(0, 1, At, B1); PG8_BAR;
            PG8_LDA(At, 0, 1); PG8_STAGE(PG8_SA(0, 0), a2, voffA);
            PG8_BAR; PG8_WAIT_L(0); PG8_MMA(1, 0, At, B0); PG8_BAR; PG8_SCHED;
            PG8_STAGE(PG8_SB(0, 1), b2 + hstep, voffB);
            PG8_WAIT_V(6); PG8_BAR; PG8_MMA(1, 1, At, B1); PG8_BAR;
            PG8_LDB(B0, 1, 0); PG8_SCHED; PG8_LDA(At, 1, 0); PG8_STAGE(PG8_SA(0, 1), a2 + hstep, voffA);
            PG8_WAIT_L(8); PG8_BAR; PG8_WAIT_L(0); PG8_MMA(0, 0, At, B0); PG8_BAR; PG8_SCHED;
            PG8_LDB(B1, 1, 1); PG8_STAGE(PG8_SB(1, 0), b3, voffB);
            PG8_BAR; PG8_WAIT_L(0); PG8_MMA(0, 1, At, B1); PG8_BAR;
            PG8_LDA(At, 1, 1); PG8_STAGE(PG8_SA(1, 0), a3, voffA);
            PG8_BAR; PG8_WAIT_L(0); PG8_MMA(1, 0, At, B0); PG8_BAR; PG8_SCHED;
            PG8_STAGE(PG8_SB(1, 1), b3 + hstep, voffB);
            PG8_WAIT_V(6); PG8_BAR; PG8_MMA(1, 1, At, B1); PG8_BAR;
            }
        }
        if constexpr (ALIGN_EPI) { if (wr == 0) PG8_BAR; }
        if constexpr (!Epi::AFTER_DRAIN) { E(acc, cur, wr, wc, fr, fq); S.done(cur); }
        if (!has_next) break;
#pragma unroll
        for (int a = 0; a < 2; ++a)
#pragma unroll
            for (int b = 0; b < 2; ++b)
#pragma unroll
                for (int m = 0; m < 4; ++m)
#pragma unroll
                    for (int n = 0; n < 2; ++n) acc[a][b][m][n] = (f32x4){0.f, 0.f, 0.f, 0.f};
        cur = nxt; cA = nA; cB = nB; ++ui;
        if constexpr (ALIGN_EPI) { if (wr == 1) PG8_BAR; }
    }
    PG8_WAIT_V(0);
    if constexpr (!ALIGN_EPI) { if (wr == 0) PG8_BAR; }
    PG8_BAR;
    if constexpr (Epi::AFTER_DRAIN) { E.fused(acc, cur, wr, wc, fr, fq, lds, wid, lane); S.done(cur); }
#undef PG8_SA
#undef PG8_SB
#undef PG8_STAGE
#undef PG8_LDA
#undef PG8_LDB
#undef PG8_MMA
#undef PG8_WAIT_V
#undef PG8_WAIT_L
#undef PG8_BAR
#undef PG8_SCHED
}
}
#define GAS __attribute__((address_space(1)))
#define LAS __attribute__((address_space(3)))
typedef unsigned short bf16;
typedef unsigned v4u __attribute__((ext_vector_type(4)));
typedef float f32x4 __attribute__((ext_vector_type(4)));
typedef short bf16x8 __attribute__((ext_vector_type(8)));
typedef GAS unsigned gu32;
typedef GAS unsigned long long gu64;
#define RLX_AGENT __ATOMIC_RELAXED, __HIP_MEMORY_SCOPE_AGENT
#define LDS_WAIT() asm volatile("s_waitcnt lgkmcnt(0)" ::: "memory")
#define VM_WAIT() asm volatile("s_waitcnt vmcnt(0)" ::: "memory")
__device__ __forceinline__ unsigned long long rt() { return __builtin_amdgcn_s_memrealtime(); }
__device__ __forceinline__ unsigned f2bf(float f) { unsigned u = __builtin_bit_cast(unsigned, f); return (u + 0x7fffu + ((u >> 16) & 1u)) >> 16; }
__device__ __forceinline__ unsigned pk2(float lo, float hi) { return f2bf(lo) | (f2bf(hi) << 16); }

#define XB_TMO      128
#define XB_XCNT(j)  (256  + 64 * (j))
#define XB_XSUB(j)  (1280 + 64 * (j))
#define XB_XGEN(j)  (2304 + 64 * (j))
#define XB_TOP      3328
#define XB_TOPGEN   3392
#define XCD_BAR_WORDS 3456
#define XB_SPIN_CAP (1u << 18)

__device__ __forceinline__ unsigned xb_ld(unsigned* p)              { return __hip_atomic_load(p, __ATOMIC_RELAXED, __HIP_MEMORY_SCOPE_AGENT); }
__device__ __forceinline__ unsigned xb_add(unsigned* p, unsigned v) { return __hip_atomic_fetch_add(p, v, __ATOMIC_RELAXED, __HIP_MEMORY_SCOPE_AGENT); }
__device__ __forceinline__ unsigned xb_xcc_id() { return (unsigned)__builtin_amdgcn_s_getreg((3 << 11) | 20) & 0xFu; }
#define XB_SPIN(cond, bar) do { unsigned _sp = 0; while (cond) { __builtin_amdgcn_s_sleep(1); \
    if ((++_sp & 255u) == 0u) { if (xb_ld(&(bar)[XB_TMO])) break; if (_sp > XB_SPIN_CAP) { atomicAdd(&(bar)[XB_TMO], 1u); break; } } } } while (0)

struct XcdBarrier {
    unsigned* bar; unsigned x;
    volatile LAS unsigned* st;
};

__device__ __forceinline__ XcdBarrier xcd_barrier_post(unsigned* bar, volatile LAS unsigned* st) {
    XcdBarrier b; b.bar = bar; b.x = xb_xcc_id(); b.st = st;
    if (threadIdx.x == 0) (void)xb_add(&bar[XB_XCNT(b.x)], 1u);
    return b;
}
__device__ __forceinline__ void xcd_barrier_complete(unsigned* bar, unsigned x, unsigned& nloc, unsigned& nx) {
    const unsigned G = gridDim.x * gridDim.y * gridDim.z;
    unsigned sum, cnt, mine, sp = 0u;
    for (;;) {
        sum = 0u; cnt = 0u; mine = 0u;
#pragma unroll
        for (unsigned j = 0; j < 16; ++j) { const unsigned c = xb_ld(&bar[XB_XCNT(j)]); sum += c; cnt += (c > 0u) ? 1u : 0u; mine = (j == x) ? c : mine; }
        if (sum == G) break;
        __builtin_amdgcn_s_sleep(1);
        if ((++sp & 255u) == 0u) { if (xb_ld(&bar[XB_TMO])) break; if (sp > XB_SPIN_CAP) { atomicAdd(&bar[XB_TMO], 1u); break; } }
    }
    nloc = mine > 0u ? mine : 1u; nx = cnt > 0u ? cnt : 1u;
}

__device__ __forceinline__ void xcd_barrier(const XcdBarrier& b) {
    asm volatile("s_waitcnt vmcnt(0)" ::: "memory");
    __syncthreads();
    if (threadIdx.x == 0) {
        unsigned* bar = b.bar;
        __builtin_amdgcn_s_waitcnt(0);
        unsigned nloc = b.st[0], nx = b.st[1];
        if (nloc == 0u) { xcd_barrier_complete(bar, b.x, nloc, nx); b.st[0] = nloc; b.st[1] = nx; }
        const unsigned old = xb_add(&bar[XB_XSUB(b.x)], 1u);
        const unsigned gen = old / nloc;
        if (old + 1u == (gen + 1u) * nloc) {
            __builtin_amdgcn_fence(__ATOMIC_RELEASE, "agent");
            asm volatile("s_waitcnt vmcnt(0)" ::: "memory");
            const unsigned og = xb_add(&bar[XB_TOP], 1u);
            const unsigned tg = og / nx;
            if (og + 1u == (tg + 1u) * nx) xb_add(&bar[XB_TOPGEN], 1u);
            else XB_SPIN(xb_ld(&bar[XB_TOPGEN]) == tg, bar);
            __builtin_amdgcn_fence(__ATOMIC_ACQUIRE, "agent");
            xb_add(&bar[XB_XGEN(b.x)], 1u);
            asm volatile("s_waitcnt vmcnt(0)" ::: "memory");
        } else {
            XB_SPIN(xb_ld(&bar[XB_XGEN(b.x)]) == gen, bar);
            __builtin_amdgcn_fence(__ATOMIC_ACQUIRE, "agent");
            asm volatile("s_waitcnt vmcnt(0)" ::: "memory");
        }
    }
    __syncthreads();
}
#define PG8_SP2 true
#define PG8_ALIGN true

constexpr int NWAVES = 8;
constexpr int BATCH = 4, SEQ = 8192, D = 1024, T = BATCH * SEQ, HD = 64;
constexpr int NIN = 6144;
constexpr int FF = 4096, PLE = 256;
constexpr int ZA_LD = 2304, ZR_LD = 1792, ZG_LD = 2048;
constexpr int RW = 512;
constexpr float NORM_EPS = 1e-6f, GN_EPS = 64e-5f;
#ifndef MK_PER_PHASE
#define MK_PER_PHASE 0
#endif
enum { PH_PRO = 0, PH_INPROJ, PH_ATT, PH_PREP, PH_CHUNK, PH_SEQ, PH_POST, PH_UPA, PH_UPR, PH_WO, PH_ROWA, PH_FFI, PH_FFO, PH_ROWB, PH_PLE, PH_PLEG, PH_ROWC, N_PHASES };

constexpr size_t MiB = 1u << 20;
constexpr size_t WS_CTL = 0, CTL_ZERO_BYTES = 1 * MiB;
constexpr size_t WS_CS = 1 * MiB;
constexpr size_t WS_BONUS = 3 * MiB;
constexpr size_t WS_LSE = 4 * MiB;
constexpr size_t WS_WIN = 6 * MiB, WS_WFI = 18 * MiB, WS_WFO = 26 * MiB, WS_WO = 34 * MiB, WS_WPG = 36 * MiB;
constexpr size_t WS_WPLE = 38 * MiB, WS_WAU = 38 * MiB + 512 * 1024, WS_WRU = 39 * MiB;
constexpr size_t WS_XN = 40 * MiB;
constexpr size_t WS_PB = 104 * MiB;
constexpr size_t WS_ZA = 120 * MiB;
constexpr size_t WS_ZR = 264 * MiB;
constexpr size_t WS_ZG = 376 * MiB;
constexpr size_t WS_END = 512 * MiB;
constexpr size_t WS_OA = WS_XN;
constexpr size_t WS_R = WS_ZA, WS_KP = WS_ZA + 32 * MiB, WS_V = WS_ZA + 64 * MiB, WS_AV = WS_ZA + 96 * MiB;
constexpr size_t WS_Y = WS_ZR;
constexpr size_t WS_ORW = WS_ZR + 64 * MiB;
constexpr size_t WS_M1 = WS_ZA;
constexpr size_t WS_TMP2A = 184 * MiB;
constexpr size_t WS_H = WS_ZA;
constexpr size_t WS_TMP2B = WS_ZG;
constexpr size_t WS_E = WS_ZA;
constexpr size_t WS_OG = WS_XN + 16 * MiB;
constexpr size_t DO_DEC = 0;
constexpr size_t DO_BV = 64 * MiB, DO_GT = 96 * MiB;
constexpr size_t WS_YLT = WS_XN + 16 * MiB;
constexpr size_t WS_GC = 504 * MiB;
constexpr int CW_TMO = 0, CW_CODE = 1, CW_BAR = 4096;

constexpr int RING_OFF = 0, RING_BYTES = 143360;
constexpr int LDSCTL_OFF = RING_BYTES, MISC_OFF = LDSCTL_OFF + 320;
constexpr int LDS_BYTES = 147456;

typedef unsigned v2u __attribute__((ext_vector_type(2)));
__device__ __forceinline__ float bf2f(bf16 u) { return __builtin_bit_cast(float, (unsigned)u << 16); }
__device__ __forceinline__ float bflo(unsigned u) { return __builtin_bit_cast(float, u << 16); }
__device__ __forceinline__ float bfhi(unsigned u) { return __builtin_bit_cast(float, u & 0xffff0000u); }
__device__ __forceinline__ float sigmoidf_(float x) { return 1.0f / (1.0f + __expf(-x)); }
template <int CTRL> __device__ __forceinline__ float dpp_f(float v) { return __builtin_bit_cast(float, __builtin_amdgcn_update_dpp(0, __builtin_bit_cast(int, v), CTRL, 0xF, 0xF, true)); }
__device__ __forceinline__ float quad_sum(float v) { v += dpp_f<0xB1>(v); v += dpp_f<0x4E>(v); return v; }
__device__ __forceinline__ float wave_sum(float v) {
    v = quad_sum(v); v += dpp_f<0x141>(v); v += dpp_f<0x140>(v);
    return __builtin_bit_cast(float, __builtin_amdgcn_readlane(__builtin_bit_cast(int, v), 0)) + __builtin_bit_cast(float, __builtin_amdgcn_readlane(__builtin_bit_cast(int, v), 16)) +
           __builtin_bit_cast(float, __builtin_amdgcn_readlane(__builtin_bit_cast(int, v), 32)) + __builtin_bit_cast(float, __builtin_amdgcn_readlane(__builtin_bit_cast(int, v), 48));
}

namespace pg8 {
struct EpiInProj {
    static constexpr bool PERM = true, AFTER_DRAIN = false;
    bf16_t *za, *zr, *zg;
    __device__ __forceinline__ void operator()(const f32x4 (&acc)[2][2][4][2], const Unit& u, int wr, int wc, int fr, int fq) const {
        bf16_t* base; int ld, colt; bool sig = false;
        if (u.pn < 9) { base = za; ld = 2304; colt = u.pn * 256; }
        else if (u.pn < 16) { base = zr; ld = 1792; colt = (u.pn - 9) * 256; }
        else { base = zg; ld = 2048; colt = (u.pn - 16) * 256; sig = true; }
        const int row0 = u.pm * BM + wr * 64 + fr, col0 = colt + wc * 32 + 8 * fq;
#pragma unroll
        for (int ai = 0; ai < 2; ++ai)
#pragma unroll
            for (int m = 0; m < 4; ++m) { bf16_t* rowp = base + (size_t)(row0 + ai * HALF + m * 16) * ld + col0;
#pragma unroll
                for (int bj = 0; bj < 2; ++bj) { f32x4 v0 = acc[ai][bj][m][0], v1 = acc[ai][bj][m][1];
                    if (sig) {
#pragma unroll
                        for (int k = 0; k < 4; ++k) { v0[k] = 1.0f / (1.0f + __expf(-v0[k])); v1[k] = 1.0f / (1.0f + __expf(-v1[k])); } }
                    u32x4 w; w.x = cvt_pk_bf16(v0[0], v0[1]); w.y = cvt_pk_bf16(v0[2], v0[3]); w.z = cvt_pk_bf16(v1[0], v1[1]); w.w = cvt_pk_bf16(v1[2], v1[3]);
                    *(u32x4*)(rowp + bj * HALF) = w; } }
    }
};
struct EpiGateF32 {
    static constexpr bool PERM = false, AFTER_DRAIN = false;
    float* out; const bf16_t* gate; int gld, gcol0;
    __device__ __forceinline__ void operator()(const f32x4 (&acc)[2][2][4][2], const Unit& u, int wr, int wc, int fr, int fq) const {
        const int col0 = u.pn * BM + wc * 32 + 4 * fq;
#pragma unroll
        for (int ai = 0; ai < 2; ++ai)
#pragma unroll
            for (int m = 0; m < 4; ++m) { const int r = u.pm * BM + ai * HALF + wr * 64 + m * 16 + fr;
#pragma unroll
                for (int bj = 0; bj < 2; ++bj)
#pragma unroll
                    for (int n = 0; n < 2; ++n) { const int c = col0 + bj * HALF + n * 16;
                        const unsigned long long gq = *(const unsigned long long*)(gate + (size_t)r * gld + gcol0 + c);
                        const unsigned g0 = (unsigned)gq, g1 = (unsigned)(gq >> 32);
                        f32x4 a = acc[ai][bj][m][n];
                        a[0] *= __builtin_bit_cast(float, g0 << 16); a[1] *= __builtin_bit_cast(float, g0 & 0xffff0000u);
                        a[2] *= __builtin_bit_cast(float, g1 << 16); a[3] *= __builtin_bit_cast(float, g1 & 0xffff0000u);
                        *(f32x4*)(out + (size_t)r * 1024 + c) = a; } }
    }
};
struct EpiMerge {
    static constexpr bool PERM = true, AFTER_DRAIN = false;
    const float* tmp; const bf16_t* gate; int gld, gcol0; bf16_t* out;
    __device__ __forceinline__ void operator()(const f32x4 (&acc)[2][2][4][2], const Unit& u, int wr, int wc, int fr, int fq) const {
        const int row0 = u.pm * BM + wr * 64 + fr, col0 = u.pn * BM + wc * 32 + 8 * fq;
#pragma unroll
        for (int ai = 0; ai < 2; ++ai)
#pragma unroll
            for (int m = 0; m < 4; ++m) { const int r = row0 + ai * HALF + m * 16;
#pragma unroll
                for (int bj = 0; bj < 2; ++bj) { const int c = col0 + bj * HALF;
                    const u32x4 gq = *(const u32x4*)(gate + (size_t)r * gld + gcol0 + c);
                    const f32x4 t0 = *(const f32x4*)(tmp + (size_t)r * 1024 + c), t1 = *(const f32x4*)(tmp + (size_t)r * 1024 + c + 4);
                    f32x4 v0 = acc[ai][bj][m][0], v1 = acc[ai][bj][m][1];
                    v0[0] = t0[0] + v0[0] * __builtin_bit_cast(float, gq.x << 16); v0[1] = t0[1] + v0[1] * __builtin_bit_cast(float, gq.x & 0xffff0000u);
                    v0[2] = t0[2] + v0[2] * __builtin_bit_cast(float, gq.y << 16); v0[3] = t0[3] + v0[3] * __builtin_bit_cast(float, gq.y & 0xffff0000u);
                    v1[0] = t1[0] + v1[0] * __builtin_bit_cast(float, gq.z << 16); v1[1] = t1[1] + v1[1] * __builtin_bit_cast(float, gq.z & 0xffff0000u);
                    v1[2] = t1[2] + v1[2] * __builtin_bit_cast(float, gq.w << 16); v1[3] = t1[3] + v1[3] * __builtin_bit_cast(float, gq.w & 0xffff0000u);
                    u32x4 w; w.x = cvt_pk_bf16(v0[0], v0[1]); w.y = cvt_pk_bf16(v0[2], v0[3]); w.z = cvt_pk_bf16(v1[0], v1[1]); w.w = cvt_pk_bf16(v1[2], v1[3]);
                    *(u32x4*)(out + (size_t)r * 1024 + c) = w; } }
    }
};
template <int MODE> struct EpiF32 {
    static constexpr bool PERM = false, AFTER_DRAIN = false;
    float* out;
    __device__ __forceinline__ void operator()(const f32x4 (&acc)[2][2][4][2], const Unit& u, int wr, int wc, int fr, int fq) const {
        const int col0 = u.pn * BM + wc * 32 + 4 * fq;
#pragma unroll
        for (int ai = 0; ai < 2; ++ai)
#pragma unroll
            for (int m = 0; m < 4; ++m) { const int r = u.pm * BM + ai * HALF + wr * 64 + m * 16 + fr;
#pragma unroll
                for (int bj = 0; bj < 2; ++bj)
#pragma unroll
                    for (int n = 0; n < 2; ++n) { float* p = out + (size_t)r * 1024 + col0 + bj * HALF + n * 16; f32x4 a = acc[ai][bj][m][n];
                        if (MODE == 1) { const f32x4 e = *(const f32x4*)p;
#pragma unroll
                            for (int k = 0; k < 4; ++k) a[k] = e[k] / (1.0f + __expf(-a[k])); }
                        *(f32x4*)p = a; } }
    }
};
struct EpiRelu2 {
    static constexpr bool PERM = true, AFTER_DRAIN = false;
    bf16_t* out;
    __device__ __forceinline__ void operator()(const f32x4 (&acc)[2][2][4][2], const Unit& u, int wr, int wc, int fr, int fq) const {
        const int row0 = u.pm * BM + wr * 64 + fr, col0 = u.pn * BM + wc * 32 + 8 * fq;
#pragma unroll
        for (int ai = 0; ai < 2; ++ai)
#pragma unroll
            for (int m = 0; m < 4; ++m) { bf16_t* rowp = out + (size_t)(row0 + ai * HALF + m * 16) * 4096 + col0;
#pragma unroll
                for (int bj = 0; bj < 2; ++bj) { f32x4 v0 = acc[ai][bj][m][0], v1 = acc[ai][bj][m][1];
#pragma unroll
                    for (int k = 0; k < 4; ++k) { const float a = fmaxf(v0[k], 0.f), b = fmaxf(v1[k], 0.f); v0[k] = a * a; v1[k] = b * b; }
                    u32x4 w; w.x = cvt_pk_bf16(v0[0], v0[1]); w.y = cvt_pk_bf16(v0[2], v0[3]); w.z = cvt_pk_bf16(v1[0], v1[1]); w.w = cvt_pk_bf16(v1[2], v1[3]);
                    *(u32x4*)(rowp + bj * HALF) = w; } }
    }
};
}

__device__ __forceinline__ void p0_transpose_item(const float* W, int K, int N, bf16* WT, int row_off, LAS float* scr, int item, int lane) {
    const int nblk = N / 32, kb = item / nblk, nb = item % nblk, k0 = 64 * kb, n0 = 32 * nb;
#pragma unroll 8
    for (int i = 0; i < 32; ++i) { const int kk = 2 * i + (lane >> 5); scr[kk * 33 + (lane & 31)] = W[(size_t)(k0 + kk) * N + n0 + (lane & 31)]; }
    LDS_WAIT(); asm volatile("" ::: "memory");
    const int c = lane & 7;
#pragma unroll
    for (int j = 0; j < 4; ++j) { const int n = (lane >> 3) + 8 * j; const LAS float* s = scr + (8 * c) * 33 + n;
        v4u o; o.x = pk2(s[0 * 33], s[1 * 33]); o.y = pk2(s[2 * 33], s[3 * 33]); o.z = pk2(s[4 * 33], s[5 * 33]); o.w = pk2(s[6 * 33], s[7 * 33]);
        *(GAS v4u*)(WT + (size_t)(row_off + n0 + n) * K + k0 + 8 * c) = o; }
    LDS_WAIT(); asm volatile("" ::: "memory");
}
__device__ __forceinline__ void rms_row_to_bf16(const float* xrow, const float* g, bf16* orow, int lane) {
    const GAS f32x4* xr = (const GAS f32x4*)xrow + lane; const GAS f32x4* gr = (const GAS f32x4*)g + lane;
    f32x4 v[4]; float s = 0.f;
#pragma unroll
    for (int j = 0; j < 4; ++j) { v[j] = xr[64 * j]; s += (v[j].x * v[j].x + v[j].y * v[j].y) + (v[j].z * v[j].z + v[j].w * v[j].w); }
    const float rs = 1.f / sqrtf(wave_sum(s) * (1.f / D) + NORM_EPS);
    GAS unsigned long long* o8 = (GAS unsigned long long*)orow + lane;
#pragma unroll
    for (int j = 0; j < 4; ++j) { const f32x4 gg = gr[64 * j];
        o8[64 * j] = (unsigned long long)pk2(v[j].x * rs * gg.x, v[j].y * rs * gg.y) | ((unsigned long long)pk2(v[j].z * rs * gg.z, v[j].w * rs * gg.w) << 32); }
}

struct Args { const float* in[26]; float* out; unsigned char* ws; int ph_lo, ph_hi, li, pad; };

__global__ void __launch_bounds__(NWAVES * 64, 2) skel_fwd(Args args) {
    extern __shared__ __attribute__((aligned(16))) unsigned char lds_raw[];
    LAS unsigned char* const lds = (LAS unsigned char*)lds_raw;
    volatile LAS unsigned* const MISC = (volatile LAS unsigned*)(lds + MISC_OFF);
    const int tid = threadIdx.x, lane = tid & 63, wave = __builtin_amdgcn_readfirstlane(tid >> 6);
    const int G = gridDim.x; int vcu; { const int bx = blockIdx.x; vcu = (G % 8 == 0) ? (bx % 8) * (G / 8) + bx / 8 : bx; }
    unsigned char* const ws = args.ws;
    gu32* const ctl = (gu32*)(ws + WS_CTL);
    for (int u = tid; u < (LDS_BYTES - LDSCTL_OFF) / 4; u += NWAVES * 64) ((LAS unsigned*)(lds + LDSCTL_OFF))[u] = 0u;
    __syncthreads();
    XcdBarrier bar; bar.bar = (unsigned*)(ctl + CW_BAR); bar.x = 0; bar.st = nullptr;
    if (!MK_PER_PHASE) bar = xcd_barrier_post((unsigned*)(ctl + CW_BAR), MISC + 8);
#define GRID_BAR() do { if (MK_PER_PHASE) { if (tid == 0) __hip_atomic_store(ctl + CW_TMO, 0xBADBA0u, RLX_AGENT); } else { xcd_barrier(bar); } } while (0)
    const int lo = args.ph_lo, hi = args.ph_hi;
#ifndef PH_MASK
#define PH_MASK 0xFFFFFFFFu
#endif
#define IN(k) (((PH_MASK >> (k)) & 1u) && lo <= (k) && (k) < hi)
#define BOTH(k) (IN(k) && IN((k) + 1))
    const int gw = vcu * NWAVES + wave, NGW = G * NWAVES;
    const int gt = vcu * (NWAVES * 64) + tid, NGT = G * NWAVES * 64;

    const float* const x = args.in[0]; const float* const pin = args.in[1];
    float* const out = args.out;
    bf16* const WinT = (bf16*)(ws + WS_WIN); bf16* const WfiT = (bf16*)(ws + WS_WFI); bf16* const WfoT = (bf16*)(ws + WS_WFO);
    bf16* const WoT = (bf16*)(ws + WS_WO); bf16* const WpgT = (bf16*)(ws + WS_WPG); bf16* const WpleT = (bf16*)(ws + WS_WPLE);
    bf16* const WauT = (bf16*)(ws + WS_WAU); bf16* const WruT = (bf16*)(ws + WS_WRU);
    bf16* const XN = (bf16*)(ws + WS_XN); bf16* const PB = (bf16*)(ws + WS_PB);
    bf16* const ZA = (bf16*)(ws + WS_ZA); bf16* const ZR = (bf16*)(ws + WS_ZR); bf16* const ZG = (bf16*)(ws + WS_ZG);
    float2* const CS = (float2*)(ws + WS_CS);

    if (IN(PH_PRO)) {
        LAS float* scr = (LAS float*)(lds + RING_OFF + wave * 16384);
        constexpr int I_IN = (D / 64) * (6048 / 32), I_FI = (D / 64) * (FF / 32), I_FO = (FF / 64) * (D / 32), I_O = (D / 64) * (D / 32), I_PG = I_O;
        constexpr int I_PLE = (PLE / 64) * (D / 32), I_AU = (256 / 64) * (D / 32), I_RU = (512 / 64) * (D / 32);
        constexpr int NITEMS = I_IN + I_FI + I_FO + I_O + I_PG + I_PLE + I_AU + I_RU;
        for (int it = gw; it < NITEMS; it += NGW) {
            int r = it;
            if (r < I_IN) { const int nb = r % (6048 / 32); p0_transpose_item(args.in[3], D, 6048, WinT, (nb * 32 >= 4000) ? 96 : 0, scr, r, lane); continue; } r -= I_IN;
            if (r < I_FI) { p0_transpose_item(args.in[20], D, FF, WfiT, 0, scr, r, lane); continue; } r -= I_FI;
            if (r < I_FO) { p0_transpose_item(args.in[21], FF, D, WfoT, 0, scr, r, lane); continue; } r -= I_FO;
            if (r < I_O) { p0_transpose_item(args.in[17], D, D, WoT, 0, scr, r, lane); continue; } r -= I_O;
            if (r < I_PG) { p0_transpose_item(args.in[24], D, D, WpgT, 0, scr, r, lane); continue; } r -= I_PG;
            if (r < I_PLE) { p0_transpose_item(args.in[23], PLE, D, WpleT, 0, scr, r, lane); continue; } r -= I_PLE;
            if (r < I_AU) { p0_transpose_item(args.in[15], 256, D, WauT, 0, scr, r, lane); continue; } r -= I_AU;
            p0_transpose_item(args.in[16], 512, D, WruT, 0, scr, r, lane);
        }
        for (int i = gt; i < 96 * 1024 / 8; i += NGT) ((GAS v4u*)(WinT + (size_t)4000 * 1024))[i] = (v4u){0u, 0u, 0u, 0u};
        for (int m = gw; m < T; m += NGW) rms_row_to_bf16(x + (size_t)m * D, args.in[2], XN + (size_t)m * D, lane);
        for (int m = gw; m < T; m += NGW) { const f32x4 v = ((const GAS f32x4*)(pin + (size_t)m * PLE))[lane];
            ((GAS unsigned long long*)(PB + (size_t)m * PLE))[lane] = (unsigned long long)pk2(v.x, v.y) | ((unsigned long long)pk2(v.z, v.w) << 32); }
        for (int i = gt; i < SEQ * 32; i += NGT) { const int pos = i >> 5, fi = i & 31;
            const float inv = (float)exp(-(double)fi * (1.0 / 32.0) * 9.210340371976184);
            const float ang = (float)pos * inv;
            const double a = (double)ang; const double kq = rint(a * 0.15915494309189535); const double rr = a - kq * 6.283185307179586;
            const float rf = (float)rr; CS[i] = make_float2(cosf(rf), sinf(rf)); }
        if (BOTH(PH_PRO)) GRID_BAR();
    }

    if (IN(PH_INPROJ)) {
        pg8::Gemm g{XN, WinT, T, NIN, D}; pg8::StaticOrder S; S.init(T, NIN, G, (int)blockIdx.x);
        pg8::EpiInProj E{ZA, ZR, ZG};
        pg8::gemm_phase<pg8::EpiInProj, pg8::StaticOrder, PG8_ALIGN, PG8_SP2>(lds + RING_OFF, g, S, E);
        if (BOTH(PH_INPROJ)) GRID_BAR();
    }

    if (IN(PH_ATT)) {
        constexpr int KS = 72, VS = 264;
        bf16* const OG = (bf16*)(ws + WS_OG); float* const LSE = (float*)(ws + WS_LSE);
        LAS bf16* const Kl = (LAS bf16*)(lds + RING_OFF); LAS bf16* const VT = (LAS bf16*)(lds + RING_OFF + 36864);
        const int lr = lane & 15, lq = lane >> 4;
        for (int unit = vcu; unit < BATCH * 3 * 4 * 64; unit += G) {
            const int tau = unit & 63, h = (unit >> 6) & 3, g = (unit >> 8) % 3, b = unit / (64 * 4 * 3);
            const int dl = (g == 0) ? 1 : (g == 1) ? 4 : 16;
            const int rho = tau % dl, it = tau / dl, i0 = it * 128;
            const int colq = g * 256 + h * 64, colk = 768 + colq, colv = 1536 + colq;
#pragma unroll
            for (int r2 = 0; r2 < 2; ++r2) { const int idx = tid + 512 * r2, key = idx >> 2, p = idx & 3, ik = i0 - 128 + key;
                v4u lo = {0u, 0u, 0u, 0u}, hi = {0u, 0u, 0u, 0u};
                if (ik >= 0) { const int t = ik * dl + rho; const bf16* rowp = ZA + (size_t)(b * SEQ + t) * ZA_LD + colk + 8 * p;
                    const v4u x1 = *(const GAS v4u*)rowp, x2 = *(const GAS v4u*)(rowp + 32);
                    const GAS f32x4* cs = (const GAS f32x4*)(CS + t * 32 + 8 * p); const f32x4 c0 = cs[0], c1 = cs[1], c2 = cs[2], c3 = cs[3];
                    float a1[8] = {bflo(x1.x), bfhi(x1.x), bflo(x1.y), bfhi(x1.y), bflo(x1.z), bfhi(x1.z), bflo(x1.w), bfhi(x1.w)};
                    float a2[8] = {bflo(x2.x), bfhi(x2.x), bflo(x2.y), bfhi(x2.y), bflo(x2.z), bfhi(x2.z), bflo(x2.w), bfhi(x2.w)};
                    float cc[8] = {c0.x, c0.z, c1.x, c1.z, c2.x, c2.z, c3.x, c3.z}, ss[8] = {c0.y, c0.w, c1.y, c1.w, c2.y, c2.w, c3.y, c3.w};
                    float o1[8], o2[8];
#pragma unroll
                    for (int e = 0; e < 8; ++e) { o1[e] = a1[e] * cc[e] - a2[e] * ss[e]; o2[e] = a2[e] * cc[e] + a1[e] * ss[e]; }
                    lo = (v4u){pk2(o1[0], o1[1]), pk2(o1[2], o1[3]), pk2(o1[4], o1[5]), pk2(o1[6], o1[7])}; hi = (v4u){pk2(o2[0], o2[1]), pk2(o2[2], o2[3]), pk2(o2[4], o2[5]), pk2(o2[6], o2[7])}; }
                *(LAS v4u*)(Kl + key * KS + 8 * p) = lo; *(LAS v4u*)(Kl + key * KS + 32 + 8 * p) = hi; }
#pragma unroll
            for (int r4 = 0; r4 < 4; ++r4) { const int idx = tid + 512 * r4, key = idx >> 3, pc = idx & 7, ik = i0 - 128 + key;
                v4u x = {0u, 0u, 0u, 0u};
                if (ik >= 0) { const int t = ik * dl + rho; x = *(const GAS v4u*)(ZA + (size_t)(b * SEQ + t) * ZA_LD + colv + 8 * pc); }
                LAS bf16* vp = VT + (8 * pc) * VS + key;
                vp[0] = (bf16)(x.x & 0xffffu); vp[VS] = (bf16)(x.x >> 16); vp[2 * VS] = (bf16)(x.y & 0xffffu); vp[3 * VS] = (bf16)(x.y >> 16);
                vp[4 * VS] = (bf16)(x.z & 0xffffu); vp[5 * VS] = (bf16)(x.z >> 16); vp[6 * VS] = (bf16)(x.w & 0xffffu); vp[7 * VS] = (bf16)(x.w >> 16); }
            const int tq = (i0 + 16 * wave + lr) * dl + rho; const size_t trow = (size_t)(b * SEQ + tq);
            bf16x8 qf0, qf1;
            { const bf16* rowp = ZA + trow * ZA_LD + colq + 8 * lq; const v4u x1 = *(const GAS v4u*)rowp, x2 = *(const GAS v4u*)(rowp + 32);
              const GAS f32x4* cs = (const GAS f32x4*)(CS + tq * 32 + 8 * lq); const f32x4 c0 = cs[0], c1 = cs[1], c2 = cs[2], c3 = cs[3];
              float a1[8] = {bflo(x1.x), bfhi(x1.x), bflo(x1.y), bfhi(x1.y), bflo(x1.z), bfhi(x1.z), bflo(x1.w), bfhi(x1.w)};
              float a2[8] = {bflo(x2.x), bfhi(x2.x), bflo(x2.y), bfhi(x2.y), bflo(x2.z), bfhi(x2.z), bflo(x2.w), bfhi(x2.w)};
              float cc[8] = {c0.x, c0.z, c1.x, c1.z, c2.x, c2.z, c3.x, c3.z}, ss[8] = {c0.y, c0.w, c1.y, c1.w, c2.y, c2.w, c3.y, c3.w};
              const float qs = 0.125f * 1.4426950408889634f; float o1[8], o2[8];
#pragma unroll
              for (int e = 0; e < 8; ++e) { o1[e] = (a1[e] * cc[e] - a2[e] * ss[e]) * qs; o2[e] = (a2[e] * cc[e] + a1[e] * ss[e]) * qs; }
              const v4u lo = {pk2(o1[0], o1[1]), pk2(o1[2], o1[3]), pk2(o1[4], o1[5]), pk2(o1[6], o1[7])}, hi = {pk2(o2[0], o2[1]), pk2(o2[2], o2[3]), pk2(o2[4], o2[5]), pk2(o2[6], o2[7])};
              qf0 = __builtin_bit_cast(bf16x8, lo); qf1 = __builtin_bit_cast(bf16x8, hi); }
            __syncthreads();
            f32x4 sc[9]; float m = -INFINITY;
#pragma unroll
            for (int kt = 0; kt < 9; ++kt) { const LAS bf16* kp = Kl + (16 * wave + 16 * kt + lr) * KS + 8 * lq;
                const bf16x8 a0 = *(const LAS bf16x8*)kp, a1 = *(const LAS bf16x8*)(kp + 32);
                f32x4 acc = {0.f, 0.f, 0.f, 0.f};
                acc = __builtin_amdgcn_mfma_f32_16x16x32_bf16(a0, qf0, acc, 0, 0, 0); acc = __builtin_amdgcn_mfma_f32_16x16x32_bf16(a1, qf1, acc, 0, 0, 0);
#pragma unroll
                for (int i = 0; i < 4; ++i) { const int ko = 4 * lq + i; const int ik = i0 - 128 + 16 * wave + 16 * kt + ko;
                    const bool valid = (ik >= 0) && (kt > 0 || ko >= lr) && (kt < 8 || ko <= lr);
                    acc[i] = valid ? acc[i] : -INFINITY; m = fmaxf(m, acc[i]); }
                sc[kt] = acc; }
            m = fmaxf(m, __shfl_xor(m, 16)); m = fmaxf(m, __shfl_xor(m, 32));
            float l = 0.f;
#pragma unroll
            for (int kt = 0; kt < 9; ++kt)
#pragma unroll
                for (int i = 0; i < 4; ++i) { const float pj = __builtin_amdgcn_exp2f(sc[kt][i] - m); sc[kt][i] = pj; l += pj; }
            l += __shfl_xor(l, 16); l += __shfl_xor(l, 32);
            bf16x8 pb[5];
#pragma unroll
            for (int st = 0; st < 5; ++st) { const f32x4 t0v = sc[2 * st]; const f32x4 t1v = (st < 4) ? sc[2 * st + 1] : (f32x4){0.f, 0.f, 0.f, 0.f};
                const v4u pk = {pk2(t0v[0], t0v[1]), pk2(t0v[2], t0v[3]), pk2(t1v[0], t1v[1]), pk2(t1v[2], t1v[3])}; pb[st] = __builtin_bit_cast(bf16x8, pk); }
            const float il = 1.0f / l;
#pragma unroll
            for (int dt = 0; dt < 4; ++dt) { f32x4 acc = {0.f, 0.f, 0.f, 0.f};
#pragma unroll
                for (int st = 0; st < 5; ++st) { const LAS bf16* vp = VT + (16 * dt + lr) * VS + 16 * wave + 32 * st + 4 * lq;
                    const v2u v0 = *(const LAS v2u*)vp; const v2u v1 = (st < 4) ? *(const LAS v2u*)(vp + 16) : (v2u){0u, 0u};
                    const v4u av = {v0.x, v0.y, v1.x, v1.y};
                    acc = __builtin_amdgcn_mfma_f32_16x16x32_bf16(__builtin_bit_cast(bf16x8, av), pb[st], acc, 0, 0, 0); }
                *(GAS unsigned long long*)(OG + ((size_t)g * T + trow) * 256 + h * 64 + 16 * dt + 4 * lq) = (unsigned long long)pk2(acc[0] * il, acc[1] * il) | ((unsigned long long)pk2(acc[2] * il, acc[3] * il) << 32); }
            if (lq == 0) LSE[((size_t)g * T + trow) * 4 + h] = (m + __builtin_amdgcn_logf(l)) * 0.6931471805599453f;
            __syncthreads();
        }
        if (BOTH(PH_ATT)) GRID_BAR();
    }

    if (IN(PH_PREP)) {
        {
            const bf16* const OG = (const bf16*)(ws + WS_OG); const float* const LSE = (const float*)(ws + WS_LSE); bf16* const OA = (bf16*)(ws + WS_OA);
            for (int i = gt; i < T * 32; i += NGT) { const int t = i >> 5, h = (i >> 3) & 3, c8 = i & 7;
                const float l0 = LSE[((size_t)0 * T + t) * 4 + h], l1 = LSE[((size_t)1 * T + t) * 4 + h], l2 = LSE[((size_t)2 * T + t) * 4 + h];
                const float mx = fmaxf(l0, fmaxf(l1, l2)); const float e0 = __expf(l0 - mx), e1 = __expf(l1 - mx), e2 = __expf(l2 - mx); const float inv = 1.0f / (e0 + e1 + e2);
                const float a0 = e0 * inv, a1 = e1 * inv, a2 = e2 * inv;
                const v4u x0 = *(const GAS v4u*)(OG + ((size_t)0 * T + t) * 256 + h * 64 + 8 * c8), x1 = *(const GAS v4u*)(OG + ((size_t)1 * T + t) * 256 + h * 64 + 8 * c8), x2 = *(const GAS v4u*)(OG + ((size_t)2 * T + t) * 256 + h * 64 + 8 * c8);
                v4u w;
                w.x = pk2(a0 * bflo(x0.x) + a1 * bflo(x1.x) + a2 * bflo(x2.x), a0 * bfhi(x0.x) + a1 * bfhi(x1.x) + a2 * bfhi(x2.x));
                w.y = pk2(a0 * bflo(x0.y) + a1 * bflo(x1.y) + a2 * bflo(x2.y), a0 * bfhi(x0.y) + a1 * bfhi(x1.y) + a2 * bfhi(x2.y));
                w.z = pk2(a0 * bflo(x0.z) + a1 * bflo(x1.z) + a2 * bflo(x2.z), a0 * bfhi(x0.z) + a1 * bfhi(x1.z) + a2 * bfhi(x2.z));
                w.w = pk2(a0 * bflo(x0.w) + a1 * bflo(x1.w) + a2 * bflo(x2.w), a0 * bfhi(x0.w) + a1 * bfhi(x1.w) + a2 * bfhi(x2.w));
                *(GAS v4u*)(OA + (size_t)t * 256 + h * 64 + 8 * c8) = w; }
        }
        {
            const float* const mu = args.in[4]; const float* const w0 = args.in[5]; const float* const w2 = args.in[6]; const float* const a0 = args.in[7];
            const float* const a2 = args.in[8]; const float* const g2 = args.in[9]; const float* const k_k = args.in[10]; const float* const k_a = args.in[11]; const float* const r_k = args.in[12];
            bf16* const Rb = (bf16*)(ws + WS_R); bf16* const Kb = (bf16*)(ws + WS_KP); bf16* const Vb = (bf16*)(ws + WS_V); bf16* const AVb = (bf16*)(ws + WS_AV);
            float* const DEC = (float*)((unsigned char*)out + DO_DEC);   bf16* const BVb = (bf16*)((unsigned char*)out + DO_BV); bf16* const GTb = (bf16*)((unsigned char*)out + DO_GT);
            float* const BONUS = (float*)(ws + WS_BONUS);
            const int c = tid;
            float w2c[32], a2c[32]; unsigned g2c[48];
#pragma unroll
            for (int j = 0; j < 32; ++j) { w2c[j] = w2[j * RW + c]; a2c[j] = a2[j * RW + c]; }
#pragma unroll
            for (int j = 0; j < 48; ++j) g2c[j] = pk2(g2[(2 * j) * RW + c], g2[(2 * j + 1) * RW + c]);
            const float mu_r = mu[c], mu_k = mu[512 + c], mu_v = mu[1024 + c], w0c = w0[c], a0c = a0[c], kkc = k_k[c], kac = k_a[c], rkc = r_k[c];
            LAS float* L = (LAS float*)(lds + RING_OFF);
            for (int tile = vcu; tile < T / 16; tile += G) {
                const int t0 = tile * 16;
                for (int idx = tid; idx < 16 * 160; idx += 512) { const int tok = idx / 160, j = idx - tok * 160, t = t0 + tok;
                    const float z = bf2f(ZR[(size_t)t * ZR_LD + 1536 + j]); const float zp = ((t & (SEQ - 1)) == 0) ? 0.f : bf2f(ZR[(size_t)(t - 1) * ZR_LD + 1536 + j]);
                    const float xx = z + (zp - z) * mu[1536 + j];
                    L[idx] = (j < 32) ? tanhf(xx) : (j < 64) ? xx : sigmoidf_(xx); }
                __syncthreads();
                float pr = 0.f, pk = 0.f, pv = 0.f;
                if ((t0 & (SEQ - 1)) != 0) { const bf16* zp = ZR + (size_t)(t0 - 1) * ZR_LD; pr = bf2f(zp[c]); pk = bf2f(zp[512 + c]); pv = bf2f(zp[1024 + c]); }
                for (int tok = 0; tok < 16; ++tok) { const int t = t0 + tok; const bf16* zc = ZR + (size_t)t * ZR_LD;
                    const float zr = bf2f(zc[c]), zk = bf2f(zc[512 + c]), zv = bf2f(zc[1024 + c]);
                    const float r = zr + (pr - zr) * mu_r; float k = zk + (pk - zk) * mu_k; const float v = zv + (pv - zv) * mu_v; pr = zr; pk = zk; pv = zv;
                    const LAS f32x4* Lt = (const LAS f32x4*)(L + tok * 160);
                    float wl = 0.f, al = 0.f, gl = 0.f;
#pragma unroll
                    for (int j = 0; j < 8; ++j) { const f32x4 a = Lt[j]; wl += a.x * w2c[4 * j] + a.y * w2c[4 * j + 1] + a.z * w2c[4 * j + 2] + a.w * w2c[4 * j + 3]; }
#pragma unroll
                    for (int j = 0; j < 8; ++j) { const f32x4 a = Lt[8 + j]; al += a.x * a2c[4 * j] + a.y * a2c[4 * j + 1] + a.z * a2c[4 * j + 2] + a.w * a2c[4 * j + 3]; }
#pragma unroll
                    for (int j = 0; j < 24; ++j) { const f32x4 a = Lt[16 + j]; gl += a.x * bflo(g2c[2 * j]) + a.y * bfhi(g2c[2 * j]) + a.z * bflo(g2c[2 * j + 1]) + a.w * bfhi(g2c[2 * j + 1]); }
                    const float wv = w0c + wl; const float nx = -wv;
                    const float sp = fmaxf(nx, 0.f) + log1pf(__expf(-fabsf(nx)));
                    const float dec = -__expf(-sp - 0.5f);
                    const float a = sigmoidf_(a0c + al);
                    float kk = k * kkc; const float ss = wave_sum(kk * kk); kk = kk / fmaxf(sqrtf(ss), 1e-12f);
                    k = k * (1.0f + (a - 1.0f) * kac);
                    const float bon = wave_sum(r * k * rkc);
                    const size_t o = (size_t)t * RW + c;
                    Rb[o] = (bf16)f2bf(r); Kb[o] = (bf16)f2bf(k); Vb[o] = (bf16)f2bf(v); AVb[o] = (bf16)f2bf(-kk); BVb[o] = (bf16)f2bf(kk * a); GTb[o] = (bf16)f2bf(gl); DEC[o] = dec;
                    if (lane == 0) BONUS[(size_t)t * 8 + wave] = bon;
                }
                __syncthreads();
            }
        }
        if (BOTH(PH_PREP)) GRID_BAR();
    }

    if (IN(PH_CHUNK)) {
        constexpr int LS = 72, FS = 68;
        bf16* const Rb = (bf16*)(ws + WS_R); bf16* const Kb = (bf16*)(ws + WS_KP); const bf16* const Vb = (const bf16*)(ws + WS_V); bf16* const AVb = (bf16*)(ws + WS_AV);
        float* const LW = (float*)((unsigned char*)out + DO_DEC); bf16* const BVb = (bf16*)((unsigned char*)out + DO_BV);
        bf16* const YLT = (bf16*)(ws + WS_YLT); float* const GC = (float*)(ws + WS_GC);
        LAS bf16* const At = (LAS bf16*)(lds + 0); LAS bf16* const Rt = (LAS bf16*)(lds + 9216); LAS bf16* const Bt = (LAS bf16*)(lds + 18432); LAS bf16* const Kt = (LAS bf16*)(lds + 27648);
        LAS bf16* const VmT = (LAS bf16*)(lds + 36864); LAS bf16* const KhT = (LAS bf16*)(lds + 46080); LAS bf16* const Lak = (LAS bf16*)(lds + 55296); LAS bf16* const Mrb = (LAS bf16*)(lds + 64512);
        LAS bf16* const Mrk = (LAS bf16*)(lds + 73728); LAS bf16* const BhT = (LAS bf16*)(lds + 82944); LAS float* const LabF = (LAS float*)(lds + 92160); LAS float* const X1F = (LAS float*)(lds + 109568);
        LAS bf16* const ApT = Bt; LAS bf16* const WT2 = Kt; LAS float* const cum = X1F;
        const int lr = lane & 15, lq = lane >> 4;
        for (int unit = vcu; unit < BATCH * 8 * (SEQ / 64); unit += G) {
            const int ch = unit & 127, h = (unit >> 7) & 7, b = unit >> 10;
            const size_t t0 = (size_t)b * SEQ + (size_t)ch * 64;
            const int c = tid >> 3, kq = tid & 7;
            const size_t goff = (t0 + c) * RW + h * 64 + kq * 8;
            const v4u r8 = *(const GAS v4u*)(Rb + goff), k8 = *(const GAS v4u*)(Kb + goff), v8 = *(const GAS v4u*)(Vb + goff), a8 = *(const GAS v4u*)(AVb + goff), b8 = *(const GAS v4u*)(BVb + goff);
            const f32x4 lw0 = *(const GAS f32x4*)(LW + goff), lw1 = *(const GAS f32x4*)(LW + goff + 4);
            float lwv[8] = {lw0.x, lw0.y, lw0.z, lw0.w, lw1.x, lw1.y, lw1.z, lw1.w};
#pragma unroll
            for (int i = 0; i < 8; ++i) cum[c * 65 + kq * 8 + i] = lwv[i];
            __syncthreads();
#pragma unroll
            for (int i = 0; i < 8; ++i) { const int chn = 8 * wave + i; float xx = cum[lane * 65 + chn];
#pragma unroll
                for (int o = 1; o < 64; o <<= 1) { const float yy = __shfl_up(xx, o); if (lane >= o) xx += yy; }
                cum[lane * 65 + chn] = xx; }
            __syncthreads();
            {
                float rr[8], kk8[8], vv[8], aa[8], bb[8];
                rr[0] = bflo(r8.x); rr[1] = bfhi(r8.x); rr[2] = bflo(r8.y); rr[3] = bfhi(r8.y); rr[4] = bflo(r8.z); rr[5] = bfhi(r8.z); rr[6] = bflo(r8.w); rr[7] = bfhi(r8.w);
                kk8[0] = bflo(k8.x); kk8[1] = bfhi(k8.x); kk8[2] = bflo(k8.y); kk8[3] = bfhi(k8.y); kk8[4] = bflo(k8.z); kk8[5] = bfhi(k8.z); kk8[6] = bflo(k8.w); kk8[7] = bfhi(k8.w);
                vv[0] = bflo(v8.x); vv[1] = bfhi(v8.x); vv[2] = bflo(v8.y); vv[3] = bfhi(v8.y); vv[4] = bflo(v8.z); vv[5] = bfhi(v8.z); vv[6] = bflo(v8.w); vv[7] = bfhi(v8.w);
                aa[0] = bflo(a8.x); aa[1] = bfhi(a8.x); aa[2] = bflo(a8.y); aa[3] = bfhi(a8.y); aa[4] = bflo(a8.z); aa[5] = bfhi(a8.z); aa[6] = bflo(a8.w); aa[7] = bfhi(a8.w);
                bb[0] = bflo(b8.x); bb[1] = bfhi(b8.x); bb[2] = bflo(b8.y); bb[3] = bfhi(b8.y); bb[4] = bflo(b8.z); bb[5] = bfhi(b8.z); bb[6] = bflo(b8.w); bb[7] = bfhi(b8.w);
                float at[8], rt[8], bt[8], kt[8];
#pragma unroll
                for (int i = 0; i < 8; ++i) { const float cu = cum[c * 65 + kq * 8 + i], cC = cum[63 * 65 + kq * 8 + i];
                    const float ep = __expf(cu), em = __expf(-cu), epv = __expf(cu - lwv[i]), eh = __expf(cC - cu);
                    at[i] = aa[i] * epv; rt[i] = rr[i] * ep; bt[i] = bb[i] * em; kt[i] = kk8[i] * em;
                    const int kk_ = kq * 8 + i;
                    VmT[kk_ * LS + c] = (bf16)f2bf(vv[i]); KhT[kk_ * LS + c] = (bf16)f2bf(kk8[i] * eh); BhT[kk_ * LS + c] = (bf16)f2bf(bb[i] * eh);
                    if (c == 63) GC[(size_t)unit * 64 + kk_] = __expf(cC); }
                *(LAS v4u*)(At + c * LS + kq * 8) = (v4u){pk2(at[0], at[1]), pk2(at[2], at[3]), pk2(at[4], at[5]), pk2(at[6], at[7])};
                *(LAS v4u*)(Rt + c * LS + kq * 8) = (v4u){pk2(rt[0], rt[1]), pk2(rt[2], rt[3]), pk2(rt[4], rt[5]), pk2(rt[6], rt[7])};
                *(LAS v4u*)(Bt + c * LS + kq * 8) = (v4u){pk2(bt[0], bt[1]), pk2(bt[2], bt[3]), pk2(bt[4], bt[5]), pk2(bt[6], bt[7])};
                *(LAS v4u*)(Kt + c * LS + kq * 8) = (v4u){pk2(kt[0], kt[1]), pk2(kt[2], kt[3]), pk2(kt[4], kt[5]), pk2(kt[6], kt[7])};
            }
            __syncthreads();
            {
                const int p = wave >> 1; const LAS bf16* Ab = (p < 2) ? At : Rt; const LAS bf16* Bb = (p & 1) ? Kt : Bt;
                LAS bf16* dstb = (p == 1) ? Lak : (p == 2) ? Mrb : Mrk;
#pragma unroll 1
                for (int tl = (wave & 1) * 8; tl < (wave & 1) * 8 + 8; ++tl) { const int mt = tl >> 2, nt = tl & 3;
                    f32x4 acc = {0.f, 0.f, 0.f, 0.f};
                    if (nt <= mt) {
#pragma unroll
                        for (int ks = 0; ks < 2; ++ks) { const bf16x8 a = *(const LAS bf16x8*)(Ab + (16 * mt + lr) * LS + 32 * ks + 8 * lq), bq = *(const LAS bf16x8*)(Bb + (16 * nt + lr) * LS + 32 * ks + 8 * lq);
                            acc = __builtin_amdgcn_mfma_f32_16x16x32_bf16(a, bq, acc, 0, 0, 0); } }
                    const int col = 16 * nt + lr;
#pragma unroll
                    for (int i = 0; i < 4; ++i) { const int row = 16 * mt + 4 * lq + i; const bool keep = (p < 2) ? (col < row) : (col <= row); const float val = keep ? acc[i] : 0.f;
                        if (p == 0) LabF[row * FS + (col & 3) * 16 + (col >> 2)] = val; else dstb[row * LS + col] = (bf16)f2bf(val); } }
            }
            __syncthreads();
#pragma unroll 1
            for (int tl = wave * 2; tl < wave * 2 + 2; ++tl) { const int mt = tl >> 2, nt = tl & 3; f32x4 acc = {0.f, 0.f, 0.f, 0.f};
#pragma unroll
                for (int ks = 0; ks < 2; ++ks) { const bf16x8 a = *(const LAS bf16x8*)(Lak + (16 * mt + lr) * LS + 32 * ks + 8 * lq), bq = *(const LAS bf16x8*)(VmT + (16 * nt + lr) * LS + 32 * ks + 8 * lq);
                    acc = __builtin_amdgcn_mfma_f32_16x16x32_bf16(a, bq, acc, 0, 0, 0); }
#pragma unroll
                for (int i = 0; i < 4; ++i) X1F[(16 * mt + 4 * lq + i) * FS + 16 * nt + lr] = acc[i]; }
            __syncthreads();
            {
                const int jl = lane >> 2, part = lane & 3, j = 16 * (wave & 3) + jl;
                float xp[16];
                if (wave < 4) {
#pragma unroll
                    for (int m = 0; m < 16; ++m) xp[m] = bf2f(At[(4 * m + part) * LS + j]);
                } else {
#pragma unroll
                    for (int m = 0; m < 16; ++m) xp[m] = X1F[(4 * m + part) * FS + j];
                }
                int lpo = part * 16;
#pragma unroll
                for (int t = 1; t < 64; ++t) { const int tm = t >> 2, tp = t & 3; float s0 = 0.f, s1 = 0.f;
#pragma unroll
                    for (int m4 = 0; m4 <= tm / 4; ++m4) { const f32x4 L4 = *(const LAS f32x4*)(LabF + lpo + t * FS + 4 * m4);
                        s0 += L4.x * xp[4 * m4]; if (4 * m4 + 1 <= tm) s1 += L4.y * xp[4 * m4 + 1]; if (4 * m4 + 2 <= tm) s0 += L4.z * xp[4 * m4 + 2]; if (4 * m4 + 3 <= tm) s1 += L4.w * xp[4 * m4 + 3]; }
                    const float sum = quad_sum(s0 + s1);
                    xp[tm] = (part == tp) ? xp[tm] + sum : xp[tm];
                    if (tp == 3) asm volatile("" : "+v"(lpo) : "v"(xp[tm])); }
                LAS bf16* dl = (wave < 4) ? ApT : WT2;
#pragma unroll
                for (int m = 0; m < 16; ++m) dl[j * LS + 4 * m + part] = (bf16)f2bf(xp[m]);
            }
            __syncthreads();
#pragma unroll 1
            for (int tl = wave * 6; tl < wave * 6 + 6; ++tl) { const int kind = tl >> 4, mt = (tl >> 2) & 3, nt = tl & 3; f32x4 acc = {0.f, 0.f, 0.f, 0.f};
                if (kind == 0) {
#pragma unroll
                    for (int ks = 0; ks < 2; ++ks) { const bf16x8 a = *(const LAS bf16x8*)(Mrb + (16 * mt + lr) * LS + 32 * ks + 8 * lq), bq = *(const LAS bf16x8*)(ApT + (16 * nt + lr) * LS + 32 * ks + 8 * lq);
                        acc = __builtin_amdgcn_mfma_f32_16x16x32_bf16(a, bq, acc, 0, 0, 0); }
#pragma unroll
                    for (int i = 0; i < 4; ++i) { const int row = 16 * mt + 4 * lq + i, col = 16 * nt + lr; Kb[(t0 + row) * RW + h * 64 + col] = (bf16)f2bf(acc[i] + bf2f(Rt[row * LS + col])); }
                } else if (kind == 1) {
#pragma unroll
                    for (int ks = 0; ks < 2; ++ks) { const bf16x8 a = *(const LAS bf16x8*)(Mrb + (16 * mt + lr) * LS + 32 * ks + 8 * lq), bq = *(const LAS bf16x8*)(WT2 + (16 * nt + lr) * LS + 32 * ks + 8 * lq);
                        acc = __builtin_amdgcn_mfma_f32_16x16x32_bf16(a, bq, acc, 0, 0, 0);
                        const bf16x8 a2 = *(const LAS bf16x8*)(Mrk + (16 * mt + lr) * LS + 32 * ks + 8 * lq), b2 = *(const LAS bf16x8*)(VmT + (16 * nt + lr) * LS + 32 * ks + 8 * lq);
                        acc = __builtin_amdgcn_mfma_f32_16x16x32_bf16(a2, b2, acc, 0, 0, 0); }
                    *(GAS unsigned long long*)(YLT + (t0 + 16 * nt + lr) * RW + h * 64 + 16 * mt + 4 * lq) = (unsigned long long)pk2(acc[0], acc[1]) | ((unsigned long long)pk2(acc[2], acc[3]) << 32);
                } else {
#pragma unroll
                    for (int ks = 0; ks < 2; ++ks) { const bf16x8 a = *(const LAS bf16x8*)(VmT + (16 * mt + lr) * LS + 32 * ks + 8 * lq), bq = *(const LAS bf16x8*)(KhT + (16 * nt + lr) * LS + 32 * ks + 8 * lq);
                        acc = __builtin_amdgcn_mfma_f32_16x16x32_bf16(a, bq, acc, 0, 0, 0); }
                    *(GAS unsigned long long*)((bf16*)(LW + (t0 + 16 * nt + lr) * RW + h * 64) + 16 * mt + 4 * lq) = (unsigned long long)pk2(acc[0], acc[1]) | ((unsigned long long)pk2(acc[2], acc[3]) << 32);
                } }
            *(GAS v4u*)(AVb + (t0 + c) * RW + h * 64 + kq * 8) = *(const LAS v4u*)(BhT + c * LS + kq * 8);
            *(GAS v4u*)(BVb + (t0 + c) * RW + h * 64 + kq * 8) = *(const LAS v4u*)(WT2 + c * LS + kq * 8);
            { unsigned short e[8];
#pragma unroll
              for (int i = 0; i < 8; ++i) e[i] = ApT[(kq * 8 + i) * LS + c];
              *(GAS v4u*)(Rb + (t0 + c) * RW + h * 64 + kq * 8) = (v4u){(unsigned)e[0] | ((unsigned)e[1] << 16), (unsigned)e[2] | ((unsigned)e[3] << 16), (unsigned)e[4] | ((unsigned)e[5] << 16), (unsigned)e[6] | ((unsigned)e[7] << 16)}; }
            __syncthreads();
        }
        if (BOTH(PH_CHUNK)) GRID_BAR();
    }

    if (IN(PH_SEQ)) {
        if (vcu < BATCH * 8) {
            constexpr int LS = 72; constexpr int BUFB = 56320;
            const bf16* const APg = (const bf16*)(ws + WS_R); const bf16* const RPg = (const bf16*)(ws + WS_KP); const bf16* const BHg = (const bf16*)(ws + WS_AV);
            const bf16* const WTg = (const bf16*)((unsigned char*)out + DO_BV); const float* const GTg = (const float*)((unsigned char*)out + DO_DEC);
            const bf16* const YLT = (const bf16*)(ws + WS_YLT); const float* const GC = (const float*)(ws + WS_GC);
            float* const Y = (float*)(ws + WS_Y);
            const int b = vcu >> 3, h = vcu & 7;
            LAS bf16* const Sbf0 = (LAS bf16*)(lds + 2 * BUFB); LAS bf16* const UT = (LAS bf16*)(lds + 2 * BUFB + 2 * 9216);
            const int row = tid >> 3, piece = tid & 7, lr = lane & 15, lq = lane >> 4, q = wave & 3;
            for (int i = tid; i < 2 * 9216 / 4; i += 512) ((LAS unsigned*)Sbf0)[i] = 0u;
            f32x4 st[4];
#pragma unroll
            for (int kt = 0; kt < 4; ++kt) st[kt] = (f32x4){0.f, 0.f, 0.f, 0.f};
            v4u preA[6], preB[6]; v4u gcA = {0u, 0u, 0u, 0u}, gcB = {0u, 0u, 0u, 0u};
#define SEQ_LOAD(pre, pgc, ck) do { const size_t go = ((size_t)b * SEQ + (size_t)(ck) * 64 + row) * RW + h * 64 + piece * 8; \
        pre[0] = *(const GAS v4u*)(APg + go); pre[1] = *(const GAS v4u*)(RPg + go); pre[2] = *(const GAS v4u*)(BHg + go); pre[3] = *(const GAS v4u*)(WTg + go); pre[4] = *(const GAS v4u*)(YLT + go); \
        pre[5] = *(const GAS v4u*)((const bf16*)(GTg + ((size_t)b * SEQ + (size_t)(ck) * 64 + row) * RW + h * 64) + piece * 8); \
        if (tid < 16) pgc = *(const GAS v4u*)(GC + ((size_t)((b * 8 + h) * 128 + (ck))) * 64 + tid * 4); } while (0)
#define SEQ_STORE(pre, pgc, bi) do { LAS unsigned char* bb_ = lds + (bi) * BUFB; _Pragma("unroll") for (int a_ = 0; a_ < 6; ++a_) *(LAS v4u*)(bb_ + a_ * 9216 + (row * LS + piece * 8) * 2) = pre[a_]; \
        if (tid < 16) *(LAS v4u*)(bb_ + 55296 + tid * 16) = pgc; } while (0)
#define SEQ_COMPUTE(ck) do { \
                const LAS unsigned char* bb = lds + ((ck) & 1) * BUFB; \
                const LAS bf16* Sr = Sbf0 + ((ck) & 1) * 4608; LAS bf16* Sw = Sbf0 + (((ck) + 1) & 1) * 4608; \
                const bf16x8 s0 = *(const LAS bf16x8*)(Sr + (16 * q + lr) * LS + 8 * lq), s1 = *(const LAS bf16x8*)(Sr + (16 * q + lr) * LS + 32 + 8 * lq); \
                if (wave >= 4) {       \
                    const LAS bf16* RP = (const LAS bf16*)(bb + 9216); const LAS bf16* YL = (const LAS bf16*)(bb + 36864); \
                    _Pragma("unroll") for (int ct = 0; ct < 4; ++ct) { \
                        const v2u y4 = *(const LAS v2u*)(YL + (16 * q + lr) * LS + 16 * ct + 4 * lq); f32x4 y = {bflo(y4.x), bfhi(y4.x), bflo(y4.y), bfhi(y4.y)}; \
                        const bf16x8 r0 = *(const LAS bf16x8*)(RP + (16 * ct + lr) * LS + 8 * lq), r1 = *(const LAS bf16x8*)(RP + (16 * ct + lr) * LS + 32 + 8 * lq); \
                        y = __builtin_amdgcn_mfma_f32_16x16x32_bf16(r0, s0, y, 0, 0, 0); y = __builtin_amdgcn_mfma_f32_16x16x32_bf16(r1, s1, y, 0, 0, 0); \
                        _Pragma("unroll") for (int i = 0; i < 4; ++i) Y[((size_t)b * SEQ + (size_t)(ck) * 64 + 16 * ct + 4 * lq + i) * RW + h * 64 + 16 * q + lr] = y[i]; } \
                } else {               \
                    const LAS bf16* AP = (const LAS bf16*)(bb); const LAS bf16* BH = (const LAS bf16*)(bb + 18432); const LAS bf16* WT = (const LAS bf16*)(bb + 27648); \
                    const LAS bf16* GT = (const LAS bf16*)(bb + 46080); const LAS float* GCl = (const LAS float*)(bb + 55296); \
                    _Pragma("unroll") for (int ct = 0; ct < 4; ++ct) { \
                        const v2u w4 = *(const LAS v2u*)(WT + (16 * q + lr) * LS + 16 * ct + 4 * lq); f32x4 u = {bflo(w4.x), bfhi(w4.x), bflo(w4.y), bfhi(w4.y)}; \
                        const bf16x8 a0 = *(const LAS bf16x8*)(AP + (16 * ct + lr) * LS + 8 * lq), a1 = *(const LAS bf16x8*)(AP + (16 * ct + lr) * LS + 32 + 8 * lq); \
                        u = __builtin_amdgcn_mfma_f32_16x16x32_bf16(a0, s0, u, 0, 0, 0); u = __builtin_amdgcn_mfma_f32_16x16x32_bf16(a1, s1, u, 0, 0, 0); \
                        *(LAS v2u*)(UT + (16 * q + lr) * LS + 16 * ct + 4 * lq) = (v2u){pk2(u[0], u[1]), pk2(u[2], u[3])}; } \
                    const bf16x8 ua = *(const LAS bf16x8*)(UT + (16 * q + lr) * LS + 8 * lq), ub = *(const LAS bf16x8*)(UT + (16 * q + lr) * LS + 32 + 8 * lq); \
                    _Pragma("unroll") for (int kt = 0; kt < 4; ++kt) { \
                        const v2u g4 = *(const LAS v2u*)(GT + (16 * kt + lr) * LS + 16 * q + 4 * lq); const float gam = GCl[16 * kt + lr]; \
                        st[kt] = st[kt] * gam + (f32x4){bflo(g4.x), bfhi(g4.x), bflo(g4.y), bfhi(g4.y)}; \
                        const bf16x8 b0 = *(const LAS bf16x8*)(BH + (16 * kt + lr) * LS + 8 * lq), b1 = *(const LAS bf16x8*)(BH + (16 * kt + lr) * LS + 32 + 8 * lq); \
                        st[kt] = __builtin_amdgcn_mfma_f32_16x16x32_bf16(ua, b0, st[kt], 0, 0, 0); st[kt] = __builtin_amdgcn_mfma_f32_16x16x32_bf16(ub, b1, st[kt], 0, 0, 0); \
                        _Pragma("unroll") for (int i = 0; i < 4; ++i) Sw[(16 * q + 4 * lq + i) * LS + 16 * kt + lr] = (bf16)f2bf(st[kt][i]); } \
                } } while (0)
            SEQ_LOAD(preA, gcA, 0); SEQ_STORE(preA, gcA, 0); SEQ_LOAD(preA, gcA, 1); __syncthreads();
            for (int ck = 0; ck < SEQ / 64; ck += 2) {
                if (ck + 2 < SEQ / 64) SEQ_LOAD(preB, gcB, ck + 2);
                SEQ_COMPUTE(ck);
                SEQ_STORE(preA, gcA, 1);
                __syncthreads();
                if (ck + 3 < SEQ / 64) SEQ_LOAD(preA, gcA, ck + 3);
                SEQ_COMPUTE(ck + 1);
                if (ck + 2 < SEQ / 64) SEQ_STORE(preB, gcB, 0);
                __syncthreads();
            }
#undef SEQ_COMPUTE
#undef SEQ_LOAD
#undef SEQ_STORE
        }
        if (BOTH(PH_SEQ)) GRID_BAR();
    }

    if (IN(PH_POST)) {
        const float* const Y = (const float*)(ws + WS_Y); const bf16* const Vb = (const bf16*)(ws + WS_V); const bf16* const GTb = (const bf16*)((unsigned char*)out + DO_GT);
        const float* const BONUS = (const float*)(ws + WS_BONUS); bf16* const ORW = (bf16*)(ws + WS_ORW);
        const float lnw = args.in[13][tid], lnb = args.in[14][tid];
        for (int t4 = vcu * 4; t4 < T; t4 += G * 4) {
            float yv[4], vv[4], gv[4], bo[4];
#pragma unroll
            for (int u = 0; u < 4; ++u) { const size_t o = (size_t)(t4 + u) * RW + tid; yv[u] = Y[o]; vv[u] = bf2f(Vb[o]); gv[u] = bf2f(GTb[o]); bo[u] = BONUS[(size_t)(t4 + u) * 8 + wave]; }
#pragma unroll
            for (int u = 0; u < 4; ++u) { const size_t o = (size_t)(t4 + u) * RW + tid;
                const float mean = wave_sum(yv[u]) * (1.f / 64.f); const float dy = yv[u] - mean; const float var = wave_sum(dy * dy) * (1.f / 64.f);
                const float yn = dy * (1.f / sqrtf(var + GN_EPS)) * lnw + lnb;
                ORW[o] = (bf16)f2bf((yn + bo[u] * vv[u]) * gv[u]); }
        }
        if (BOTH(PH_POST)) GRID_BAR();
    }

    if (IN(PH_UPA)) {
        pg8::Gemm g{(const bf16*)(ws + WS_OA), WauT, T, D, 256}; pg8::StaticOrder S; S.init(T, D, G, (int)blockIdx.x);
        pg8::EpiGateF32 E{out, ZG, ZG_LD, 0};
        pg8::gemm_phase<pg8::EpiGateF32, pg8::StaticOrder, PG8_ALIGN, PG8_SP2>(lds + RING_OFF, g, S, E);
        if (BOTH(PH_UPA)) GRID_BAR();
    }
    if (IN(PH_UPR)) {
        pg8::Gemm g{(const bf16*)(ws + WS_ORW), WruT, T, D, 512}; pg8::StaticOrder S; S.init(T, D, G, (int)blockIdx.x);
        pg8::EpiMerge E{out, ZG, ZG_LD, 1024, (bf16*)(ws + WS_M1)};
        pg8::gemm_phase<pg8::EpiMerge, pg8::StaticOrder, PG8_ALIGN, PG8_SP2>(lds + RING_OFF, g, S, E);
        if (BOTH(PH_UPR)) GRID_BAR();
    }
    if (IN(PH_WO)) {
        pg8::Gemm g{(const bf16*)(ws + WS_M1), WoT, T, D, D}; pg8::StaticOrder S; S.init(T, D, G, (int)blockIdx.x);
        pg8::EpiF32<0> E{(float*)(ws + WS_TMP2A)};
        pg8::gemm_phase<pg8::EpiF32<0>, pg8::StaticOrder, PG8_ALIGN, PG8_SP2>(lds + RING_OFF, g, S, E);
        if (BOTH(PH_WO)) GRID_BAR();
    }
    if (IN(PH_ROWA)) {
        const float* const tmp = (const float*)(ws + WS_TMP2A); const float* const g1 = args.in[18]; const float* const g2 = args.in[19];
        for (int m = gw; m < T; m += NGW) {
            const GAS f32x4* tr = (const GAS f32x4*)(tmp + (size_t)m * D) + lane; const GAS f32x4* xr = (const GAS f32x4*)(x + (size_t)m * D) + lane;
            f32x4 v[4]; float s = 0.f;
#pragma unroll
            for (int j = 0; j < 4; ++j) { v[j] = tr[64 * j]; s += (v[j].x * v[j].x + v[j].y * v[j].y) + (v[j].z * v[j].z + v[j].w * v[j].w); }
            const float rs = 1.f / sqrtf(wave_sum(s) * (1.f / D) + NORM_EPS); float s2 = 0.f;
#pragma unroll
            for (int j = 0; j < 4; ++j) { const f32x4 gg = ((const GAS f32x4*)g1)[lane + 64 * j]; const f32x4 xx = xr[64 * j];
                v[j].x = xx.x + v[j].x * rs * gg.x; v[j].y = xx.y + v[j].y * rs * gg.y; v[j].z = xx.z + v[j].z * rs * gg.z; v[j].w = xx.w + v[j].w * rs * gg.w;
                ((GAS f32x4*)(out + (size_t)m * D))[lane + 64 * j] = v[j];
                s2 += (v[j].x * v[j].x + v[j].y * v[j].y) + (v[j].z * v[j].z + v[j].w * v[j].w); }
            const float rs2 = 1.f / sqrtf(wave_sum(s2) * (1.f / D) + NORM_EPS);
            GAS unsigned long long* o8 = (GAS unsigned long long*)(XN + (size_t)m * D) + lane;
#pragma unroll
            for (int j = 0; j < 4; ++j) { const f32x4 gg = ((const GAS f32x4*)g2)[lane + 64 * j];
                o8[64 * j] = (unsigned long long)pk2(v[j].x * rs2 * gg.x, v[j].y * rs2 * gg.y) | ((unsigned long long)pk2(v[j].z * rs2 * gg.z, v[j].w * rs2 * gg.w) << 32); }
        }
        if (BOTH(PH_ROWA)) GRID_BAR();
    }
    if (IN(PH_FFI)) {
        pg8::Gemm g{XN, WfiT, T, FF, D}; pg8::StaticOrder S; S.init(T, FF, G, (int)blockIdx.x);
        pg8::EpiRelu2 E{(bf16*)(ws + WS_H)};
        pg8::gemm_phase<pg8::EpiRelu2, pg8::StaticOrder, PG8_ALIGN, PG8_SP2>(lds + RING_OFF, g, S, E);
        if (BOTH(PH_FFI)) GRID_BAR();
    }
    if (IN(PH_FFO)) {
        pg8::Gemm g{(const bf16*)(ws + WS_H), WfoT, T, D, FF}; pg8::StaticOrder S; S.init(T, D, G, (int)blockIdx.x);
        pg8::EpiF32<0> E{(float*)(ws + WS_TMP2B)};
        pg8::gemm_phase<pg8::EpiF32<0>, pg8::StaticOrder, PG8_ALIGN, PG8_SP2>(lds + RING_OFF, g, S, E);
        if (BOTH(PH_FFO)) GRID_BAR();
    }
    if (IN(PH_ROWB)) {
        const float* const tmp = (const float*)(ws + WS_TMP2B); const float* const g1 = args.in[22];
        for (int m = gw; m < T; m += NGW) {
            const GAS f32x4* tr = (const GAS f32x4*)(tmp + (size_t)m * D) + lane; GAS f32x4* hr = (GAS f32x4*)(out + (size_t)m * D) + lane;
            f32x4 v[4]; float s = 0.f;
#pragma unroll
            for (int j = 0; j < 4; ++j) { v[j] = tr[64 * j]; s += (v[j].x * v[j].x + v[j].y * v[j].y) + (v[j].z * v[j].z + v[j].w * v[j].w); }
            const float rs = 1.f / sqrtf(wave_sum(s) * (1.f / D) + NORM_EPS);
            GAS unsigned long long* o8 = (GAS unsigned long long*)(XN + (size_t)m * D) + lane;
#pragma unroll
            for (int j = 0; j < 4; ++j) { const f32x4 gg = ((const GAS f32x4*)g1)[lane + 64 * j]; const f32x4 hh = hr[64 * j];
                v[j].x = hh.x + v[j].x * rs * gg.x; v[j].y = hh.y + v[j].y * rs * gg.y; v[j].z = hh.z + v[j].z * rs * gg.z; v[j].w = hh.w + v[j].w * rs * gg.w;
                hr[64 * j] = v[j];
                o8[64 * j] = (unsigned long long)pk2(v[j].x, v[j].y) | ((unsigned long long)pk2(v[j].z, v[j].w) << 32); }
        }
        if (BOTH(PH_ROWB)) GRID_BAR();
    }
    if (IN(PH_PLE)) {
        pg8::Gemm g{PB, WpleT, T, D, PLE}; pg8::StaticOrder S; S.init(T, D, G, (int)blockIdx.x);
        pg8::EpiF32<0> E{(float*)(ws + WS_E)};
        pg8::gemm_phase<pg8::EpiF32<0>, pg8::StaticOrder, PG8_ALIGN, PG8_SP2>(lds + RING_OFF, g, S, E);
        if (BOTH(PH_PLE)) GRID_BAR();
    }
    if (IN(PH_PLEG)) {
        pg8::Gemm g{XN, WpgT, T, D, D}; pg8::StaticOrder S; S.init(T, D, G, (int)blockIdx.x);
        pg8::EpiF32<1> E{(float*)(ws + WS_E)};
        pg8::gemm_phase<pg8::EpiF32<1>, pg8::StaticOrder, PG8_ALIGN, PG8_SP2>(lds + RING_OFF, g, S, E);
        if (BOTH(PH_PLEG)) GRID_BAR();
    }
    if (IN(PH_ROWC)) {
        const float* const tmp = (const float*)(ws + WS_E); const float* const g1 = args.in[25];
        for (int m = gw; m < T; m += NGW) {
            const GAS f32x4* tr = (const GAS f32x4*)(tmp + (size_t)m * D) + lane; GAS f32x4* hr = (GAS f32x4*)(out + (size_t)m * D) + lane;
            f32x4 v[4]; float s = 0.f;
#pragma unroll
            for (int j = 0; j < 4; ++j) { v[j] = tr[64 * j]; s += (v[j].x * v[j].x + v[j].y * v[j].y) + (v[j].z * v[j].z + v[j].w * v[j].w); }
            const float rs = 1.f / sqrtf(wave_sum(s) * (1.f / D) + NORM_EPS);
#pragma unroll
            for (int j = 0; j < 4; ++j) { const f32x4 gg = ((const GAS f32x4*)g1)[lane + 64 * j]; const f32x4 hh = hr[64 * j];
                v[j].x = hh.x + v[j].x * rs * gg.x; v[j].y = hh.y + v[j].y * rs * gg.y; v[j].z = hh.z + v[j].z * rs * gg.z; v[j].w = hh.w + v[j].w * rs * gg.w;
                hr[64 * j] = v[j]; }
        }
    }
#undef IN
#undef BOTH
}

extern "C" void kernel_launch(void* const* d_in, const int* in_sizes, int n_in, void* d_out, int out_size, void* d_ws, size_t ws_size, hipStream_t stream) {
    static int grid = 0;
    if (grid == 0) {
        if (n_in != 26 || in_sizes[0] != T * D || out_size != T * D || ws_size < WS_END) { fprintf(stderr, "kernel_launch: shape/workspace mismatch (n_in %d, in0 %d, out %d, ws %zu)\n", n_in, n_in > 0 ? in_sizes[0] : -1, out_size, ws_size); grid = -1; return; }
        int dev = 0, cus = 0, per_cu = 0;
        if (hipGetDevice(&dev) != hipSuccess || hipDeviceGetAttribute(&cus, hipDeviceAttributeMultiprocessorCount, dev) != hipSuccess) { grid = -1; return; }
        if (hipFuncSetAttribute((const void*)skel_fwd, hipFuncAttributeMaxDynamicSharedMemorySize, LDS_BYTES) != hipSuccess) { fprintf(stderr, "kernel_launch: hipFuncSetAttribute failed\n"); grid = -1; return; }
        if (hipOccupancyMaxActiveBlocksPerMultiprocessor(&per_cu, (const void*)skel_fwd, NWAVES * 64, LDS_BYTES) != hipSuccess || per_cu < 1) { fprintf(stderr, "kernel_launch: occupancy query says %d\n", per_cu); }
        (void)hipGetLastError();
        grid = cus;
    }
    if (grid < 0) return;
    if (hipMemsetAsync((char*)d_ws + WS_CTL, 0, CTL_ZERO_BYTES, stream) != hipSuccess) return;
    Args a{};
    for (int i = 0; i < 26; ++i) a.in[i] = (const float*)d_in[i];
    a.out = (float*)d_out; a.ws = (unsigned char*)d_ws;
#if MK_PER_PHASE
    for (int li = 0; li < N_PHASES; ++li) { a.ph_lo = li; a.ph_hi = li + 1; a.li = li; hipLaunchKernelGGL(skel_fwd, dim3(grid), dim3(NWAVES * 64), LDS_BYTES, stream, a); }
#else
    a.ph_lo = 0; a.ph_hi = N_PHASES; a.li = 0; hipLaunchKernelGGL(skel_fwd, dim3(grid), dim3(NWAVES * 64), LDS_BYTES, stream, a);
#endif
}
```

```cpp
#include <hip/hip_runtime.h>
#include <cstdio>
#include <cstdint>
namespace pg8 {
#define PG8_LAS __attribute__((address_space(3)))
typedef unsigned short bf16_t;
typedef short bf16x8 __attribute__((ext_vector_type(8)));
typedef float f32x4 __attribute__((ext_vector_type(4)));
typedef unsigned u32x4 __attribute__((ext_vector_type(4)));
constexpr int BM = 256, BK = 64, HALF = 128, HTB = HALF * BK * 2  , STAGE_BYTES = 8 * HTB, NXCD = 8, WGM = 8;

__host__ __device__ __forceinline__ int lds_byte(int r, int c) { const int st = (r >> 4) * 2 + (c >> 5), rr = r & 15, cc = c & 31, ob = rr * 64 + cc * 2; return st * 1024 + (ob ^ (((ob >> 9) & 1) << 5)); }
__host__ __device__ __forceinline__ void stage_rc(int b, int& R, int& C) { const int st = b / 1024, sb = b % 1024, swz = sb ^ (((sb >> 9) & 1) << 5); R = (st >> 1) * 16 + swz / 64; C = (st & 1) * 32 + (swz % 64) / 2; }
__host__ __device__ __forceinline__ int perm32(int rho) { const int n = rho >> 4, i = rho & 15; return 8 * (i >> 2) + 4 * n + (i & 3); }

struct Unit { int pm, pn; };
struct Gemm { const bf16_t* A; const bf16_t* Bt; int M, N, K; };

struct StaticOrder {
    int nM, nN, nwg, G, c;
    __host__ __device__ void init(int M, int N, int G_, int c_) { nM = M / BM; nN = N / BM; nwg = nM * nN; G = G_; c = c_; }
    __host__ __device__ bool next(int i, Unit& u) const {
        const long L = (long)i * G + c; if (L >= nwg) return false;
        int wgid = (int)L; { const int q = nwg / NXCD, r = nwg % NXCD, xcd = wgid % NXCD, off = wgid / NXCD; wgid = (xcd < r ? xcd * (q + 1) : r * (q + 1) + (xcd - r) * q) + off; }
        const int nig = WGM * nN, gid = wgid / nig, fm = gid * WGM, gsz = (nM - fm) < WGM ? (nM - fm) : WGM;
        u.pm = fm + ((wgid % nig) % gsz); u.pn = (wgid % nig) / gsz; return true;
    }
    __device__ __forceinline__ void a_ready(const Unit&) const {}
    __device__ __forceinline__ void done(const Unit&) const {}
};

typedef __bf16 bf16pair_t __attribute__((ext_vector_type(2)));
__device__ __forceinline__ unsigned cvt_pk_bf16(float lo, float hi) { const bf16pair_t v = {(__bf16)lo, (__bf16)hi}; return __builtin_bit_cast(unsigned, v); }
typedef float f32x2 __attribute__((ext_vector_type(2)));
__device__ __forceinline__ f32x2 gelu_pk(f32x2 v) {
    const f32x2 av = __builtin_elementwise_abs(v), d = av * 0.2316418882f + 1.0f;
    f32x2 t; t.x = __builtin_amdgcn_rcpf(d.x); t.y = __builtin_amdgcn_rcpf(d.y);
    f32x2 q = t * 0.5307027145f + (-0.7265760135f); q = q * t + 0.7107068705f; q = q * t + (-0.142248368f); q = q * t + 0.127414796f; q = q * t;
    const f32x2 s = (v * v) * (-0.72134752044f);
    f32x2 e; e.x = __builtin_amdgcn_exp2f(s.x); e.y = __builtin_amdgcn_exp2f(s.y);
    const f32x2 m = v * (q * e), r = v - m;
    f32x2 o; o.x = v.x < 0.f ? m.x : r.x; o.y = v.y < 0.f ? m.y : r.y; return o;
}

template <int ACT  > struct EpiBf16 {
    static constexpr bool PERM = true, AFTER_DRAIN = false; static_assert(ACT == 0 || ACT == 1, "EpiBf16: ACT is 0 (none) or 1 (gelu_pk)");
    bf16_t* O; int ldc; const float* bias; int split_cols; size_t split_stride; float scale0;
    __device__ __forceinline__ void operator()(const f32x4 (&acc)[2][2][4][2], const Unit& u, int wr, int wc, int fr, int fq) const {
        const int row0 = u.pm * BM + wr * 64 + fr; int colt = u.pn * BM; bf16_t* base = O;
        float sc = 1.f; if (split_cols) { const int t = colt / split_cols; base += (size_t)t * split_stride; colt -= t * split_cols; if (t == 0) sc = scale0; }
        const int col0 = colt + wc * 32 + 8 * fq, bcol0 = u.pn * BM + wc * 32 + 8 * fq;
        f32x4 bv[2][2];
#pragma unroll
        for (int bj = 0; bj < 2; ++bj)
#pragma unroll
            for (int n = 0; n < 2; ++n) bv[bj][n] = bias ? *(const f32x4*)(bias + bcol0 + bj * HALF + 4 * n) : (f32x4){0.f, 0.f, 0.f, 0.f};
#pragma unroll
        for (int ai = 0; ai < 2; ++ai)
#pragma unroll
            for (int m = 0; m < 4; ++m) { bf16_t* rowp = base + (size_t)(row0 + ai * HALF + m * 16) * ldc + col0;
#pragma unroll
                for (int bj = 0; bj < 2; ++bj) { f32x4 v0 = acc[ai][bj][m][0] + bv[bj][0], v1 = acc[ai][bj][m][1] + bv[bj][1];
                    if (ACT == 1) { f32x2 a = gelu_pk((f32x2){v0[0], v0[1]}), b = gelu_pk((f32x2){v0[2], v0[3]}), c = gelu_pk((f32x2){v1[0], v1[1]}), d = gelu_pk((f32x2){v1[2], v1[3]});
                        v0 = (f32x4){a.x, a.y, b.x, b.y}; v1 = (f32x4){c.x, c.y, d.x, d.y}; }
                    v0 = v0 * sc; v1 = v1 * sc; u32x4 w; w.x = cvt_pk_bf16(v0[0], v0[1]); w.y = cvt_pk_bf16(v0[2], v0[3]); w.z = cvt_pk_bf16(v1[0], v1[1]); w.w = cvt_pk_bf16(v1[2], v1[3]);
                    *(u32x4*)(rowp + bj * HALF) = w; } }
    }
};
template <class Epi, class Sched, bool ALIGN_EPI = false, bool SP2 = false>
__device__ __forceinline__ void gemm_phase(PG8_LAS unsigned char* lds, const Gemm g, const Sched& S, const Epi& E) {
    const int tid = threadIdx.x, wid = __builtin_amdgcn_readfirstlane(tid >> 6), lane = tid & 63, wr = wid >> 2, wc = wid & 3, fr = lane & 15, fq = lane >> 4;
    const int K = g.K, nt = K / BK;
    unsigned voffA[2], voffB[2];
#pragma unroll
    for (int i = 0; i < 2; ++i) { int R, C; stage_rc(tid * 16 + i * 8192, R, C); const int Rb = Epi::PERM ? ((R & ~31) + perm32(R & 31)) : R;
        voffA[i] = (unsigned)(R * K + C) * 2u; voffB[i] = (unsigned)(Rb * K + C) * 2u; }
    const size_t kstep = (size_t)(BK * 2);
    const size_t hstep = (size_t)HALF * K * 2;
    const size_t tstep = 2 * hstep;
    const unsigned ldsw = (unsigned)wid * 1024u;
    const int aoff = lds_byte(wr * 64 + fr, fq * 8), boff = lds_byte(wc * 32 + fr, fq * 8);
#define PG8_SA(b, h) (((b) * 2 + (h)) * HTB)
#define PG8_SB(b, h) ((4 + (b) * 2 + (h)) * HTB)
#define PG8_STAGE(bufoff, gbase, voff) do { _Pragma("unroll") for (int _i = 0; _i < 2; ++_i) \
        __builtin_amdgcn_global_load_lds((const unsigned*)((const char*)(gbase) + (voff)[_i]), (PG8_LAS unsigned*)(lds + (bufoff) + ldsw + _i * 8192), 16, 0, 0); } while (0)
#define PG8_LDA(dst, b, h) do { _Pragma("unroll") for (int m = 0; m < 4; ++m) _Pragma("unroll") for (int k = 0; k < 2; ++k) dst[m][k] = *(const PG8_LAS bf16x8*)(lds + PG8_SA(b, h) + aoff + m * 2048 + k * 1024); } while (0)
#define PG8_LDB(dst, b, h) do { _Pragma("unroll") for (int n = 0; n < 2; ++n) _Pragma("unroll") for (int k = 0; k < 2; ++k) dst[n][k] = *(const PG8_LAS bf16x8*)(lds + PG8_SB(b, h) + boff + n * 2048 + k * 1024); } while (0)
#define PG8_MMA(ai, bj, At, Bt) do { __builtin_amdgcn_s_setprio(1); _Pragma("unroll") for (int m = 0; m < 4; ++m) _Pragma("unroll") for (int n = 0; n < 2; ++n) _Pragma("unroll") for (int k = 0; k < 2; ++k) \
        acc[ai][bj][m][n] = __builtin_amdgcn_mfma_f32_16x16x32_bf16(Bt[n][k], At[m][k], acc[ai][bj][m][n], 0, 0, 0); __builtin_amdgcn_s_setprio(0); } while (0)
#define PG8_WAIT_V(n) asm volatile("s_waitcnt vmcnt(" #n ")" ::: "memory")
#define PG8_WAIT_L(n) asm volatile("s_waitcnt lgkmcnt(" #n ")" ::: "memory")
#define PG8_BAR __builtin_amdgcn_s_barrier()
#define PG8_SCHED __builtin_amdgcn_sched_barrier(0)
    Unit cur, nxt; int ui = 0;
    if (!S.next(0, cur)) return;
    f32x4 acc[2][2][4][2];
#pragma unroll
    for (int a = 0; a < 2; ++a)
#pragma unroll
        for (int b = 0; b < 2; ++b)
#pragma unroll
            for (int m = 0; m < 4; ++m)
#pragma unroll
                for (int n = 0; n < 2; ++n) acc[a][b][m][n] = (f32x4){0.f, 0.f, 0.f, 0.f};
    bf16x8 At[4][2], B0[2][2], B1[2][2];
    const char* cA = (const char*)g.A + (size_t)cur.pm * tstep; const char* cB = (const char*)g.Bt + (size_t)cur.pn * tstep;
    S.a_ready(cur);
    if constexpr (SP2) {
        PG8_STAGE(PG8_SB(0, 0), cB, voffB); PG8_STAGE(PG8_SB(0, 1), cB + hstep, voffB); PG8_STAGE(PG8_SA(0, 0), cA, voffA); PG8_STAGE(PG8_SA(0, 1), cA + hstep, voffA);
        if (wr == 1) PG8_BAR;
        PG8_WAIT_V(2); PG8_BAR;
        PG8_STAGE(PG8_SB(1, 0), cB + kstep, voffB); PG8_STAGE(PG8_SA(1, 0), cA + kstep, voffA); PG8_STAGE(PG8_SB(1, 1), cB + hstep + kstep, voffB);
        PG8_WAIT_V(6); PG8_BAR;
    } else {
        PG8_STAGE(PG8_SB(0, 0), cB, voffB); PG8_STAGE(PG8_SA(0, 0), cA, voffA); PG8_STAGE(PG8_SB(0, 1), cB + hstep, voffB); PG8_STAGE(PG8_SA(0, 1), cA + hstep, voffA);
        if (wr == 1) PG8_BAR;
        PG8_WAIT_V(4); PG8_BAR;
        PG8_STAGE(PG8_SB(1, 0), cB + kstep, voffB); PG8_STAGE(PG8_SA(1, 0), cA + kstep, voffA); PG8_STAGE(PG8_SB(1, 1), cB + hstep + kstep, voffB);
        PG8_WAIT_V(6); PG8_BAR;
    }
    for (;;) {
        const bool has_next = S.next(ui + 1, nxt);
        const char* nA = has_next ? (const char*)g.A + (size_t)nxt.pm * tstep : cA; const char* nB = has_next ? (const char*)g.Bt + (size_t)nxt.pn * tstep : cB;
        for (int t = 0; t < nt; t += 2) {
            const bool last = (t == nt - 2);
            const char* a1 = cA + (size_t)(t + 1) * kstep;
            const char* a2 = last ? nA : cA + (size_t)(t + 2) * kstep; const char* b2 = last ? nB : cB + (size_t)(t + 2) * kstep;
            const char* a3 = a2 + kstep; const char* b3 = b2 + kstep;
            if (last && has_next) S.a_ready(nxt);
            if constexpr (SP2) {
            PG8_LDB(B0, 0, 0); PG8_LDB(B1, 0, 1); PG8_SCHED; PG8_LDA(At, 0, 0); PG8_STAGE(PG8_SA(1, 1), a1 + hstep, voffA);
            PG8_WAIT_V(8); PG8_WAIT_L(0); PG8_BAR; PG8_MMA(0, 0, At, B0); PG8_MMA(0, 1, At, B1); PG8_BAR; PG8_SCHED;
            PG8_LDA(At, 0, 1); PG8_STAGE(PG8_SB(0, 0), b2, voffB); PG8_STAGE(PG8_SB(0, 1), b2 + hstep, voffB); PG8_STAGE(PG8_SA(0, 0), a2, voffA);
            PG8_WAIT_V(8); PG8_WAIT_L(0); PG8_BAR; PG8_MMA(1, 0, At, B0); PG8_MMA(1, 1, At, B1); PG8_BAR; PG8_SCHED;
            PG8_LDB(B0, 1, 0); PG8_LDB(B1, 1, 1); PG8_SCHED; PG8_LDA(At, 1, 0); PG8_STAGE(PG8_SA(0, 1), a2 + hstep, voffA);
            PG8_WAIT_V(8); PG8_WAIT_L(0); PG8_BAR; PG8_MMA(0, 0, At, B0); PG8_MMA(0, 1, At, B1); PG8_BAR; PG8_SCHED;
            PG8_LDA(At, 1, 1); PG8_STAGE(PG8_SB(1, 0), b3, voffB); PG8_STAGE(PG8_SB(1, 1), b3 + hstep, voffB); PG8_STAGE(PG8_SA(1, 0), a3, voffA);
            PG8_WAIT_V(8); PG8_WAIT_L(0); PG8_BAR; PG8_MMA(1, 0, At, B0); PG8_MMA(1, 1, At, B1); PG8_BAR; PG8_SCHED;
            } else {
            PG8_LDB(B0, 0, 0); PG8_SCHED; PG8_LDA(At, 0, 0); PG8_STAGE(PG8_SA(1, 1), a1 + hstep, voffA);
            PG8_WAIT_L(8); PG8_BAR; PG8_WAIT_L(0); PG8_MMA(0, 0, At, B0); PG8_BAR; PG8_SCHED;
            PG8_LDB(B1, 0, 1); PG8_STAGE(PG8_SB(0, 0), b2, voffB);
            PG8_BAR; PG8_WAIT_L(0); PG8_MMA(0, 1, At, B1); PG8_BAR;
            PG8_LDA(At, 0, 1); PG8_STAGE(PG8_SA(0, 0), a2, voffA);
            PG8_BAR; PG8_WAIT_L(0); PG8_MMA(1, 0, At, B0); PG8_BAR; PG8_SCHED;
            PG8_STAGE(PG8_SB(0, 1), b2 + hstep, voffB);
            PG8_WAIT_V(6); PG8_BAR; PG8_MMA(1, 1, At, B1); PG8_BAR;
            PG8_LDB(B0, 1, 0); PG8_SCHED; PG8_LDA(At, 1, 0); PG8_STAGE(PG8_SA(0, 1), a2 + hstep, voffA);
            PG8_WAIT_L(8); PG8_BAR; PG8_WAIT_L(0); PG8_MMA(0, 0, At, B0); PG8_BAR; PG8_SCHED;
            PG8_LDB(B1, 1, 1); PG8_STAGE(PG8_SB(1, 0), b3, voffB);
            PG8_BAR; PG8_WAIT_L(0); PG8_MMA(0, 1, At, B1); PG8_BAR;
            PG8_LDA(At, 1, 1); PG8_STAGE(PG8_SA(1, 0), a3, voffA);
            PG8_BAR; PG8_WAIT_L(0); PG8_MMA(1, 0, At, B0); PG8_BAR; PG8_SCHED;
            PG8_STAGE(PG8_SB(1, 1), b3 + hstep, voffB);
            PG8_WAIT_V(6); PG8_BAR; PG8_MMA(1, 1, At, B1); PG8_BAR;
            }
        }
        if constexpr (ALIGN_EPI) { if (wr == 0) PG8_BAR; }
        if constexpr (!Epi::AFTER_DRAIN) { E(acc, cur, wr, wc, fr, fq); S.done(cur); }
        if (!has_next) break;
#pragma unroll
        for (int a = 0; a < 2; ++a)
#pragma unroll
            for (int b = 0; b < 2; ++b)
#pragma unroll
                for (int m = 0; m < 4; ++m)
#pragma unroll
                    for (int n = 0; n < 2; ++n) acc[a][b][m][n] = (f32x4){0.f, 0.f, 0.f, 0.f};
        cur = nxt; cA = nA; cB = nB; ++ui;
        if constexpr (ALIGN_EPI) { if (wr == 1) PG8_BAR; }
    }
    PG8_WAIT_V(0);
    if constexpr (!ALIGN_EPI) { if (wr == 0) PG8_BAR; }
    PG8_BAR;
    if constexpr (Epi::AFTER_DRAIN) { E.fused(acc, cur, wr, wc, fr, fq, lds, wid, lane); S.done(cur); }
#undef PG8_SA
#undef PG8_SB
#undef PG8_STAGE
#undef PG8_LDA
#undef PG8_LDB
#undef PG8_MMA
#undef PG8_WAIT_V
#undef PG8_WAIT_L
#undef PG8_BAR
#undef PG8_SCHED
}
}
#define GAS __attribute__((address_space(1)))
#define LAS __attribute__((address_space(3)))
typedef unsigned short bf16;
typedef unsigned v4u __attribute__((ext_vector_type(4)));
typedef float f32x4 __attribute__((ext_vector_type(4)));
typedef short bf16x8 __attribute__((ext_vector_type(8)));
typedef GAS unsigned gu32;
typedef GAS unsigned long long gu64;
#define RLX_AGENT __ATOMIC_RELAXED, __HIP_MEMORY_SCOPE_AGENT
#define LDS_WAIT() asm volatile("s_waitcnt lgkmcnt(0)" ::: "memory")
#define VM_WAIT() asm volatile("s_waitcnt vmcnt(0)" ::: "memory")
__device__ __forceinline__ unsigned long long rt() { return __builtin_amdgcn_s_memrealtime(); }
__device__ __forceinline__ unsigned f2bf(float f) { return (unsigned)__builtin_bit_cast(unsigned short, (__bf16)f); }
__device__ __forceinline__ unsigned pk2(float lo, float hi) { return pg8::cvt_pk_bf16(lo, hi); }

#define XB_TMO      128
#define XB_XCNT(j)  (256  + 64 * (j))
#define XB_XSUB(j)  (1280 + 64 * (j))
#define XB_XGEN(j)  (2304 + 64 * (j))
#define XB_TOP      3328
#define XB_TOPGEN   3392
#define XCD_BAR_WORDS 3456
#define XB_SPIN_CAP (1u << 18)

__device__ __forceinline__ unsigned xb_ld(unsigned* p)              { return __hip_atomic_load(p, __ATOMIC_RELAXED, __HIP_MEMORY_SCOPE_AGENT); }
__device__ __forceinline__ unsigned xb_add(unsigned* p, unsigned v) { return __hip_atomic_fetch_add(p, v, __ATOMIC_RELAXED, __HIP_MEMORY_SCOPE_AGENT); }
__device__ __forceinline__ unsigned xb_xcc_id() { return (unsigned)__builtin_amdgcn_s_getreg((3 << 11) | 20) & 0xFu; }
#define XB_SPIN(cond, bar) do { unsigned _sp = 0; while (cond) { __builtin_amdgcn_s_sleep(1); \
    if ((++_sp & 255u) == 0u) { if (xb_ld(&(bar)[XB_TMO])) break; if (_sp > XB_SPIN_CAP) { atomicAdd(&(bar)[XB_TMO], 1u); break; } } } } while (0)

struct XcdBarrier {
    unsigned* bar; unsigned x;
    volatile LAS unsigned* st;
};

__device__ __forceinline__ XcdBarrier xcd_barrier_post(unsigned* bar, volatile LAS unsigned* st) {
    XcdBarrier b; b.bar = bar; b.x = xb_xcc_id(); b.st = st;
    if (threadIdx.x == 0) (void)xb_add(&bar[XB_XCNT(b.x)], 1u);
    return b;
}
__device__ __forceinline__ void xcd_barrier_complete(unsigned* bar, unsigned x, unsigned& nloc, unsigned& nx) {
    const unsigned G = gridDim.x * gridDim.y * gridDim.z;
    unsigned sum, cnt, mine, sp = 0u;
    for (;;) {
        sum = 0u; cnt = 0u; mine = 0u;
#pragma unroll
        for (unsigned j = 0; j < 16; ++j) { const unsigned c = xb_ld(&bar[XB_XCNT(j)]); sum += c; cnt += (c > 0u) ? 1u : 0u; mine = (j == x) ? c : mine; }
        if (sum == G) break;
        __builtin_amdgcn_s_sleep(1);
        if ((++sp & 255u) == 0u) { if (xb_ld(&bar[XB_TMO])) break; if (sp > XB_SPIN_CAP) { atomicAdd(&bar[XB_TMO], 1u); break; } }
    }
    nloc = mine > 0u ? mine : 1u; nx = cnt > 0u ? cnt : 1u;
}

__device__ __forceinline__ void xcd_barrier(const XcdBarrier& b) {
    asm volatile("s_waitcnt vmcnt(0)" ::: "memory");
    __syncthreads();
    if (threadIdx.x == 0) {
        unsigned* bar = b.bar;
        __builtin_amdgcn_s_waitcnt(0);
        unsigned nloc = b.st[0], nx = b.st[1];
        if (nloc == 0u) { xcd_barrier_complete(bar, b.x, nloc, nx); b.st[0] = nloc; b.st[1] = nx; }
        const unsigned old = xb_add(&bar[XB_XSUB(b.x)], 1u);
        const unsigned gen = old / nloc;
        if (old + 1u == (gen + 1u) * nloc) {
            __builtin_amdgcn_fence(__ATOMIC_RELEASE, "agent");
            asm volatile("s_waitcnt vmcnt(0)" ::: "memory");
            const unsigned og = xb_add(&bar[XB_TOP], 1u);
            const unsigned tg = og / nx;
            if (og + 1u == (tg + 1u) * nx) xb_add(&bar[XB_TOPGEN], 1u);
            else XB_SPIN(xb_ld(&bar[XB_TOPGEN]) == tg, bar);
            __builtin_amdgcn_fence(__ATOMIC_ACQUIRE, "agent");
            xb_add(&bar[XB_XGEN(b.x)], 1u);
            asm volatile("s_waitcnt vmcnt(0)" ::: "memory");
        } else {
            XB_SPIN(xb_ld(&bar[XB_XGEN(b.x)]) == gen, bar);
            __builtin_amdgcn_fence(__ATOMIC_ACQUIRE, "agent");
            asm volatile("s_waitcnt vmcnt(0)" ::: "memory");
        }
    }
    __syncthreads();
}
#define PG8_SP2 true
#define PG8_ALIGN true

constexpr int NWAVES = 8;
constexpr int BATCH = 4, SEQ = 8192, D = 1024, T = BATCH * SEQ, HD = 64;
constexpr int NIN = 6144;
constexpr int FF = 4096, PLE = 256;
constexpr int ZA_LD = 2304, ZR_LD = 1792, ZG_LD = 2048;
constexpr int RW = 512;
constexpr float NORM_EPS = 1e-6f, GN_EPS = 64e-5f;
#ifndef MK_PER_PHASE
#define MK_PER_PHASE 0
#endif
enum { PH_PRO = 0, PH_INPROJ, PH_ATT, PH_PREP, PH_CHUNK, PH_SEQ, PH_POST, PH_UPA, PH_UPR, PH_WO, PH_ROWA, PH_FFI, PH_FFO, PH_ROWB, PH_PLE, PH_PLEG, PH_ROWC, N_PHASES };

constexpr size_t MiB = 1u << 20;
constexpr size_t WS_CTL = 0, CTL_ZERO_BYTES = 1 * MiB;
constexpr size_t WS_CS = 1 * MiB;
constexpr size_t WS_BONUS = 3 * MiB;
constexpr size_t WS_LSE = 4 * MiB;
constexpr size_t WS_WIN = 6 * MiB, WS_WFI = 18 * MiB, WS_WFO = 26 * MiB, WS_WO = 34 * MiB, WS_WPG = 36 * MiB;
constexpr size_t WS_WPLE = 38 * MiB, WS_WAU = 38 * MiB + 512 * 1024, WS_WRU = 39 * MiB;
constexpr size_t WS_XN = 40 * MiB;
constexpr size_t WS_PB = 104 * MiB;
constexpr size_t WS_ZA = 120 * MiB;
constexpr size_t WS_ZR = 264 * MiB;
constexpr size_t WS_ZG = 376 * MiB;
constexpr size_t WS_END = 512 * MiB;
constexpr size_t WS_OA = WS_XN;
constexpr size_t WS_R = WS_ZA, WS_KP = WS_ZA + 32 * MiB, WS_V = WS_ZA + 64 * MiB, WS_AV = WS_ZA + 96 * MiB;
constexpr size_t WS_Y = WS_ZR;
constexpr size_t WS_ORW = WS_ZR + 64 * MiB;
constexpr size_t WS_M1 = WS_ZA;
constexpr size_t WS_TMP2A = 184 * MiB;
constexpr size_t WS_H = WS_ZA;
constexpr size_t WS_TMP2B = WS_ZG;
constexpr size_t WS_E = WS_ZA;
constexpr size_t WS_OG = WS_XN + 16 * MiB;
constexpr size_t DO_DEC = 0;
constexpr size_t DO_BV = 64 * MiB, DO_GT = 96 * MiB;
constexpr size_t WS_YLT = WS_XN + 16 * MiB;
constexpr size_t WS_GC = 504 * MiB;
constexpr int CW_TMO = 0, CW_CODE = 1, CW_BAR = 4096;

constexpr int RING_OFF = 0, RING_BYTES = 143360;
constexpr int LDSCTL_OFF = RING_BYTES, MISC_OFF = LDSCTL_OFF + 320;
constexpr int LDS_BYTES = 147456;

typedef unsigned v2u __attribute__((ext_vector_type(2)));
__device__ __forceinline__ float bf2f(bf16 u) { return __builtin_bit_cast(float, (unsigned)u << 16); }
__device__ __forceinline__ float bflo(unsigned u) { return __builtin_bit_cast(float, u << 16); }
__device__ __forceinline__ float bfhi(unsigned u) { return __builtin_bit_cast(float, u & 0xffff0000u); }
__device__ __forceinline__ float sigmoidf_(float x) { return 1.0f / (1.0f + __expf(-x)); }
template <int CTRL> __device__ __forceinline__ float dpp_f(float v) { return __builtin_bit_cast(float, __builtin_amdgcn_update_dpp(0, __builtin_bit_cast(int, v), CTRL, 0xF, 0xF, true)); }
__device__ __forceinline__ float quad_sum(float v) { v += dpp_f<0xB1>(v); v += dpp_f<0x4E>(v); return v; }
__device__ __forceinline__ float wave_sum(float v) {
    v = quad_sum(v); v += dpp_f<0x141>(v); v += dpp_f<0x140>(v);
    return __builtin_bit_cast(float, __builtin_amdgcn_readlane(__builtin_bit_cast(int, v), 0)) + __builtin_bit_cast(float, __builtin_amdgcn_readlane(__builtin_bit_cast(int, v), 16)) +
           __builtin_bit_cast(float, __builtin_amdgcn_readlane(__builtin_bit_cast(int, v), 32)) + __builtin_bit_cast(float, __builtin_amdgcn_readlane(__builtin_bit_cast(int, v), 48));
}

namespace pg8 {
struct EpiInProj {
    static constexpr bool PERM = true, AFTER_DRAIN = false;
    bf16_t *za, *zr, *zg;
    __device__ __forceinline__ void operator()(const f32x4 (&acc)[2][2][4][2], const Unit& u, int wr, int wc, int fr, int fq) const {
        bf16_t* base; int ld, colt; bool sig = false;
        if (u.pn < 9) { base = za; ld = 2304; colt = u.pn * 256; }
        else if (u.pn < 16) { base = zr; ld = 1792; colt = (u.pn - 9) * 256; }
        else { base = zg; ld = 2048; colt = (u.pn - 16) * 256; sig = true; }
        const int row0 = u.pm * BM + wr * 64 + fr, col0 = colt + wc * 32 + 8 * fq;
#pragma unroll
        for (int ai = 0; ai < 2; ++ai)
#pragma unroll
            for (int m = 0; m < 4; ++m) { bf16_t* rowp = base + (size_t)(row0 + ai * HALF + m * 16) * ld + col0;
#pragma unroll
                for (int bj = 0; bj < 2; ++bj) { f32x4 v0 = acc[ai][bj][m][0], v1 = acc[ai][bj][m][1];
                    if (sig) {
#pragma unroll
                        for (int k = 0; k < 4; ++k) { v0[k] = 1.0f / (1.0f + __expf(-v0[k])); v1[k] = 1.0f / (1.0f + __expf(-v1[k])); } }
                    u32x4 w; w.x = cvt_pk_bf16(v0[0], v0[1]); w.y = cvt_pk_bf16(v0[2], v0[3]); w.z = cvt_pk_bf16(v1[0], v1[1]); w.w = cvt_pk_bf16(v1[2], v1[3]);
                    *(u32x4*)(rowp + bj * HALF) = w; } }
    }
};
struct EpiGateF32 {
    static constexpr bool PERM = false, AFTER_DRAIN = false;
    float* out; const bf16_t* gate; int gld, gcol0;
    __device__ __forceinline__ void operator()(const f32x4 (&acc)[2][2][4][2], const Unit& u, int wr, int wc, int fr, int fq) const {
        const int col0 = u.pn * BM + wc * 32 + 4 * fq;
#pragma unroll
        for (int ai = 0; ai < 2; ++ai)
#pragma unroll
            for (int m = 0; m < 4; ++m) { const int r = u.pm * BM + ai * HALF + wr * 64 + m * 16 + fr;
#pragma unroll
                for (int bj = 0; bj < 2; ++bj)
#pragma unroll
                    for (int n = 0; n < 2; ++n) { const int c = col0 + bj * HALF + n * 16;
                        const unsigned long long gq = *(const unsigned long long*)(gate + (size_t)r * gld + gcol0 + c);
                        const unsigned g0 = (unsigned)gq, g1 = (unsigned)(gq >> 32);
                        f32x4 a = acc[ai][bj][m][n];
                        a[0] *= __builtin_bit_cast(float, g0 << 16); a[1] *= __builtin_bit_cast(float, g0 & 0xffff0000u);
                        a[2] *= __builtin_bit_cast(float, g1 << 16); a[3] *= __builtin_bit_cast(float, g1 & 0xffff0000u);
                        *(f32x4*)(out + (size_t)r * 1024 + c) = a; } }
    }
};
struct EpiMerge {
    static constexpr bool PERM = true, AFTER_DRAIN = false;
    const float* tmp; const bf16_t* gate; int gld, gcol0; bf16_t* out;
    __device__ __forceinline__ void operator()(const f32x4 (&acc)[2][2][4][2], const Unit& u, int wr, int wc, int fr, int fq) const {
        const int row0 = u.pm * BM + wr * 64 + fr, col0 = u.pn * BM + wc * 32 + 8 * fq;
#pragma unroll
        for (int ai = 0; ai < 2; ++ai)
#pragma unroll
            for (int m = 0; m < 4; ++m) { const int r = row0 + ai * HALF + m * 16;
#pragma unroll
                for (int bj = 0; bj < 2; ++bj) { const int c = col0 + bj * HALF;
                    const u32x4 gq = *(const u32x4*)(gate + (size_t)r * gld + gcol0 + c);
                    const f32x4 t0 = *(const f32x4*)(tmp + (size_t)r * 1024 + c), t1 = *(const f32x4*)(tmp + (size_t)r * 1024 + c + 4);
                    f32x4 v0 = acc[ai][bj][m][0], v1 = acc[ai][bj][m][1];
                    v0[0] = t0[0] + v0[0] * __builtin_bit_cast(float, gq.x << 16); v0[1] = t0[1] + v0[1] * __builtin_bit_cast(float, gq.x & 0xffff0000u);
                    v0[2] = t0[2] + v0[2] * __builtin_bit_cast(float, gq.y << 16); v0[3] = t0[3] + v0[3] * __builtin_bit_cast(float, gq.y & 0xffff0000u);
                    v1[0] = t1[0] + v1[0] * __builtin_bit_cast(float, gq.z << 16); v1[1] = t1[1] + v1[1] * __builtin_bit_cast(float, gq.z & 0xffff0000u);
                    v1[2] = t1[2] + v1[2] * __builtin_bit_cast(float, gq.w << 16); v1[3] = t1[3] + v1[3] * __builtin_bit_cast(float, gq.w & 0xffff0000u);
                    u32x4 w; w.x = cvt_pk_bf16(v0[0], v0[1]); w.y = cvt_pk_bf16(v0[2], v0[3]); w.z = cvt_pk_bf16(v1[0], v1[1]); w.w = cvt_pk_bf16(v1[2], v1[3]);
                    *(u32x4*)(out + (size_t)r * 1024 + c) = w; } }
    }
};
template <int MODE> struct EpiF32 {
    static constexpr bool PERM = false, AFTER_DRAIN = false;
    float* out;
    __device__ __forceinline__ void operator()(const f32x4 (&acc)[2][2][4][2], const Unit& u, int wr, int wc, int fr, int fq) const {
        const int col0 = u.pn * BM + wc * 32 + 4 * fq;
#pragma unroll
        for (int ai = 0; ai < 2; ++ai)
#pragma unroll
            for (int m = 0; m < 4; ++m) { const int r = u.pm * BM + ai * HALF + wr * 64 + m * 16 + fr;
#pragma unroll
                for (int bj = 0; bj < 2; ++bj)
#pragma unroll
                    for (int n = 0; n < 2; ++n) { float* p = out + (size_t)r * 1024 + col0 + bj * HALF + n * 16; f32x4 a = acc[ai][bj][m][n];
                        if (MODE == 1) { const f32x4 e = *(const f32x4*)p;
#pragma unroll
                            for (int k = 0; k < 4; ++k) a[k] = e[k] / (1.0f + __expf(-a[k])); }
                        *(f32x4*)p = a; } }
    }
};
struct EpiRelu2 {
    static constexpr bool PERM = true, AFTER_DRAIN = false;
    bf16_t* out;
    __device__ __forceinline__ void operator()(const f32x4 (&acc)[2][2][4][2], const Unit& u, int wr, int wc, int fr, int fq) const {
        const int row0 = u.pm * BM + wr * 64 + fr, col0 = u.pn * BM + wc * 32 + 8 * fq;
#pragma unroll
        for (int ai = 0; ai < 2; ++ai)
#pragma unroll
            for (int m = 0; m < 4; ++m) { bf16_t* rowp = out + (size_t)(row0 + ai * HALF + m * 16) * 4096 + col0;
#pragma unroll
                for (int bj = 0; bj < 2; ++bj) { f32x4 v0 = acc[ai][bj][m][0], v1 = acc[ai][bj][m][1];
#pragma unroll
                    for (int k = 0; k < 4; ++k) { const float a = fmaxf(v0[k], 0.f), b = fmaxf(v1[k], 0.f); v0[k] = a * a; v1[k] = b * b; }
                    u32x4 w; w.x = cvt_pk_bf16(v0[0], v0[1]); w.y = cvt_pk_bf16(v0[2], v0[3]); w.z = cvt_pk_bf16(v1[0], v1[1]); w.w = cvt_pk_bf16(v1[2], v1[3]);
                    *(u32x4*)(rowp + bj * HALF) = w; } }
    }
};
}

__device__ __forceinline__ void p0_transpose_item(const float* W, int K, int N, bf16* WT, int row_off, LAS float* scr, int item, int lane) {
    const int nblk = N / 32, kb = item / nblk, nb = item % nblk, k0 = 64 * kb, n0 = 32 * nb;
#pragma unroll 8
    for (int i = 0; i < 32; ++i) { const int kk = 2 * i + (lane >> 5); scr[kk * 33 + (lane & 31)] = W[(size_t)(k0 + kk) * N + n0 + (lane & 31)]; }
    LDS_WAIT(); asm volatile("" ::: "memory");
    const int c = lane & 7;
#pragma unroll
    for (int j = 0; j < 4; ++j) { const int n = (lane >> 3) + 8 * j; const LAS float* s = scr + (8 * c) * 33 + n;
        v4u o; o.x = pk2(s[0 * 33], s[1 * 33]); o.y = pk2(s[2 * 33], s[3 * 33]); o.z = pk2(s[4 * 33], s[5 * 33]); o.w = pk2(s[6 * 33], s[7 * 33]);
        *(GAS v4u*)(WT + (size_t)(row_off + n0 + n) * K + k0 + 8 * c) = o; }
    LDS_WAIT(); asm volatile("" ::: "memory");
}
__device__ __forceinline__ void rms_row_to_bf16(const float* xrow, const float* g, bf16* orow, int lane) {
    const GAS f32x4* xr = (const GAS f32x4*)xrow + lane; const GAS f32x4* gr = (const GAS f32x4*)g + lane;
    f32x4 v[4]; float s = 0.f;
#pragma unroll
    for (int j = 0; j < 4; ++j) { v[j] = xr[64 * j]; s += (v[j].x * v[j].x + v[j].y * v[j].y) + (v[j].z * v[j].z + v[j].w * v[j].w); }
    const float rs = 1.f / sqrtf(wave_sum(s) * (1.f / D) + NORM_EPS);
    GAS unsigned long long* o8 = (GAS unsigned long long*)orow + lane;
#pragma unroll
    for (int j = 0; j < 4; ++j) { const f32x4 gg = gr[64 * j];
        o8[64 * j] = (unsigned long long)pk2(v[j].x * rs * gg.x, v[j].y * rs * gg.y) | ((unsigned long long)pk2(v[j].z * rs * gg.z, v[j].w * rs * gg.w) << 32); }
}

struct Args { const float* in[26]; float* out; unsigned char* ws; int ph_lo, ph_hi, li, pad; };

__global__ void __launch_bounds__(NWAVES * 64, 2) skel_fwd(Args args) {
    extern __shared__ __attribute__((aligned(16))) unsigned char lds_raw[];
    LAS unsigned char* const lds = (LAS unsigned char*)lds_raw;
    volatile LAS unsigned* const MISC = (volatile LAS unsigned*)(lds + MISC_OFF);
    const int tid0 = threadIdx.x;
    const int G = gridDim.x; int vcu; { const int bx = blockIdx.x; vcu = (G % 8 == 0) ? (bx % 8) * (G / 8) + bx / 8 : bx; }
    for (int u = tid0; u < (LDS_BYTES - LDSCTL_OFF) / 4; u += NWAVES * 64) ((LAS unsigned*)(lds + LDSCTL_OFF))[u] = 0u;
    __syncthreads();
    XcdBarrier bar = xcd_barrier_post((unsigned*)((gu32*)(args.ws + WS_CTL) + CW_BAR), MISC + 8);
#define GRID_BAR() xcd_barrier(bar)
    const int lo = args.ph_lo, hi = args.ph_hi;
#ifndef PH_MASK
#define PH_MASK 0xFFFFFFFFu
#endif
#define IN(k) (((PH_MASK >> (k)) & 1u) && lo <= (k) && (k) < hi)
#define BOTH(k) (IN(k) && IN((k) + 1))
#define PH_BEGIN \
    int tid_l = tid0; asm volatile("" : "+v"(tid_l)); const int tid = tid_l, lane = tid & 63, wave = __builtin_amdgcn_readfirstlane(tid >> 6); \
    unsigned char* ws_l = args.ws; asm volatile("" : "+s"(ws_l)); unsigned char* const ws = ws_l; \
    float* out_l = args.out; asm volatile("" : "+s"(out_l)); float* const out = out_l; \
    const int gw = vcu * NWAVES + wave, NGW = G * NWAVES, gt = vcu * (NWAVES * 64) + tid, NGT = G * NWAVES * 64; \
    const float* const x = args.in[0]; const float* const pin = args.in[1]; \
    bf16* const WinT = (bf16*)(ws + WS_WIN); bf16* const WfiT = (bf16*)(ws + WS_WFI); bf16* const WfoT = (bf16*)(ws + WS_WFO); \
    bf16* const WoT = (bf16*)(ws + WS_WO); bf16* const WpgT = (bf16*)(ws + WS_WPG); bf16* const WpleT = (bf16*)(ws + WS_WPLE); \
    bf16* const WauT = (bf16*)(ws + WS_WAU); bf16* const WruT = (bf16*)(ws + WS_WRU); \
    bf16* const XN = (bf16*)(ws + WS_XN); bf16* const PB = (bf16*)(ws + WS_PB); \
    bf16* const ZA = (bf16*)(ws + WS_ZA); bf16* const ZR = (bf16*)(ws + WS_ZR); bf16* const ZG = (bf16*)(ws + WS_ZG); \
    float2* const CS = (float2*)(ws + WS_CS); \
    (void)lane; (void)wave; (void)gw; (void)NGW; (void)gt; (void)NGT; (void)x; (void)pin; (void)out; (void)WinT; (void)WfiT; (void)WfoT; (void)WoT; (void)WpgT; (void)WpleT; (void)WauT; (void)WruT; (void)XN; (void)PB; (void)ZA; (void)ZR; (void)ZG; (void)CS;

    if (IN(PH_PRO)) { PH_BEGIN
        LAS float* scr = (LAS float*)(lds + RING_OFF + wave * 16384);
        constexpr int I_IN = (D / 64) * (6048 / 32), I_FI = (D / 64) * (FF / 32), I_FO = (FF / 64) * (D / 32), I_O = (D / 64) * (D / 32), I_PG = I_O;
        constexpr int I_PLE = (PLE / 64) * (D / 32), I_AU = (256 / 64) * (D / 32), I_RU = (512 / 64) * (D / 32);
        constexpr int NITEMS = I_IN + I_FI + I_FO + I_O + I_PG + I_PLE + I_AU + I_RU;
        for (int it = gw; it < NITEMS; it += NGW) {
            int r = it;
            if (r < I_IN) { const int nb = r % (6048 / 32); p0_transpose_item(args.in[3], D, 6048, WinT, (nb * 32 >= 4000) ? 96 : 0, scr, r, lane); continue; } r -= I_IN;
            if (r < I_FI) { p0_transpose_item(args.in[20], D, FF, WfiT, 0, scr, r, lane); continue; } r -= I_FI;
            if (r < I_FO) { p0_transpose_item(args.in[21], FF, D, WfoT, 0, scr, r, lane); continue; } r -= I_FO;
            if (r < I_O) { p0_transpose_item(args.in[17], D, D, WoT, 0, scr, r, lane); continue; } r -= I_O;
            if (r < I_PG) { p0_transpose_item(args.in[24], D, D, WpgT, 0, scr, r, lane); continue; } r -= I_PG;
            if (r < I_PLE) { p0_transpose_item(args.in[23], PLE, D, WpleT, 0, scr, r, lane); continue; } r -= I_PLE;
            if (r < I_AU) { p0_transpose_item(args.in[15], 256, D, WauT, 0, scr, r, lane); continue; } r -= I_AU;
            p0_transpose_item(args.in[16], 512, D, WruT, 0, scr, r, lane);
        }
        for (int i = gt; i < 96 * 1024 / 8; i += NGT) ((GAS v4u*)(WinT + (size_t)4000 * 1024))[i] = (v4u){0u, 0u, 0u, 0u};
        for (int m = gw; m < T; m += NGW) rms_row_to_bf16(x + (size_t)m * D, args.in[2], XN + (size_t)m * D, lane);
        for (int m = gw; m < T; m += NGW) { const f32x4 v = ((const GAS f32x4*)(pin + (size_t)m * PLE))[lane];
            ((GAS unsigned long long*)(PB + (size_t)m * PLE))[lane] = (unsigned long long)pk2(v.x, v.y) | ((unsigned long long)pk2(v.z, v.w) << 32); }
        for (int i = gt; i < SEQ * 32; i += NGT) { const int pos = i >> 5, fi = i & 31;
            const float inv = (float)exp(-(double)fi * (1.0 / 32.0) * 9.210340371976184);
            const float ang = (float)pos * inv;
            const double a = (double)ang; const double kq = rint(a * 0.15915494309189535); const double rr = a - kq * 6.283185307179586;
            const float rf = (float)rr; CS[i] = make_float2(cosf(rf), sinf(rf)); }
        if (BOTH(PH_PRO)) GRID_BAR();
    }

    if (IN(PH_INPROJ)) { PH_BEGIN
        pg8::Gemm g{XN, WinT, T, NIN, D}; pg8::StaticOrder S; S.init(T, NIN, G, (int)blockIdx.x);
        pg8::EpiInProj E{ZA, ZR, ZG};
        pg8::gemm_phase<pg8::EpiInProj, pg8::StaticOrder, PG8_ALIGN, PG8_SP2>(lds + RING_OFF, g, S, E);
        if (BOTH(PH_INPROJ)) GRID_BAR();
    }

    if (IN(PH_ATT)) { PH_BEGIN
        constexpr int KS = 72, VS = 264;
        bf16* const OG = (bf16*)(ws + WS_OG); float* const LSE = (float*)(ws + WS_LSE);
        LAS bf16* const Kl = (LAS bf16*)(lds + RING_OFF); LAS bf16* const VT = (LAS bf16*)(lds + RING_OFF + 36864);
        const int lr = lane & 15, lq = lane >> 4;
        for (int unit = vcu; unit < BATCH * 3 * 4 * 64; unit += G) {
            const int tau = unit & 63, h = (unit >> 6) & 3, g = (unit >> 8) % 3, b = unit / (64 * 4 * 3);
            const int dl = (g == 0) ? 1 : (g == 1) ? 4 : 16;
            const int rho = tau % dl, it = tau / dl, i0 = it * 128;
            const int colq = g * 256 + h * 64, colk = 768 + colq, colv = 1536 + colq;
#pragma unroll
            for (int r2 = 0; r2 < 2; ++r2) { const int idx = tid + 512 * r2, key = idx >> 2, p = idx & 3, ik = i0 - 128 + key;
                v4u lo = {0u, 0u, 0u, 0u}, hi = {0u, 0u, 0u, 0u};
                if (ik >= 0) { const int t = ik * dl + rho; const bf16* rowp = ZA + (size_t)(b * SEQ + t) * ZA_LD + colk + 8 * p;
                    const v4u x1 = *(const GAS v4u*)rowp, x2 = *(const GAS v4u*)(rowp + 32);
                    const GAS f32x4* cs = (const GAS f32x4*)(CS + t * 32 + 8 * p); const f32x4 c0 = cs[0], c1 = cs[1], c2 = cs[2], c3 = cs[3];
                    float a1[8] = {bflo(x1.x), bfhi(x1.x), bflo(x1.y), bfhi(x1.y), bflo(x1.z), bfhi(x1.z), bflo(x1.w), bfhi(x1.w)};
                    float a2[8] = {bflo(x2.x), bfhi(x2.x), bflo(x2.y), bfhi(x2.y), bflo(x2.z), bfhi(x2.z), bflo(x2.w), bfhi(x2.w)};
                    float cc[8] = {c0.x, c0.z, c1.x, c1.z, c2.x, c2.z, c3.x, c3.z}, ss[8] = {c0.y, c0.w, c1.y, c1.w, c2.y, c2.w, c3.y, c3.w};
                    float o1[8], o2[8];
#pragma unroll
                    for (int e = 0; e < 8; ++e) { o1[e] = a1[e] * cc[e] - a2[e] * ss[e]; o2[e] = a2[e] * cc[e] + a1[e] * ss[e]; }
                    lo = (v4u){pk2(o1[0], o1[1]), pk2(o1[2], o1[3]), pk2(o1[4], o1[5]), pk2(o1[6], o1[7])}; hi = (v4u){pk2(o2[0], o2[1]), pk2(o2[2], o2[3]), pk2(o2[4], o2[5]), pk2(o2[6], o2[7])}; }
                *(LAS v4u*)(Kl + key * KS + 8 * p) = lo; *(LAS v4u*)(Kl + key * KS + 32 + 8 * p) = hi; }
#pragma unroll
            for (int r4 = 0; r4 < 4; ++r4) { const int idx = tid + 512 * r4, key = idx >> 3, pc = idx & 7, ik = i0 - 128 + key;
                v4u x = {0u, 0u, 0u, 0u};
                if (ik >= 0) { const int t = ik * dl + rho; x = *(const GAS v4u*)(ZA + (size_t)(b * SEQ + t) * ZA_LD + colv + 8 * pc); }
                LAS bf16* vp = VT + (8 * pc) * VS + key;
                vp[0] = (bf16)(x.x & 0xffffu); vp[VS] = (bf16)(x.x >> 16); vp[2 * VS] = (bf16)(x.y & 0xffffu); vp[3 * VS] = (bf16)(x.y >> 16);
                vp[4 * VS] = (bf16)(x.z & 0xffffu); vp[5 * VS] = (bf16)(x.z >> 16); vp[6 * VS] = (bf16)(x.w & 0xffffu); vp[7 * VS] = (bf16)(x.w >> 16); }
            const int tq = (i0 + 16 * wave + lr) * dl + rho; const size_t trow = (size_t)(b * SEQ + tq);
            bf16x8 qf0, qf1;
            { const bf16* rowp = ZA + trow * ZA_LD + colq + 8 * lq; const v4u x1 = *(const GAS v4u*)rowp, x2 = *(const GAS v4u*)(rowp + 32);
              const GAS f32x4* cs = (const GAS f32x4*)(CS + tq * 32 + 8 * lq); const f32x4 c0 = cs[0], c1 = cs[1], c2 = cs[2], c3 = cs[3];
              float a1[8] = {bflo(x1.x), bfhi(x1.x), bflo(x1.y), bfhi(x1.y), bflo(x1.z), bfhi(x1.z), bflo(x1.w), bfhi(x1.w)};
              float a2[8] = {bflo(x2.x), bfhi(x2.x), bflo(x2.y), bfhi(x2.y), bflo(x2.z), bfhi(x2.z), bflo(x2.w), bfhi(x2.w)};
              float cc[8] = {c0.x, c0.z, c1.x, c1.z, c2.x, c2.z, c3.x, c3.z}, ss[8] = {c0.y, c0.w, c1.y, c1.w, c2.y, c2.w, c3.y, c3.w};
              const float qs = 0.125f * 1.4426950408889634f; float o1[8], o2[8];
#pragma unroll
              for (int e = 0; e < 8; ++e) { o1[e] = (a1[e] * cc[e] - a2[e] * ss[e]) * qs; o2[e] = (a2[e] * cc[e] + a1[e] * ss[e]) * qs; }
              const v4u lo = {pk2(o1[0], o1[1]), pk2(o1[2], o1[3]), pk2(o1[4], o1[5]), pk2(o1[6], o1[7])}, hi = {pk2(o2[0], o2[1]), pk2(o2[2], o2[3]), pk2(o2[4], o2[5]), pk2(o2[6], o2[7])};
              qf0 = __builtin_bit_cast(bf16x8, lo); qf1 = __builtin_bit_cast(bf16x8, hi); }
            __syncthreads();
            f32x4 sc[9]; float m = -INFINITY;
#pragma unroll
            for (int kt = 0; kt < 9; ++kt) { const LAS bf16* kp = Kl + (16 * wave + 16 * kt + lr) * KS + 8 * lq;
                const bf16x8 a0 = *(const LAS bf16x8*)kp, a1 = *(const LAS bf16x8*)(kp + 32);
                f32x4 acc = {0.f, 0.f, 0.f, 0.f};
                acc = __builtin_amdgcn_mfma_f32_16x16x32_bf16(a0, qf0, acc, 0, 0, 0); acc = __builtin_amdgcn_mfma_f32_16x16x32_bf16(a1, qf1, acc, 0, 0, 0);
#pragma unroll
                for (int i = 0; i < 4; ++i) { const int ko = 4 * lq + i; const int ik = i0 - 128 + 16 * wave + 16 * kt + ko;
                    const bool valid = (ik >= 0) && (kt > 0 || ko >= lr) && (kt < 8 || ko <= lr);
                    acc[i] = valid ? acc[i] : -INFINITY; m = fmaxf(m, acc[i]); }
                sc[kt] = acc; }
            m = fmaxf(m, __shfl_xor(m, 16)); m = fmaxf(m, __shfl_xor(m, 32));
            float l = 0.f;
#pragma unroll
            for (int kt = 0; kt < 9; ++kt)
#pragma unroll
                for (int i = 0; i < 4; ++i) { const float pj = __builtin_amdgcn_exp2f(sc[kt][i] - m); sc[kt][i] = pj; l += pj; }
            l += __shfl_xor(l, 16); l += __shfl_xor(l, 32);
            bf16x8 pb[5];
#pragma unroll
            for (int st = 0; st < 5; ++st) { const f32x4 t0v = sc[2 * st]; const f32x4 t1v = (st < 4) ? sc[2 * st + 1] : (f32x4){0.f, 0.f, 0.f, 0.f};
                const v4u pk = {pk2(t0v[0], t0v[1]), pk2(t0v[2], t0v[3]), pk2(t1v[0], t1v[1]), pk2(t1v[2], t1v[3])}; pb[st] = __builtin_bit_cast(bf16x8, pk); }
            const float il = 1.0f / l;
#pragma unroll
            for (int dt = 0; dt < 4; ++dt) { f32x4 acc = {0.f, 0.f, 0.f, 0.f};
#pragma unroll
                for (int st = 0; st < 5; ++st) { const LAS bf16* vp = VT + (16 * dt + lr) * VS + 16 * wave + 32 * st + 4 * lq;
                    const v2u v0 = *(const LAS v2u*)vp; const v2u v1 = (st < 4) ? *(const LAS v2u*)(vp + 16) : (v2u){0u, 0u};
                    const v4u av = {v0.x, v0.y, v1.x, v1.y};
                    acc = __builtin_amdgcn_mfma_f32_16x16x32_bf16(__builtin_bit_cast(bf16x8, av), pb[st], acc, 0, 0, 0); }
                *(GAS unsigned long long*)(OG + ((size_t)g * T + trow) * 256 + h * 64 + 16 * dt + 4 * lq) = (unsigned long long)pk2(acc[0] * il, acc[1] * il) | ((unsigned long long)pk2(acc[2] * il, acc[3] * il) << 32); }
            if (lq == 0) LSE[((size_t)g * T + trow) * 4 + h] = (m + __builtin_amdgcn_logf(l)) * 0.6931471805599453f;
            __syncthreads();
        }
        if (BOTH(PH_ATT)) GRID_BAR();
    }

    if (IN(PH_PREP)) { PH_BEGIN
        {
            const bf16* const OG = (const bf16*)(ws + WS_OG); const float* const LSE = (const float*)(ws + WS_LSE); bf16* const OA = (bf16*)(ws + WS_OA);
            for (int i = gt; i < T * 32; i += NGT) { const int t = i >> 5, h = (i >> 3) & 3, c8 = i & 7;
                const float l0 = LSE[((size_t)0 * T + t) * 4 + h], l1 = LSE[((size_t)1 * T + t) * 4 + h], l2 = LSE[((size_t)2 * T + t) * 4 + h];
                const float mx = fmaxf(l0, fmaxf(l1, l2)); const float e0 = __expf(l0 - mx), e1 = __expf(l1 - mx), e2 = __expf(l2 - mx); const float inv = 1.0f / (e0 + e1 + e2);
                const float a0 = e0 * inv, a1 = e1 * inv, a2 = e2 * inv;
                const v4u x0 = *(const GAS v4u*)(OG + ((size_t)0 * T + t) * 256 + h * 64 + 8 * c8), x1 = *(const GAS v4u*)(OG + ((size_t)1 * T + t) * 256 + h * 64 + 8 * c8), x2 = *(const GAS v4u*)(OG + ((size_t)2 * T + t) * 256 + h * 64 + 8 * c8);
                v4u w;
                w.x = pk2(a0 * bflo(x0.x) + a1 * bflo(x1.x) + a2 * bflo(x2.x), a0 * bfhi(x0.x) + a1 * bfhi(x1.x) + a2 * bfhi(x2.x));
                w.y = pk2(a0 * bflo(x0.y) + a1 * bflo(x1.y) + a2 * bflo(x2.y), a0 * bfhi(x0.y) + a1 * bfhi(x1.y) + a2 * bfhi(x2.y));
                w.z = pk2(a0 * bflo(x0.z) + a1 * bflo(x1.z) + a2 * bflo(x2.z), a0 * bfhi(x0.z) + a1 * bfhi(x1.z) + a2 * bfhi(x2.z));
                w.w = pk2(a0 * bflo(x0.w) + a1 * bflo(x1.w) + a2 * bflo(x2.w), a0 * bfhi(x0.w) + a1 * bfhi(x1.w) + a2 * bfhi(x2.w));
                *(GAS v4u*)(OA + (size_t)t * 256 + h * 64 + 8 * c8) = w; }
        }
        {
            const float* const mu = args.in[4]; const float* const w0 = args.in[5]; const float* const w2 = args.in[6]; const float* const a0 = args.in[7];
            const float* const a2 = args.in[8]; const float* const g2 = args.in[9]; const float* const k_k = args.in[10]; const float* const k_a = args.in[11]; const float* const r_k = args.in[12];
            bf16* const Rb = (bf16*)(ws + WS_R); bf16* const Kb = (bf16*)(ws + WS_KP); bf16* const Vb = (bf16*)(ws + WS_V); bf16* const AVb = (bf16*)(ws + WS_AV);
            float* const DEC = (float*)((unsigned char*)out + DO_DEC);   bf16* const BVb = (bf16*)((unsigned char*)out + DO_BV); bf16* const GTb = (bf16*)((unsigned char*)out + DO_GT);
            float* const BONUS = (float*)(ws + WS_BONUS);
            const int c = tid;
            float w2c[32], a2c[32]; unsigned g2c[48];
#pragma unroll
            for (int j = 0; j < 32; ++j) { w2c[j] = w2[j * RW + c]; a2c[j] = a2[j * RW + c]; }
#pragma unroll
            for (int j = 0; j < 48; ++j) g2c[j] = pk2(g2[(2 * j) * RW + c], g2[(2 * j + 1) * RW + c]);
            const float mu_r = mu[c], mu_k = mu[512 + c], mu_v = mu[1024 + c], w0c = w0[c], a0c = a0[c], kkc = k_k[c], kac = k_a[c], rkc = r_k[c];
            LAS float* L = (LAS float*)(lds + RING_OFF);
            LAS bf16* Zs = (LAS bf16*)(lds + RING_OFF + 16384);
            for (int tile = vcu; tile < T / 16; tile += G) {
                const int t0 = tile * 16; const bool first = (t0 & (SEQ - 1)) == 0;
                for (int p = tid; p < 17 * 224; p += 512) { const int r = p / 224, cp = p - r * 224; v4u xz = {0u, 0u, 0u, 0u};
                    if (!(r == 0 && first)) xz = *(const GAS v4u*)(ZR + (size_t)(t0 - 1 + r) * ZR_LD + cp * 8);
                    *(LAS v4u*)(Zs + r * 1792 + cp * 8) = xz; }
                __syncthreads();
                for (int idx = tid; idx < 16 * 160; idx += 512) { const int tok = idx / 160, j = idx - tok * 160;
                    const float z = bf2f(Zs[(tok + 1) * 1792 + 1536 + j]), zp = bf2f(Zs[tok * 1792 + 1536 + j]);
                    const float xx = z + (zp - z) * mu[1536 + j];
                    L[idx] = (j < 32) ? tanhf(xx) : (j < 64) ? xx : sigmoidf_(xx); }
                __syncthreads();
                for (int tok = 0; tok < 16; ++tok) { const int t = t0 + tok; const LAS bf16* zc = Zs + (tok + 1) * 1792; const LAS bf16* zq = Zs + tok * 1792;
                    const float zr = bf2f(zc[c]), zk = bf2f(zc[512 + c]), zv = bf2f(zc[1024 + c]);
                    const float r = zr + (bf2f(zq[c]) - zr) * mu_r; float k = zk + (bf2f(zq[512 + c]) - zk) * mu_k; const float v = zv + (bf2f(zq[1024 + c]) - zv) * mu_v;
                    const LAS f32x4* Lt = (const LAS f32x4*)(L + tok * 160);
                    float wl = 0.f, al = 0.f, gl = 0.f;
#pragma unroll
                    for (int j = 0; j < 8; ++j) { const f32x4 a = Lt[j]; wl += a.x * w2c[4 * j] + a.y * w2c[4 * j + 1] + a.z * w2c[4 * j + 2] + a.w * w2c[4 * j + 3]; }
#pragma unroll
                    for (int j = 0; j < 8; ++j) { const f32x4 a = Lt[8 + j]; al += a.x * a2c[4 * j] + a.y * a2c[4 * j + 1] + a.z * a2c[4 * j + 2] + a.w * a2c[4 * j + 3]; }
#pragma unroll
                    for (int j = 0; j < 24; ++j) { const f32x4 a = Lt[16 + j]; gl += a.x * bflo(g2c[2 * j]) + a.y * bfhi(g2c[2 * j]) + a.z * bflo(g2c[2 * j + 1]) + a.w * bfhi(g2c[2 * j + 1]); }
                    const float wv = w0c + wl; const float nx = -wv;
                    const float sp = fmaxf(nx, 0.f) + log1pf(__expf(-fabsf(nx)));
                    const float dec = -__expf(-sp - 0.5f);
                    const float a = sigmoidf_(a0c + al);
                    float kk = k * kkc; const float ss = wave_sum(kk * kk); kk = kk / fmaxf(sqrtf(ss), 1e-12f);
                    k = k * (1.0f + (a - 1.0f) * kac);
                    const float bon = wave_sum(r * k * rkc);
                    const size_t o = (size_t)t * RW + c;
                    Rb[o] = (bf16)f2bf(r); Kb[o] = (bf16)f2bf(k); Vb[o] = (bf16)f2bf(v); AVb[o] = (bf16)f2bf(-kk); BVb[o] = (bf16)f2bf(kk * a); GTb[o] = (bf16)f2bf(gl); DEC[o] = dec;
                    if (lane == 0) BONUS[(size_t)t * 8 + wave] = bon;
                }
                __syncthreads();
            }
        }
        if (BOTH(PH_PREP)) GRID_BAR();
    }

    if (IN(PH_CHUNK)) { PH_BEGIN
        constexpr int LS = 72, FS = 68;
        bf16* const Rb = (bf16*)(ws + WS_R); bf16* const Kb = (bf16*)(ws + WS_KP); const bf16* const Vb = (const bf16*)(ws + WS_V); bf16* const AVb = (bf16*)(ws + WS_AV);
        float* const LW = (float*)((unsigned char*)out + DO_DEC); bf16* const BVb = (bf16*)((unsigned char*)out + DO_BV);
        bf16* const YLT = (bf16*)(ws + WS_YLT); float* const GC = (float*)(ws + WS_GC);
        LAS bf16* const At = (LAS bf16*)(lds + 0); LAS bf16* const Rt = (LAS bf16*)(lds + 9216); LAS bf16* const Bt = (LAS bf16*)(lds + 18432); LAS bf16* const Kt = (LAS bf16*)(lds + 27648);
        LAS bf16* const VmT = (LAS bf16*)(lds + 36864); LAS bf16* const KhT = (LAS bf16*)(lds + 46080); LAS bf16* const Lak = (LAS bf16*)(lds + 55296); LAS bf16* const Mrb = (LAS bf16*)(lds + 64512);
        LAS bf16* const Mrk = (LAS bf16*)(lds + 73728); LAS bf16* const BhT = (LAS bf16*)(lds + 82944); LAS float* const LabF = (LAS float*)(lds + 92160); LAS float* const X1F = (LAS float*)(lds + 109568);
        LAS bf16* const ApT = Bt; LAS bf16* const WT2 = Kt; LAS float* const cum = X1F;
        const int lr = lane & 15, lq = lane >> 4;
        for (int unit = vcu; unit < BATCH * 8 * (SEQ / 64); unit += G) {
            const int ch = unit & 127, h = (unit >> 7) & 7, b = unit >> 10;
            const size_t t0 = (size_t)b * SEQ + (size_t)ch * 64;
            const int c = tid >> 3, kq = tid & 7;
            const size_t goff = (t0 + c) * RW + h * 64 + kq * 8;
            const v4u r8 = *(const GAS v4u*)(Rb + goff), k8 = *(const GAS v4u*)(Kb + goff), v8 = *(const GAS v4u*)(Vb + goff), a8 = *(const GAS v4u*)(AVb + goff), b8 = *(const GAS v4u*)(BVb + goff);
            const f32x4 lw0 = *(const GAS f32x4*)(LW + goff), lw1 = *(const GAS f32x4*)(LW + goff + 4);
            float lwv[8] = {lw0.x, lw0.y, lw0.z, lw0.w, lw1.x, lw1.y, lw1.z, lw1.w};
#pragma unroll
            for (int i = 0; i < 8; ++i) cum[c * 65 + kq * 8 + i] = lwv[i];
            __syncthreads();
#pragma unroll
            for (int i = 0; i < 8; ++i) { const int chn = 8 * wave + i; float xx = cum[lane * 65 + chn];
#pragma unroll
                for (int o = 1; o < 64; o <<= 1) { const float yy = __shfl_up(xx, o); if (lane >= o) xx += yy; }
                cum[lane * 65 + chn] = xx; }
            __syncthreads();
            {
                float rr[8], kk8[8], vv[8], aa[8], bb[8];
                rr[0] = bflo(r8.x); rr[1] = bfhi(r8.x); rr[2] = bflo(r8.y); rr[3] = bfhi(r8.y); rr[4] = bflo(r8.z); rr[5] = bfhi(r8.z); rr[6] = bflo(r8.w); rr[7] = bfhi(r8.w);
                kk8[0] = bflo(k8.x); kk8[1] = bfhi(k8.x); kk8[2] = bflo(k8.y); kk8[3] = bfhi(k8.y); kk8[4] = bflo(k8.z); kk8[5] = bfhi(k8.z); kk8[6] = bflo(k8.w); kk8[7] = bfhi(k8.w);
                vv[0] = bflo(v8.x); vv[1] = bfhi(v8.x); vv[2] = bflo(v8.y); vv[3] = bfhi(v8.y); vv[4] = bflo(v8.z); vv[5] = bfhi(v8.z); vv[6] = bflo(v8.w); vv[7] = bfhi(v8.w);
                aa[0] = bflo(a8.x); aa[1] = bfhi(a8.x); aa[2] = bflo(a8.y); aa[3] = bfhi(a8.y); aa[4] = bflo(a8.z); aa[5] = bfhi(a8.z); aa[6] = bflo(a8.w); aa[7] = bfhi(a8.w);
                bb[0] = bflo(b8.x); bb[1] = bfhi(b8.x); bb[2] = bflo(b8.y); bb[3] = bfhi(b8.y); bb[4] = bflo(b8.z); bb[5] = bfhi(b8.z); bb[6] = bflo(b8.w); bb[7] = bfhi(b8.w);
                float at[8], rt[8], bt[8], kt[8];
#pragma unroll
                for (int i = 0; i < 8; ++i) { const float cu = cum[c * 65 + kq * 8 + i], cC = cum[63 * 65 + kq * 8 + i];
                    const float ep = __expf(cu), em = __expf(-cu), epv = __expf(cu - lwv[i]), eh = __expf(cC - cu);
                    at[i] = aa[i] * epv; rt[i] = rr[i] * ep; bt[i] = bb[i] * em; kt[i] = kk8[i] * em;
                    const int kk_ = kq * 8 + i;
                    VmT[kk_ * LS + c] = (bf16)f2bf(vv[i]); KhT[kk_ * LS + c] = (bf16)f2bf(kk8[i] * eh); BhT[kk_ * LS + c] = (bf16)f2bf(bb[i] * eh);
                    if (c == 63) GC[(size_t)unit * 64 + kk_] = __expf(cC); }
                *(LAS v4u*)(At + c * LS + kq * 8) = (v4u){pk2(at[0], at[1]), pk2(at[2], at[3]), pk2(at[4], at[5]), pk2(at[6], at[7])};
                *(LAS v4u*)(Rt + c * LS + kq * 8) = (v4u){pk2(rt[0], rt[1]), pk2(rt[2], rt[3]), pk2(rt[4], rt[5]), pk2(rt[6], rt[7])};
                *(LAS v4u*)(Bt + c * LS + kq * 8) = (v4u){pk2(bt[0], bt[1]), pk2(bt[2], bt[3]), pk2(bt[4], bt[5]), pk2(bt[6], bt[7])};
                *(LAS v4u*)(Kt + c * LS + kq * 8) = (v4u){pk2(kt[0], kt[1]), pk2(kt[2], kt[3]), pk2(kt[4], kt[5]), pk2(kt[6], kt[7])};
            }
            __syncthreads();
            {
                const int p = wave >> 1; const LAS bf16* Ab = (p < 2) ? At : Rt; const LAS bf16* Bb = (p & 1) ? Kt : Bt;
                LAS bf16* dstb = (p == 1) ? Lak : (p == 2) ? Mrb : Mrk;
#pragma unroll 1
                for (int tl = (wave & 1) * 8; tl < (wave & 1) * 8 + 8; ++tl) { const int mt = tl >> 2, nt = tl & 3;
                    f32x4 acc = {0.f, 0.f, 0.f, 0.f};
                    if (nt <= mt) {
#pragma unroll
                        for (int ks = 0; ks < 2; ++ks) { const bf16x8 a = *(const LAS bf16x8*)(Ab + (16 * mt + lr) * LS + 32 * ks + 8 * lq), bq = *(const LAS bf16x8*)(Bb + (16 * nt + lr) * LS + 32 * ks + 8 * lq);
                            acc = __builtin_amdgcn_mfma_f32_16x16x32_bf16(a, bq, acc, 0, 0, 0); } }
                    const int col = 16 * nt + lr;
#pragma unroll
                    for (int i = 0; i < 4; ++i) { const int row = 16 * mt + 4 * lq + i; const bool keep = (p < 2) ? (col < row) : (col <= row); const float val = keep ? acc[i] : 0.f;
                        if (p == 0) LabF[row * FS + (col & 3) * 16 + (col >> 2)] = val; else dstb[row * LS + col] = (bf16)f2bf(val); } }
            }
            __syncthreads();
#pragma unroll 1
            for (int tl = wave * 2; tl < wave * 2 + 2; ++tl) { const int mt = tl >> 2, nt = tl & 3; f32x4 acc = {0.f, 0.f, 0.f, 0.f};
#pragma unroll
                for (int ks = 0; ks < 2; ++ks) { const bf16x8 a = *(const LAS bf16x8*)(Lak + (16 * mt + lr) * LS + 32 * ks + 8 * lq), bq = *(const LAS bf16x8*)(VmT + (16 * nt + lr) * LS + 32 * ks + 8 * lq);
                    acc = __builtin_amdgcn_mfma_f32_16x16x32_bf16(a, bq, acc, 0, 0, 0); }
#pragma unroll
                for (int i = 0; i < 4; ++i) X1F[(16 * mt + 4 * lq + i) * FS + 16 * nt + lr] = acc[i]; }
            __syncthreads();
            {
                const int jl = lane >> 2, part = lane & 3, j = 16 * (wave & 3) + jl;
                float xp[16];
                if (wave < 4) {
#pragma unroll
                    for (int m = 0; m < 16; ++m) xp[m] = bf2f(At[(4 * m + part) * LS + j]);
                } else {
#pragma unroll
                    for (int m = 0; m < 16; ++m) xp[m] = X1F[(4 * m + part) * FS + j];
                }
                int lpo = part * 16;
#pragma unroll
                for (int t = 1; t < 64; ++t) { const int tm = t >> 2, tp = t & 3; float s0 = 0.f, s1 = 0.f;
#pragma unroll
                    for (int m4 = 0; m4 <= tm / 4; ++m4) { const f32x4 L4 = *(const LAS f32x4*)(LabF + lpo + t * FS + 4 * m4);
                        s0 += L4.x * xp[4 * m4]; if (4 * m4 + 1 <= tm) s1 += L4.y * xp[4 * m4 + 1]; if (4 * m4 + 2 <= tm) s0 += L4.z * xp[4 * m4 + 2]; if (4 * m4 + 3 <= tm) s1 += L4.w * xp[4 * m4 + 3]; }
                    const float sum = quad_sum(s0 + s1);
                    xp[tm] = (part == tp) ? xp[tm] + sum : xp[tm];
                    if (tp == 3) asm volatile("" : "+v"(lpo) : "v"(xp[tm])); }
                LAS bf16* dl = (wave < 4) ? ApT : WT2;
#pragma unroll
                for (int m = 0; m < 16; ++m) dl[j * LS + 4 * m + part] = (bf16)f2bf(xp[m]);
            }
            __syncthreads();
            {
                const int kind = wave >> 1;
#pragma unroll 1
                for (int tl = (wave & 1) * 8; tl < (wave & 1) * 8 + 8; ++tl) { const int mt = tl >> 2, nt = tl & 3; f32x4 acc = {0.f, 0.f, 0.f, 0.f};
                    const LAS bf16* A1 = (kind == 0 || kind == 1) ? Mrb : (kind == 2) ? ApT : WT2;
                    const LAS bf16* B1 = (kind == 0) ? ApT : (kind == 1) ? WT2 : BhT;
#pragma unroll
                    for (int ks = 0; ks < 2; ++ks) { const bf16x8 a = *(const LAS bf16x8*)(A1 + (16 * mt + lr) * LS + 32 * ks + 8 * lq), bq = *(const LAS bf16x8*)(B1 + (16 * nt + lr) * LS + 32 * ks + 8 * lq);
                        acc = __builtin_amdgcn_mfma_f32_16x16x32_bf16(a, bq, acc, 0, 0, 0); }
                    if (kind == 1 || kind == 3) { const LAS bf16* A2 = (kind == 1) ? Mrk : VmT; const LAS bf16* B2 = (kind == 1) ? VmT : KhT;
#pragma unroll
                        for (int ks = 0; ks < 2; ++ks) { const bf16x8 a = *(const LAS bf16x8*)(A2 + (16 * mt + lr) * LS + 32 * ks + 8 * lq), bq = *(const LAS bf16x8*)(B2 + (16 * nt + lr) * LS + 32 * ks + 8 * lq);
                            acc = __builtin_amdgcn_mfma_f32_16x16x32_bf16(a, bq, acc, 0, 0, 0); } }
                    if (kind == 0) {
#pragma unroll
                        for (int i = 0; i < 4; ++i) { const int row = 16 * mt + 4 * lq + i, col = 16 * nt + lr; Kb[(t0 + row) * RW + h * 64 + col] = (bf16)f2bf(acc[i] + bf2f(Rt[row * LS + col])); }
                    } else {
                        bf16* dst = (kind == 1) ? YLT : (kind == 2) ? Rb : AVb;
                        *(GAS unsigned long long*)(dst + (t0 + 16 * nt + lr) * RW + h * 64 + 16 * mt + 4 * lq) = (unsigned long long)pg8::cvt_pk_bf16(acc[0], acc[1]) | ((unsigned long long)pg8::cvt_pk_bf16(acc[2], acc[3]) << 32);
                    } }
            }
            __syncthreads();
        }
        if (BOTH(PH_CHUNK)) GRID_BAR();
    }

    if (IN(PH_SEQ)) { PH_BEGIN
        if (vcu < BATCH * 8 * 4 && wave == 0) {
            constexpr int LS = 72;
            const bf16* const PhiT = (const bf16*)(ws + WS_R); const bf16* const PsiT = (const bf16*)(ws + WS_AV); const float* const GC = (const float*)(ws + WS_GC);
            bf16* const SST = (bf16*)((unsigned char*)out + DO_BV);
            const int chain = vcu >> 2, q = vcu & 3, b = chain >> 3, h = chain & 7, lr = lane & 15, lq = lane >> 4;
            LAS bf16* const Sbf = (LAS bf16*)(lds + RING_OFF);
            for (int i = lane; i < 16 * LS / 2; i += 64) ((LAS unsigned*)Sbf)[i] = 0u;
            f32x4 st[4];
#pragma unroll
            for (int nt = 0; nt < 4; ++nt) st[nt] = (f32x4){0.f, 0.f, 0.f, 0.f};
            v4u phA[8], phB[8]; v2u psA[4], psB[4]; float gA[4], gB[4];
#define SQ_LOAD(ph, ps, gg, ck) do { const size_t tb = (size_t)b * SEQ + (size_t)(ck) * 64; \
        _Pragma("unroll") for (int nt = 0; nt < 4; ++nt) { const size_t ro = (tb + 16 * nt + lr) * RW + h * 64; \
            ph[2 * nt] = *(const GAS v4u*)(PhiT + ro + 8 * lq); ph[2 * nt + 1] = *(const GAS v4u*)(PhiT + ro + 32 + 8 * lq); \
            ps[nt] = *(const GAS v2u*)(PsiT + ro + 16 * q + 4 * lq); gg[nt] = GC[((size_t)(chain * 128 + (ck))) * 64 + 16 * nt + lr]; } } while (0)
#define SQ_STEP(ph, ps, gg, ck) do { \
        const bf16x8 a0 = *(const LAS bf16x8*)(Sbf + lr * LS + 8 * lq), a1 = *(const LAS bf16x8*)(Sbf + lr * LS + 32 + 8 * lq); \
        { const size_t so = ((size_t)b * SEQ + (size_t)(ck) * 64 + 16 * q + lr) * RW + h * 64; *(GAS bf16x8*)(SST + so + 8 * lq) = a0; *(GAS bf16x8*)(SST + so + 32 + 8 * lq) = a1; } \
        _Pragma("unroll") for (int nt = 0; nt < 4; ++nt) { \
            st[nt] = st[nt] * gg[nt] + (f32x4){bflo(ps[nt].x), bfhi(ps[nt].x), bflo(ps[nt].y), bfhi(ps[nt].y)}; \
            st[nt] = __builtin_amdgcn_mfma_f32_16x16x32_bf16(a0, __builtin_bit_cast(bf16x8, ph[2 * nt]), st[nt], 0, 0, 0); \
            st[nt] = __builtin_amdgcn_mfma_f32_16x16x32_bf16(a1, __builtin_bit_cast(bf16x8, ph[2 * nt + 1]), st[nt], 0, 0, 0); } \
        _Pragma("unroll") for (int nt = 0; nt < 4; ++nt) { const unsigned p01 = pg8::cvt_pk_bf16(st[nt][0], st[nt][1]), p23 = pg8::cvt_pk_bf16(st[nt][2], st[nt][3]); \
            Sbf[(4 * lq + 0) * LS + 16 * nt + lr] = (bf16)(p01 & 0xffffu); Sbf[(4 * lq + 1) * LS + 16 * nt + lr] = (bf16)(p01 >> 16); \
            Sbf[(4 * lq + 2) * LS + 16 * nt + lr] = (bf16)(p23 & 0xffffu); Sbf[(4 * lq + 3) * LS + 16 * nt + lr] = (bf16)(p23 >> 16); } } while (0)
            SQ_LOAD(phA, psA, gA, 0); SQ_LOAD(phB, psB, gB, 1);
            for (int ck = 0; ck < SEQ / 64; ck += 2) {
                SQ_STEP(phA, psA, gA, ck);
                if (ck + 2 < SEQ / 64) SQ_LOAD(phA, psA, gA, ck + 2);
                SQ_STEP(phB, psB, gB, ck + 1);
                if (ck + 3 < SEQ / 64) SQ_LOAD(phB, psB, gB, ck + 3);
            }
#undef SQ_LOAD
#undef SQ_STEP
        }
        if (BOTH(PH_SEQ)) GRID_BAR();
    }

    if (IN(PH_POST)) { PH_BEGIN
        const bf16* const RPg = (const bf16*)(ws + WS_KP); const bf16* const SST = (const bf16*)((unsigned char*)out + DO_BV); const bf16* const YLT = (const bf16*)(ws + WS_YLT);
        const bf16* const Vb = (const bf16*)(ws + WS_V); const bf16* const GTb = (const bf16*)((unsigned char*)out + DO_GT); const float* const BONUS = (const float*)(ws + WS_BONUS);
        bf16* const ORW = (bf16*)(ws + WS_ORW);
        const int lr = lane & 15, lq = lane >> 4;
        for (int unit = gw; unit < BATCH * 8 * (SEQ / 64); unit += NGW) {
            const int ch = unit & 127, h = (unit >> 7) & 7, b = unit >> 10;
            const size_t t0 = (size_t)b * SEQ + (size_t)ch * 64;
            bf16x8 sb[4][2];
#pragma unroll
            for (int nt = 0; nt < 4; ++nt)
#pragma unroll
                for (int ks = 0; ks < 2; ++ks) sb[nt][ks] = *(const GAS bf16x8*)(SST + (t0 + 16 * nt + lr) * RW + h * 64 + 32 * ks + 8 * lq);
            float lnw[4], lnb[4];
#pragma unroll
            for (int nt = 0; nt < 4; ++nt) { lnw[nt] = args.in[13][h * 64 + 16 * nt + lr]; lnb[nt] = args.in[14][h * 64 + 16 * nt + lr]; }
#pragma unroll 1
            for (int mt = 0; mt < 4; ++mt) {
                const bf16x8 ra0 = *(const GAS bf16x8*)(RPg + (t0 + 16 * mt + lr) * RW + h * 64 + 8 * lq), ra1 = *(const GAS bf16x8*)(RPg + (t0 + 16 * mt + lr) * RW + h * 64 + 32 + 8 * lq);
                f32x4 y[4];
#pragma unroll
                for (int nt = 0; nt < 4; ++nt) { const v2u y4 = *(const GAS v2u*)(YLT + (t0 + 16 * nt + lr) * RW + h * 64 + 16 * mt + 4 * lq);
                    y[nt] = (f32x4){bflo(y4.x), bfhi(y4.x), bflo(y4.y), bfhi(y4.y)};
                    y[nt] = __builtin_amdgcn_mfma_f32_16x16x32_bf16(ra0, sb[nt][0], y[nt], 0, 0, 0); y[nt] = __builtin_amdgcn_mfma_f32_16x16x32_bf16(ra1, sb[nt][1], y[nt], 0, 0, 0); }
#pragma unroll
                for (int i = 0; i < 4; ++i) { const size_t trow = t0 + 16 * mt + 4 * lq + i;
                    float sm = (y[0][i] + y[1][i]) + (y[2][i] + y[3][i]); sm = quad_sum(sm); sm += dpp_f<0x141>(sm); sm += dpp_f<0x140>(sm);
                    const float mean = sm * (1.f / 64.f);
                    const float d0 = y[0][i] - mean, d1 = y[1][i] - mean, d2 = y[2][i] - mean, d3 = y[3][i] - mean;
                    float sq = (d0 * d0 + d1 * d1) + (d2 * d2 + d3 * d3); sq = quad_sum(sq); sq += dpp_f<0x141>(sq); sq += dpp_f<0x140>(sq);
                    const float rstd = 1.f / sqrtf(sq * (1.f / 64.f) + GN_EPS); const float bon = BONUS[trow * 8 + h];
                    const float dd[4] = {d0, d1, d2, d3};
#pragma unroll
                    for (int nt = 0; nt < 4; ++nt) { const size_t o = trow * RW + h * 64 + 16 * nt + lr;
                        ORW[o] = (bf16)f2bf((dd[nt] * rstd * lnw[nt] + lnb[nt] + bon * bf2f(Vb[o])) * bf2f(GTb[o])); } }
            }
        }
        if (BOTH(PH_POST)) GRID_BAR();
    }

    if (IN(PH_UPA)) { PH_BEGIN
        pg8::Gemm g{(const bf16*)(ws + WS_OA), WauT, T, D, 256}; pg8::StaticOrder S; S.init(T, D, G, (int)blockIdx.x);
        pg8::EpiGateF32 E{out, ZG, ZG_LD, 0};
        pg8::gemm_phase<pg8::EpiGateF32, pg8::StaticOrder, PG8_ALIGN, PG8_SP2>(lds + RING_OFF, g, S, E);
        if (BOTH(PH_UPA)) GRID_BAR();
    }
    if (IN(PH_UPR)) { PH_BEGIN
        pg8::Gemm g{(const bf16*)(ws + WS_ORW), WruT, T, D, 512}; pg8::StaticOrder S; S.init(T, D, G, (int)blockIdx.x);
        pg8::EpiMerge E{out, ZG, ZG_LD, 1024, (bf16*)(ws + WS_M1)};
        pg8::gemm_phase<pg8::EpiMerge, pg8::StaticOrder, PG8_ALIGN, PG8_SP2>(lds + RING_OFF, g, S, E);
        if (BOTH(PH_UPR)) GRID_BAR();
    }
    if (IN(PH_WO)) { PH_BEGIN
        pg8::Gemm g{(const bf16*)(ws + WS_M1), WoT, T, D, D}; pg8::StaticOrder S; S.init(T, D, G, (int)blockIdx.x);
        pg8::EpiF32<0> E{(float*)(ws + WS_TMP2A)};
        pg8::gemm_phase<pg8::EpiF32<0>, pg8::StaticOrder, PG8_ALIGN, PG8_SP2>(lds + RING_OFF, g, S, E);
        if (BOTH(PH_WO)) GRID_BAR();
    }
    if (IN(PH_ROWA)) { PH_BEGIN
        const float* const tmp = (const float*)(ws + WS_TMP2A); const float* const g1 = args.in[18]; const float* const g2 = args.in[19];
        for (int m = gw; m < T; m += NGW) {
            const GAS f32x4* tr = (const GAS f32x4*)(tmp + (size_t)m * D) + lane; const GAS f32x4* xr = (const GAS f32x4*)(x + (size_t)m * D) + lane;
            f32x4 v[4]; float s = 0.f;
#pragma unroll
            for (int j = 0; j < 4; ++j) { v[j] = tr[64 * j]; s += (v[j].x * v[j].x + v[j].y * v[j].y) + (v[j].z * v[j].z + v[j].w * v[j].w); }
            const float rs = 1.f / sqrtf(wave_sum(s) * (1.f / D) + NORM_EPS); float s2 = 0.f;
#pragma unroll
            for (int j = 0; j < 4; ++j) { const f32x4 gg = ((const GAS f32x4*)g1)[lane + 64 * j]; const f32x4 xx = xr[64 * j];
                v[j].x = xx.x + v[j].x * rs * gg.x; v[j].y = xx.y + v[j].y * rs * gg.y; v[j].z = xx.z + v[j].z * rs * gg.z; v[j].w = xx.w + v[j].w * rs * gg.w;
                ((GAS f32x4*)(out + (size_t)m * D))[lane + 64 * j] = v[j];
                s2 += (v[j].x * v[j].x + v[j].y * v[j].y) + (v[j].z * v[j].z + v[j].w * v[j].w); }
            const float rs2 = 1.f / sqrtf(wave_sum(s2) * (1.f / D) + NORM_EPS);
            GAS unsigned long long* o8 = (GAS unsigned long long*)(XN + (size_t)m * D) + lane;
#pragma unroll
            for (int j = 0; j < 4; ++j) { const f32x4 gg = ((const GAS f32x4*)g2)[lane + 64 * j];
                o8[64 * j] = (unsigned long long)pk2(v[j].x * rs2 * gg.x, v[j].y * rs2 * gg.y) | ((unsigned long long)pk2(v[j].z * rs2 * gg.z, v[j].w * rs2 * gg.w) << 32); }
        }
        if (BOTH(PH_ROWA)) GRID_BAR();
    }
    if (IN(PH_FFI)) { PH_BEGIN
        pg8::Gemm g{XN, WfiT, T, FF, D}; pg8::StaticOrder S; S.init(T, FF, G, (int)blockIdx.x);
        pg8::EpiRelu2 E{(bf16*)(ws + WS_H)};
        pg8::gemm_phase<pg8::EpiRelu2, pg8::StaticOrder, PG8_ALIGN, PG8_SP2>(lds + RING_OFF, g, S, E);
        if (BOTH(PH_FFI)) GRID_BAR();
    }
    if (IN(PH_FFO)) { PH_BEGIN
        pg8::Gemm g{(const bf16*)(ws + WS_H), WfoT, T, D, FF}; pg8::StaticOrder S; S.init(T, D, G, (int)blockIdx.x);
        pg8::EpiF32<0> E{(float*)(ws + WS_TMP2B)};
        pg8::gemm_phase<pg8::EpiF32<0>, pg8::StaticOrder, PG8_ALIGN, PG8_SP2>(lds + RING_OFF, g, S, E);
        if (BOTH(PH_FFO)) GRID_BAR();
    }
    if (IN(PH_ROWB)) { PH_BEGIN
        const float* const tmp = (const float*)(ws + WS_TMP2B); const float* const g1 = args.in[22];
        for (int m = gw; m < T; m += NGW) {
            const GAS f32x4* tr = (const GAS f32x4*)(tmp + (size_t)m * D) + lane; GAS f32x4* hr = (GAS f32x4*)(out + (size_t)m * D) + lane;
            f32x4 v[4]; float s = 0.f;
#pragma unroll
            for (int j = 0; j < 4; ++j) { v[j] = tr[64 * j]; s += (v[j].x * v[j].x + v[j].y * v[j].y) + (v[j].z * v[j].z + v[j].w * v[j].w); }
            const float rs = 1.f / sqrtf(wave_sum(s) * (1.f / D) + NORM_EPS);
            GAS unsigned long long* o8 = (GAS unsigned long long*)(XN + (size_t)m * D) + lane;
#pragma unroll
            for (int j = 0; j < 4; ++j) { const f32x4 gg = ((const GAS f32x4*)g1)[lane + 64 * j]; const f32x4 hh = hr[64 * j];
                v[j].x = hh.x + v[j].x * rs * gg.x; v[j].y = hh.y + v[j].y * rs * gg.y; v[j].z = hh.z + v[j].z * rs * gg.z; v[j].w = hh.w + v[j].w * rs * gg.w;
                hr[64 * j] = v[j];
                o8[64 * j] = (unsigned long long)pk2(v[j].x, v[j].y) | ((unsigned long long)pk2(v[j].z, v[j].w) << 32); }
        }
        if (BOTH(PH_ROWB)) GRID_BAR();
    }
    if (IN(PH_PLE)) { PH_BEGIN
        pg8::Gemm g{PB, WpleT, T, D, PLE}; pg8::StaticOrder S; S.init(T, D, G, (int)blockIdx.x);
        pg8::EpiF32<0> E{(float*)(ws + WS_E)};
        pg8::gemm_phase<pg8::EpiF32<0>, pg8::StaticOrder, PG8_ALIGN, PG8_SP2>(lds + RING_OFF, g, S, E);
        if (BOTH(PH_PLE)) GRID_BAR();
    }
    if (IN(PH_PLEG)) { PH_BEGIN
        pg8::Gemm g{XN, WpgT, T, D, D}; pg8::StaticOrder S; S.init(T, D, G, (int)blockIdx.x);
        pg8::EpiF32<1> E{(float*)(ws + WS_E)};
        pg8::gemm_phase<pg8::EpiF32<1>, pg8::StaticOrder, PG8_ALIGN, PG8_SP2>(lds + RING_OFF, g, S, E);
        if (BOTH(PH_PLEG)) GRID_BAR();
    }
    if (IN(PH_ROWC)) { PH_BEGIN
        const float* const tmp = (const float*)(ws + WS_E); const float* const g1 = args.in[25];
        for (int m = gw; m < T; m += NGW) {
            const GAS f32x4* tr = (const GAS f32x4*)(tmp + (size_t)m * D) + lane; GAS f32x4* hr = (GAS f32x4*)(out + (size_t)m * D) + lane;
            f32x4 v[4]; float s = 0.f;
#pragma unroll
            for (int j = 0; j < 4; ++j) { v[j] = tr[64 * j]; s += (v[j].x * v[j].x + v[j].y * v[j].y) + (v[j].z * v[j].z + v[j].w * v[j].w); }
            const float rs = 1.f / sqrtf(wave_sum(s) * (1.f / D) + NORM_EPS);
#pragma unroll
            for (int j = 0; j < 4; ++j) { const f32x4 gg = ((const GAS f32x4*)g1)[lane + 64 * j]; const f32x4 hh = hr[64 * j];
                v[j].x = hh.x + v[j].x * rs * gg.x; v[j].y = hh.y + v[j].y * rs * gg.y; v[j].z = hh.z + v[j].z * rs * gg.z; v[j].w = hh.w + v[j].w * rs * gg.w;
                hr[64 * j] = v[j]; }
        }
    }
#undef IN
#undef BOTH
}

extern "C" void kernel_launch(void* const* d_in, const int* in_sizes, int n_in, void* d_out, int out_size, void* d_ws, size_t ws_size, hipStream_t stream) {
    static int grid = 0;
    if (grid == 0) {
        if (n_in != 26 || in_sizes[0] != T * D || out_size != T * D || ws_size < WS_END) { fprintf(stderr, "kernel_launch: shape/workspace mismatch (n_in %d, in0 %d, out %d, ws %zu)\n", n_in, n_in > 0 ? in_sizes[0] : -1, out_size, ws_size); grid = -1; return; }
        int dev = 0, cus = 0, per_cu = 0;
        if (hipGetDevice(&dev) != hipSuccess || hipDeviceGetAttribute(&cus, hipDeviceAttributeMultiprocessorCount, dev) != hipSuccess) { grid = -1; return; }
        if (hipFuncSetAttribute((const void*)skel_fwd, hipFuncAttributeMaxDynamicSharedMemorySize, LDS_BYTES) != hipSuccess) { fprintf(stderr, "kernel_launch: hipFuncSetAttribute failed\n"); grid = -1; return; }
        if (hipOccupancyMaxActiveBlocksPerMultiprocessor(&per_cu, (const void*)skel_fwd, NWAVES * 64, LDS_BYTES) != hipSuccess || per_cu < 1) { fprintf(stderr, "kernel_launch: occupancy query says %d\n", per_cu); }
        (void)hipGetLastError();
        grid = cus;
    }
    if (grid < 0) return;
    if (hipMemsetAsync((char*)d_ws + WS_CTL, 0, CTL_ZERO_BYTES, stream) != hipSuccess) return;
    Args a{};
    for (int i = 0; i < 26; ++i) a.in[i] = (const float*)d_in[i];
    a.out = (float*)d_out; a.ws = (unsigned char*)d_ws;
#if MK_PER_PHASE
    for (int li = 0; li < N_PHASES; ++li) { a.ph_lo = li; a.ph_hi = li + 1; a.li = li; hipLaunchKernelGGL(skel_fwd, dim3(grid), dim3(NWAVES * 64), LDS_BYTES, stream, a); }
#else
    a.ph_lo = 0; a.ph_hi = N_PHASES; a.li = 0; hipLaunchKernelGGL(skel_fwd, dim3(grid), dim3(NWAVES * 64), LDS_BYTES, stream, a);
#endif
}
```

```cpp
#include <hip/hip_runtime.h>
#include <cstdio>
#include <cstdint>
namespace pg8 {
#define PG8_LAS __attribute__((address_space(3)))
typedef unsigned short bf16_t;
typedef short bf16x8 __attribute__((ext_vector_type(8)));
typedef float f32x4 __attribute__((ext_vector_type(4)));
typedef unsigned u32x4 __attribute__((ext_vector_type(4)));
constexpr int BM = 256, BK = 64, HALF = 128, HTB = HALF * BK * 2  , STAGE_BYTES = 8 * HTB, NXCD = 8, WGM = 8;

__host__ __device__ __forceinline__ int lds_byte(int r, int c) { const int st = (r >> 4) * 2 + (c >> 5), rr = r & 15, cc = c & 31, ob = rr * 64 + cc * 2; return st * 1024 + (ob ^ (((ob >> 9) & 1) << 5)); }
__host__ __device__ __forceinline__ void stage_rc(int b, int& R, int& C) { const int st = b / 1024, sb = b % 1024, swz = sb ^ (((sb >> 9) & 1) << 5); R = (st >> 1) * 16 + swz / 64; C = (st & 1) * 32 + (swz % 64) / 2; }
__host__ __device__ __forceinline__ int perm32(int rho) { const int n = rho >> 4, i = rho & 15; return 8 * (i >> 2) + 4 * n + (i & 3); }

struct Unit { int pm, pn; };
struct Gemm { const bf16_t* A; const bf16_t* Bt; int M, N, K; };

struct StaticOrder {
    int nM, nN, nwg, G, c;
    __host__ __device__ void init(int M, int N, int G_, int c_) { nM = M / BM; nN = N / BM; nwg = nM * nN; G = G_; c = c_; }
    __host__ __device__ bool next(int i, Unit& u) const {
        const long L = (long)i * G + c; if (L >= nwg) return false;
        int wgid = (int)L; { const int q = nwg / NXCD, r = nwg % NXCD, xcd = wgid % NXCD, off = wgid / NXCD; wgid = (xcd < r ? xcd * (q + 1) : r * (q + 1) + (xcd - r) * q) + off; }
        const int nig = WGM * nN, gid = wgid / nig, fm = gid * WGM, gsz = (nM - fm) < WGM ? (nM - fm) : WGM;
        u.pm = fm + ((wgid % nig) % gsz); u.pn = (wgid % nig) / gsz; return true;
    }
    __device__ __forceinline__ void a_ready(const Unit&) const {}
    __device__ __forceinline__ void done(const Unit&) const {}
};

typedef __bf16 bf16pair_t __attribute__((ext_vector_type(2)));
__device__ __forceinline__ unsigned cvt_pk_bf16(float lo, float hi) { const bf16pair_t v = {(__bf16)lo, (__bf16)hi}; return __builtin_bit_cast(unsigned, v); }
typedef float f32x2 __attribute__((ext_vector_type(2)));
__device__ __forceinline__ f32x2 gelu_pk(f32x2 v) {
    const f32x2 av = __builtin_elementwise_abs(v), d = av * 0.2316418882f + 1.0f;
    f32x2 t; t.x = __builtin_amdgcn_rcpf(d.x); t.y = __builtin_amdgcn_rcpf(d.y);
    f32x2 q = t * 0.5307027145f + (-0.7265760135f); q = q * t + 0.7107068705f; q = q * t + (-0.142248368f); q = q * t + 0.127414796f; q = q * t;
    const f32x2 s = (v * v) * (-0.72134752044f);
    f32x2 e; e.x = __builtin_amdgcn_exp2f(s.x); e.y = __builtin_amdgcn_exp2f(s.y);
    const f32x2 m = v * (q * e), r = v - m;
    f32x2 o; o.x = v.x < 0.f ? m.x : r.x; o.y = v.y < 0.f ? m.y : r.y; return o;
}

template <int ACT  > struct EpiBf16 {
    static constexpr bool PERM = true, AFTER_DRAIN = false; static_assert(ACT == 0 || ACT == 1, "EpiBf16: ACT is 0 (none) or 1 (gelu_pk)");
    bf16_t* O; int ldc; const float* bias; int split_cols; size_t split_stride; float scale0;
    __device__ __forceinline__ void operator()(const f32x4 (&acc)[2][2][4][2], const Unit& u, int wr, int wc, int fr, int fq) const {
        const int row0 = u.pm * BM + wr * 64 + fr; int colt = u.pn * BM; bf16_t* base = O;
        float sc = 1.f; if (split_cols) { const int t = colt / split_cols; base += (size_t)t * split_stride; colt -= t * split_cols; if (t == 0) sc = scale0; }
        const int col0 = colt + wc * 32 + 8 * fq, bcol0 = u.pn * BM + wc * 32 + 8 * fq;
        f32x4 bv[2][2];
#pragma unroll
        for (int bj = 0; bj < 2; ++bj)
#pragma unroll
            for (int n = 0; n < 2; ++n) bv[bj][n] = bias ? *(const f32x4*)(bias + bcol0 + bj * HALF + 4 * n) : (f32x4){0.f, 0.f, 0.f, 0.f};
#pragma unroll
        for (int ai = 0; ai < 2; ++ai)
#pragma unroll
            for (int m = 0; m < 4; ++m) { bf16_t* rowp = base + (size_t)(row0 + ai * HALF + m * 16) * ldc + col0;
#pragma unroll
                for (int bj = 0; bj < 2; ++bj) { f32x4 v0 = acc[ai][bj][m][0] + bv[bj][0], v1 = acc[ai][bj][m][1] + bv[bj][1];
                    if (ACT == 1) { f32x2 a = gelu_pk((f32x2){v0[0], v0[1]}), b = gelu_pk((f32x2){v0[2], v0[3]}), c = gelu_pk((f32x2){v1[0], v1[1]}), d = gelu_pk((f32x2){v1[2], v1[3]});
                        v0 = (f32x4){a.x, a.y, b.x, b.y}; v1 = (f32x4){c.x, c.y, d.x, d.y}; }
                    v0 = v0 * sc; v1 = v1 * sc; u32x4 w; w.x = cvt_pk_bf16(v0[0], v0[1]); w.y = cvt_pk_bf16(v0[2], v0[3]); w.z = cvt_pk_bf16(v1[0], v1[1]); w.w = cvt_pk_bf16(v1[2], v1[3]);
                    *(u32x4*)(rowp + bj * HALF) = w; } }
    }
};
template <class Epi, class Sched, bool ALIGN_EPI = false, bool SP2 = false>
__device__ __forceinline__ void gemm_phase(PG8_LAS unsigned char* lds, const Gemm g, const Sched& S, const Epi& E) {
    const int tid = threadIdx.x, wid = __builtin_amdgcn_readfirstlane(tid >> 6), lane = tid & 63, wr = wid >> 2, wc = wid & 3, fr = lane & 15, fq = lane >> 4;
    const int K = g.K, nt = K / BK;
    unsigned voffA[2], voffB[2];
#pragma unroll
    for (int i = 0; i < 2; ++i) { int R, C; stage_rc(tid * 16 + i * 8192, R, C); const int Rb = Epi::PERM ? ((R & ~31) + perm32(R & 31)) : R;
        voffA[i] = (unsigned)(R * K + C) * 2u; voffB[i] = (unsigned)(Rb * K + C) * 2u; }
    const size_t kstep = (size_t)(BK * 2);
    const size_t hstep = (size_t)HALF * K * 2;
    const size_t tstep = 2 * hstep;
    const unsigned ldsw = (unsigned)wid * 1024u;
    const int aoff = lds_byte(wr * 64 + fr, fq * 8), boff = lds_byte(wc * 32 + fr, fq * 8);
#define PG8_SA(b, h) (((b) * 2 + (h)) * HTB)
#define PG8_SB(b, h) ((4 + (b) * 2 + (h)) * HTB)
#define PG8_STAGE(bufoff, gbase, voff) do { _Pragma("unroll") for (int _i = 0; _i < 2; ++_i) \
        __builtin_amdgcn_global_load_lds((const unsigned*)((const char*)(gbase) + (voff)[_i]), (PG8_LAS unsigned*)(lds + (bufoff) + ldsw + _i * 8192), 16, 0, 0); } while (0)
#define PG8_LDA(dst, b, h) do { _Pragma("unroll") for (int m = 0; m < 4; ++m) _Pragma("unroll") for (int k = 0; k < 2; ++k) dst[m][k] = *(const PG8_LAS bf16x8*)(lds + PG8_SA(b, h) + aoff + m * 2048 + k * 1024); } while (0)
#define PG8_LDB(dst, b, h) do { _Pragma("unroll") for (int n = 0; n < 2; ++n) _Pragma("unroll") for (int k = 0; k < 2; ++k) dst[n][k] = *(const PG8_LAS bf16x8*)(lds + PG8_SB(b, h) + boff + n * 2048 + k * 1024); } while (0)
#define PG8_MMA(ai, bj, At, Bt) do { __builtin_amdgcn_s_setprio(1); _Pragma("unroll") for (int m = 0; m < 4; ++m) _Pragma("unroll") for (int n = 0; n < 2; ++n) _Pragma("unroll") for (int k = 0; k < 2; ++k) \
        acc[ai][bj][m][n] = __builtin_amdgcn_mfma_f32_16x16x32_bf16(Bt[n][k], At[m][k], acc[ai][bj][m][n], 0, 0, 0); __builtin_amdgcn_s_setprio(0); } while (0)
#define PG8_WAIT_V(n) asm volatile("s_waitcnt vmcnt(" #n ")" ::: "memory")
#define PG8_WAIT_L(n) asm volatile("s_waitcnt lgkmcnt(" #n ")" ::: "memory")
#define PG8_BAR __builtin_amdgcn_s_barrier()
#define PG8_SCHED __builtin_amdgcn_sched_barrier(0)
    Unit cur, nxt; int ui = 0;
    if (!S.next(0, cur)) return;
    f32x4 acc[2][2][4][2];
#pragma unroll
    for (int a = 0; a < 2; ++a)
#pragma unroll
        for (int b = 0; b < 2; ++b)
#pragma unroll
            for (int m = 0; m < 4; ++m)
#pragma unroll
                for (int n = 0; n < 2; ++n) acc[a][b][m][n] = (f32x4){0.f, 0.f, 0.f, 0.f};
    bf16x8 At[4][2], B0[2][2], B1[2][2];
    const char* cA = (const char*)g.A + (size_t)cur.pm * tstep; const char* cB = (const char*)g.Bt + (size_t)cur.pn * tstep;
    S.a_ready(cur);
    if constexpr (SP2) {
        PG8_STAGE(PG8_SB(0, 0), cB, voffB); PG8_STAGE(PG8_SB(0, 1), cB + hstep, voffB); PG8_STAGE(PG8_SA(0, 0), cA, voffA); PG8_STAGE(PG8_SA(0, 1), cA + hstep, voffA);
        if (wr == 1) PG8_BAR;
        PG8_WAIT_V(2); PG8_BAR;
        PG8_STAGE(PG8_SB(1, 0), cB + kstep, voffB); PG8_STAGE(PG8_SA(1, 0), cA + kstep, voffA); PG8_STAGE(PG8_SB(1, 1), cB + hstep + kstep, voffB);
        PG8_WAIT_V(6); PG8_BAR;
    } else {
        PG8_STAGE(PG8_SB(0, 0), cB, voffB); PG8_STAGE(PG8_SA(0, 0), cA, voffA); PG8_STAGE(PG8_SB(0, 1), cB + hstep, voffB); PG8_STAGE(PG8_SA(0, 1), cA + hstep, voffA);
        if (wr == 1) PG8_BAR;
        PG8_WAIT_V(4); PG8_BAR;
        PG8_STAGE(PG8_SB(1, 0), cB + kstep, voffB); PG8_STAGE(PG8_SA(1, 0), cA + kstep, voffA); PG8_STAGE(PG8_SB(1, 1), cB + hstep + kstep, voffB);
        PG8_WAIT_V(6); PG8_BAR;
    }
    for (;;) {
        const bool has_next = S.next(ui + 1, nxt);
        const char* nA = has_next ? (const char*)g.A + (size_t)nxt.pm * tstep : cA; const char* nB = has_next ? (const char*)g.Bt + (size_t)nxt.pn * tstep : cB;
        for (int t = 0; t < nt; t += 2) {
            const bool last = (t == nt - 2);
            const char* a1 = cA + (size_t)(t + 1) * kstep;
            const char* a2 = last ? nA : cA + (size_t)(t + 2) * kstep; const char* b2 = last ? nB : cB + (size_t)(t + 2) * kstep;
            const char* a3 = a2 + kstep; const char* b3 = b2 + kstep;
            if (last && has_next) S.a_ready(nxt);
            if constexpr (SP2) {
            PG8_LDB(B0, 0, 0); PG8_LDB(B1, 0, 1); PG8_SCHED; PG8_LDA(At, 0, 0); PG8_STAGE(PG8_SA(1, 1), a1 + hstep, voffA);
            PG8_WAIT_V(8); PG8_WAIT_L(0); PG8_BAR; PG8_MMA(0, 0, At, B0); PG8_MMA(0, 1, At, B1); PG8_BAR; PG8_SCHED;
            PG8_LDA(At, 0, 1); PG8_STAGE(PG8_SB(0, 0), b2, voffB); PG8_STAGE(PG8_SB(0, 1), b2 + hstep, voffB); PG8_STAGE(PG8_SA(0, 0), a2, voffA);
            PG8_WAIT_V(8); PG8_WAIT_L(0); PG8_BAR; PG8_MMA(1, 0, At, B0); PG8_MMA(1, 1, At, B1); PG8_BAR; PG8_SCHED;
            PG8_LDB(B0, 1, 0); PG8_LDB(B1, 1, 1); PG8_SCHED; PG8_LDA(At, 1, 0); PG8_STAGE(PG8_SA(0, 1), a2 + hstep, voffA);
            PG8_WAIT_V(8); PG8_WAIT_L(0); PG8_BAR; PG8_MMA(0, 0, At, B0); PG8_MMA(0, 1, At, B1); PG8_BAR; PG8_SCHED;
            PG8_LDA(At, 1, 1); PG8_STAGE(PG8_SB(1, 0), b3, voffB); PG8_STAGE(PG8_SB(1, 1), b3 + hstep, voffB); PG8_STAGE(PG8_SA(1, 0), a3, voffA);
            PG8_WAIT_V(8); PG8_WAIT_L(0); PG8_BAR; PG8_MMA(1, 0, At, B0); PG8_MMA(1, 1, At, B1); PG8_BAR; PG8_SCHED;
            } else {
            PG8_LDB(B0, 0, 0); PG8_SCHED; PG8_LDA(At, 0, 0); PG8_STAGE(PG8_SA(1, 1), a1 + hstep, voffA);
            PG8_WAIT_L(8); PG8_BAR; PG8_WAIT_L(0); PG8_MMA(0, 0, At, B0); PG8_BAR; PG8_SCHED;
            PG8_LDB(B1, 0, 1); PG8_STAGE(PG8_SB(0, 0), b2, voffB);
            PG8_BAR; PG8_WAIT_L(0); PG8_MMA(0, 1, At, B1); PG8_BAR;
            PG8_LDA(At, 0, 1); PG8_STAGE(PG8_SA(0, 0), a2, voffA);
            PG8_BAR; PG8_WAIT_L(0); PG8_MMA(1, 0, At, B0); PG8_BAR; PG8_SCHED;
            PG8_STAGE(PG8_SB(0, 1), b2 + hstep, voffB);
            PG8_WAIT_V(6); PG8_BAR; PG8_MMA(1, 1, At, B1); PG8_BAR;
            PG8_LDB(B0, 1, 0); PG8_SCHED; PG8_LDA(At, 1, 0); PG8_STAGE(PG8_SA(0, 1), a2 + hstep, voffA);
            PG8_WAIT_L(8); PG8_BAR; PG8_WAIT_L(0); PG8_MMA(0, 0, At, B0); PG8_BAR; PG8_SCHED;
            PG8_LDB(B1, 1, 1); PG8_STAGE(PG8_SB(1, 0), b3, voffB);
            PG8_BAR; PG8_WAIT_L(0); PG8_MMA(0, 1, At, B1); PG8_BAR;
            PG8_LDA(At, 1, 1); PG8_STAGE(PG8_SA(1, 0), a3, voffA);
            PG8_BAR; PG8_WAIT_L(0); PG8_MMA(1, 0, At, B0); PG8_BAR; PG8_SCHED;
            PG8_STAGE(PG8_SB(1, 1), b3 + hstep, voffB);
            PG8_WAIT_V(6); PG8_BAR; PG8_MMA(1, 1, At, B1); PG8_BAR;
            }
        }
        if constexpr (ALIGN_EPI) { if (wr == 0) PG8_BAR; }
        if constexpr (!Epi::AFTER_DRAIN) { E(acc, cur, wr, wc, fr, fq); S.done(cur); }
        if (!has_next) break;
#pragma unroll
        for (int a = 0; a < 2; ++a)
#pragma unroll
            for (int b = 0; b < 2; ++b)
#pragma unroll
                for (int m = 0; m < 4; ++m)
#pragma unroll
                    for (int n = 0; n < 2; ++n) acc[a][b][m][n] = (f32x4){0.f, 0.f, 0.f, 0.f};
        cur = nxt; cA = nA; cB = nB; ++ui;
        if constexpr (ALIGN_EPI) { if (wr == 1) PG8_BAR; }
    }
    PG8_WAIT_V(0);
    if constexpr (!ALIGN_EPI) { if (wr == 0) PG8_BAR; }
    PG8_BAR;
    if constexpr (Epi::AFTER_DRAIN) { E.fused(acc, cur, wr, wc, fr, fq, lds, wid, lane); S.done(cur); }
#undef PG8_SA
#undef PG8_SB
#undef PG8_STAGE
#undef PG8_LDA
#undef PG8_LDB
#undef PG8_MMA
#undef PG8_WAIT_V
#undef PG8_WAIT_L
#undef PG8_BAR
#undef PG8_SCHED
}
}
#define GAS __attribute__((address_space(1)))
#define LAS __attribute__((address_space(3)))
typedef unsigned short bf16;
typedef unsigned v4u __attribute__((ext_vector_type(4)));
typedef float f32x4 __attribute__((ext_vector_type(4)));
typedef short bf16x8 __attribute__((ext_vector_type(8)));
typedef GAS unsigned gu32;
typedef GAS unsigned long long gu64;
#define RLX_AGENT __ATOMIC_RELAXED, __HIP_MEMORY_SCOPE_AGENT
#define LDS_WAIT() asm volatile("s_waitcnt lgkmcnt(0)" ::: "memory")
#define VM_WAIT() asm volatile("s_waitcnt vmcnt(0)" ::: "memory")
__device__ __forceinline__ unsigned long long rt() { return __builtin_amdgcn_s_memrealtime(); }
__device__ __forceinline__ unsigned f2bf(float f) { return (unsigned)__builtin_bit_cast(unsigned short, (__bf16)f); }
__device__ __forceinline__ unsigned pk2(float lo, float hi) { return pg8::cvt_pk_bf16(lo, hi); }

#define XB_TMO      128
#define XB_XCNT(j)  (256  + 64 * (j))
#define XB_XSUB(j)  (1280 + 64 * (j))
#define XB_XGEN(j)  (2304 + 64 * (j))
#define XB_TOP      3328
#define XB_TOPGEN   3392
#define XCD_BAR_WORDS 3456
#define XB_SPIN_CAP (1u << 18)

__device__ __forceinline__ unsigned xb_ld(unsigned* p)              { return __hip_atomic_load(p, __ATOMIC_RELAXED, __HIP_MEMORY_SCOPE_AGENT); }
__device__ __forceinline__ unsigned xb_add(unsigned* p, unsigned v) { return __hip_atomic_fetch_add(p, v, __ATOMIC_RELAXED, __HIP_MEMORY_SCOPE_AGENT); }
__device__ __forceinline__ unsigned xb_xcc_id() { return (unsigned)__builtin_amdgcn_s_getreg((3 << 11) | 20) & 0xFu; }
#define XB_SPIN(cond, bar) do { unsigned _sp = 0; while (cond) { __builtin_amdgcn_s_sleep(1); \
    if ((++_sp & 255u) == 0u) { if (xb_ld(&(bar)[XB_TMO])) break; if (_sp > XB_SPIN_CAP) { atomicAdd(&(bar)[XB_TMO], 1u); break; } } } } while (0)

struct XcdBarrier {
    unsigned* bar; unsigned x;
    volatile LAS unsigned* st;
};

__device__ __forceinline__ XcdBarrier xcd_barrier_post(unsigned* bar, volatile LAS unsigned* st) {
    XcdBarrier b; b.bar = bar; b.x = xb_xcc_id(); b.st = st;
    if (threadIdx.x == 0) (void)xb_add(&bar[XB_XCNT(b.x)], 1u);
    return b;
}
__device__ __forceinline__ void xcd_barrier_complete(unsigned* bar, unsigned x, unsigned& nloc, unsigned& nx) {
    const unsigned G = gridDim.x * gridDim.y * gridDim.z;
    unsigned sum, cnt, mine, sp = 0u;
    for (;;) {
        sum = 0u; cnt = 0u; mine = 0u;
#pragma unroll
        for (unsigned j = 0; j < 16; ++j) { const unsigned c = xb_ld(&bar[XB_XCNT(j)]); sum += c; cnt += (c > 0u) ? 1u : 0u; mine = (j == x) ? c : mine; }
        if (sum == G) break;
        __builtin_amdgcn_s_sleep(1);
        if ((++sp & 255u) == 0u) { if (xb_ld(&bar[XB_TMO])) break; if (sp > XB_SPIN_CAP) { atomicAdd(&bar[XB_TMO], 1u); break; } }
    }
    nloc = mine > 0u ? mine : 1u; nx = cnt > 0u ? cnt : 1u;
}

__device__ __forceinline__ void xcd_barrier(const XcdBarrier& b) {
    asm volatile("s_waitcnt vmcnt(0)" ::: "memory");
    __syncthreads();
    if (threadIdx.x == 0) {
        unsigned* bar = b.bar;
        __builtin_amdgcn_s_waitcnt(0);
        unsigned nloc = b.st[0], nx = b.st[1];
        if (nloc == 0u) { xcd_barrier_complete(bar, b.x, nloc, nx); b.st[0] = nloc; b.st[1] = nx; }
        const unsigned old = xb_add(&bar[XB_XSUB(b.x)], 1u);
        const unsigned gen = old / nloc;
        if (old + 1u == (gen + 1u) * nloc) {
            __builtin_amdgcn_fence(__ATOMIC_RELEASE, "agent");
            asm volatile("s_waitcnt vmcnt(0)" ::: "memory");
            const unsigned og = xb_add(&bar[XB_TOP], 1u);
            const unsigned tg = og / nx;
            if (og + 1u == (tg + 1u) * nx) xb_add(&bar[XB_TOPGEN], 1u);
            else XB_SPIN(xb_ld(&bar[XB_TOPGEN]) == tg, bar);
            __builtin_amdgcn_fence(__ATOMIC_ACQUIRE, "agent");
            xb_add(&bar[XB_XGEN(b.x)], 1u);
            asm volatile("s_waitcnt vmcnt(0)" ::: "memory");
        } else {
            XB_SPIN(xb_ld(&bar[XB_XGEN(b.x)]) == gen, bar);
            __builtin_amdgcn_fence(__ATOMIC_ACQUIRE, "agent");
            asm volatile("s_waitcnt vmcnt(0)" ::: "memory");
        }
    }
    __syncthreads();
}
#define PG8_SP2 true
#define PG8_ALIGN true

constexpr int NWAVES = 8;
constexpr int BATCH = 4, SEQ = 8192, D = 1024, T = BATCH * SEQ, HD = 64;
constexpr int NIN = 6144;
constexpr int FF = 4096, PLE = 256;
constexpr int ZA_LD = 2304, ZR_LD = 1792, ZG_LD = 2048;
constexpr int RW = 512;
constexpr float NORM_EPS = 1e-6f, GN_EPS = 64e-5f;
#ifndef MK_PER_PHASE
#define MK_PER_PHASE 0
#endif
enum { PH_PRO = 0, PH_INPROJ, PH_ATT, PH_PREP, PH_CHUNK, PH_SEQ, PH_POST, PH_UPA, PH_UPR, PH_WO, PH_ROWA, PH_FFI, PH_FFO, PH_ROWB, PH_PLE, PH_PLEG, PH_ROWC, N_PHASES };

constexpr size_t MiB = 1u << 20;
constexpr size_t WS_CTL = 0, CTL_ZERO_BYTES = 1 * MiB;
constexpr size_t WS_CS = 1 * MiB;
constexpr size_t WS_BONUS = 3 * MiB;
constexpr size_t WS_LSE = 4 * MiB;
constexpr size_t WS_WIN = 6 * MiB, WS_WFI = 18 * MiB, WS_WFO = 26 * MiB, WS_WO = 34 * MiB, WS_WPG = 36 * MiB;
constexpr size_t WS_WPLE = 38 * MiB, WS_WAU = 38 * MiB + 512 * 1024, WS_WRU = 39 * MiB;
constexpr size_t WS_XN = 40 * MiB;
constexpr size_t WS_PB = 104 * MiB;
constexpr size_t WS_ZA = 120 * MiB;
constexpr size_t WS_ZR = 264 * MiB;
constexpr size_t WS_ZG = 376 * MiB;
constexpr size_t WS_END = 512 * MiB;
constexpr size_t WS_OA = WS_XN;
constexpr size_t WS_R = WS_ZA, WS_KP = WS_ZA + 32 * MiB, WS_V = WS_ZA + 64 * MiB, WS_AV = WS_ZA + 96 * MiB;
constexpr size_t WS_Y = WS_ZR;
constexpr size_t WS_ORW = WS_ZR + 64 * MiB;
constexpr size_t WS_M1 = WS_ZA;
constexpr size_t WS_TMP2A = 184 * MiB;
constexpr size_t WS_H = WS_ZA;
constexpr size_t WS_TMP2B = WS_ZG;
constexpr size_t WS_E = WS_ZA;
constexpr size_t WS_OG = WS_XN + 16 * MiB;
constexpr size_t DO_DEC = 0;
constexpr size_t DO_BV = 64 * MiB, DO_GT = 96 * MiB;
constexpr size_t WS_YLT = WS_XN + 16 * MiB;
constexpr size_t WS_GC = 504 * MiB;
constexpr int CW_TMO = 0, CW_CODE = 1, CW_BAR = 4096;

constexpr int RING_OFF = 0, RING_BYTES = 143360;
constexpr int LDSCTL_OFF = RING_BYTES, MISC_OFF = LDSCTL_OFF + 320;
constexpr int LDS_BYTES = 147456;

typedef unsigned v2u __attribute__((ext_vector_type(2)));
__device__ __forceinline__ float bf2f(bf16 u) { return __builtin_bit_cast(float, (unsigned)u << 16); }
__device__ __forceinline__ float bflo(unsigned u) { return __builtin_bit_cast(float, u << 16); }
__device__ __forceinline__ float bfhi(unsigned u) { return __builtin_bit_cast(float, u & 0xffff0000u); }
__device__ __forceinline__ float sigmoidf_(float x) { return 1.0f / (1.0f + __expf(-x)); }
template <int CTRL> __device__ __forceinline__ float dpp_f(float v) { return __builtin_bit_cast(float, __builtin_amdgcn_update_dpp(0, __builtin_bit_cast(int, v), CTRL, 0xF, 0xF, true)); }
__device__ __forceinline__ float quad_sum(float v) { v += dpp_f<0xB1>(v); v += dpp_f<0x4E>(v); return v; }
__device__ __forceinline__ float wave_sum(float v) {
    v = quad_sum(v); v += dpp_f<0x141>(v); v += dpp_f<0x140>(v);
    return __builtin_bit_cast(float, __builtin_amdgcn_readlane(__builtin_bit_cast(int, v), 0)) + __builtin_bit_cast(float, __builtin_amdgcn_readlane(__builtin_bit_cast(int, v), 16)) +
           __builtin_bit_cast(float, __builtin_amdgcn_readlane(__builtin_bit_cast(int, v), 32)) + __builtin_bit_cast(float, __builtin_amdgcn_readlane(__builtin_bit_cast(int, v), 48));
}

namespace pg8 {
struct EpiInProj {
    static constexpr bool PERM = true, AFTER_DRAIN = false;
    bf16_t *za, *zr, *zg;
    __device__ __forceinline__ void operator()(const f32x4 (&acc)[2][2][4][2], const Unit& u, int wr, int wc, int fr, int fq) const {
        bf16_t* base; int ld, colt; bool sig = false;
        if (u.pn < 9) { base = za; ld = 2304; colt = u.pn * 256; }
        else if (u.pn < 16) { base = zr; ld = 1792; colt = (u.pn - 9) * 256; }
        else { base = zg; ld = 2048; colt = (u.pn - 16) * 256; sig = true; }
        const int row0 = u.pm * BM + wr * 64 + fr, col0 = colt + wc * 32 + 8 * fq;
#pragma unroll
        for (int ai = 0; ai < 2; ++ai)
#pragma unroll
            for (int m = 0; m < 4; ++m) { bf16_t* rowp = base + (size_t)(row0 + ai * HALF + m * 16) * ld + col0;
#pragma unroll
                for (int bj = 0; bj < 2; ++bj) { f32x4 v0 = acc[ai][bj][m][0], v1 = acc[ai][bj][m][1];
                    if (sig) {
#pragma unroll
                        for (int k = 0; k < 4; ++k) { v0[k] = 1.0f / (1.0f + __expf(-v0[k])); v1[k] = 1.0f / (1.0f + __expf(-v1[k])); } }
                    u32x4 w; w.x = cvt_pk_bf16(v0[0], v0[1]); w.y = cvt_pk_bf16(v0[2], v0[3]); w.z = cvt_pk_bf16(v1[0], v1[1]); w.w = cvt_pk_bf16(v1[2], v1[3]);
                    *(u32x4*)(rowp + bj * HALF) = w; } }
    }
};
struct EpiGateF32 {
    static constexpr bool PERM = false, AFTER_DRAIN = false;
    float* out; const bf16_t* gate; int gld, gcol0;
    __device__ __forceinline__ void operator()(const f32x4 (&acc)[2][2][4][2], const Unit& u, int wr, int wc, int fr, int fq) const {
        const int col0 = u.pn * BM + wc * 32 + 4 * fq;
#pragma unroll
        for (int ai = 0; ai < 2; ++ai)
#pragma unroll
            for (int m = 0; m < 4; ++m) { const int r = u.pm * BM + ai * HALF + wr * 64 + m * 16 + fr;
#pragma unroll
                for (int bj = 0; bj < 2; ++bj)
#pragma unroll
                    for (int n = 0; n < 2; ++n) { const int c = col0 + bj * HALF + n * 16;
                        const unsigned long long gq = *(const unsigned long long*)(gate + (size_t)r * gld + gcol0 + c);
                        const unsigned g0 = (unsigned)gq, g1 = (unsigned)(gq >> 32);
                        f32x4 a = acc[ai][bj][m][n];
                        a[0] *= __builtin_bit_cast(float, g0 << 16); a[1] *= __builtin_bit_cast(float, g0 & 0xffff0000u);
                        a[2] *= __builtin_bit_cast(float, g1 << 16); a[3] *= __builtin_bit_cast(float, g1 & 0xffff0000u);
                        *(f32x4*)(out + (size_t)r * 1024 + c) = a; } }
    }
};
struct EpiMerge {
    static constexpr bool PERM = true, AFTER_DRAIN = false;
    const float* tmp; const bf16_t* gate; int gld, gcol0; bf16_t* out;
    __device__ __forceinline__ void operator()(const f32x4 (&acc)[2][2][4][2], const Unit& u, int wr, int wc, int fr, int fq) const {
        const int row0 = u.pm * BM + wr * 64 + fr, col0 = u.pn * BM + wc * 32 + 8 * fq;
#pragma unroll
        for (int ai = 0; ai < 2; ++ai)
#pragma unroll
            for (int m = 0; m < 4; ++m) { const int r = row0 + ai * HALF + m * 16;
#pragma unroll
                for (int bj = 0; bj < 2; ++bj) { const int c = col0 + bj * HALF;
                    const u32x4 gq = *(const u32x4*)(gate + (size_t)r * gld + gcol0 + c);
                    const f32x4 t0 = *(const f32x4*)(tmp + (size_t)r * 1024 + c), t1 = *(const f32x4*)(tmp + (size_t)r * 1024 + c + 4);
                    f32x4 v0 = acc[ai][bj][m][0], v1 = acc[ai][bj][m][1];
                    v0[0] = t0[0] + v0[0] * __builtin_bit_cast(float, gq.x << 16); v0[1] = t0[1] + v0[1] * __builtin_bit_cast(float, gq.x & 0xffff0000u);
                    v0[2] = t0[2] + v0[2] * __builtin_bit_cast(float, gq.y << 16); v0[3] = t0[3] + v0[3] * __builtin_bit_cast(float, gq.y & 0xffff0000u);
                    v1[0] = t1[0] + v1[0] * __builtin_bit_cast(float, gq.z << 16); v1[1] = t1[1] + v1[1] * __builtin_bit_cast(float, gq.z & 0xffff0000u);
                    v1[2] = t1[2] + v1[2] * __builtin_bit_cast(float, gq.w << 16); v1[3] = t1[3] + v1[3] * __builtin_bit_cast(float, gq.w & 0xffff0000u);
                    u32x4 w; w.x = cvt_pk_bf16(v0[0], v0[1]); w.y = cvt_pk_bf16(v0[2], v0[3]); w.z = cvt_pk_bf16(v1[0], v1[1]); w.w = cvt_pk_bf16(v1[2], v1[3]);
                    *(u32x4*)(out + (size_t)r * 1024 + c) = w; } }
    }
};
template <int MODE> struct EpiF32 {
    static constexpr bool PERM = false, AFTER_DRAIN = false;
    float* out;
    __device__ __forceinline__ void operator()(const f32x4 (&acc)[2][2][4][2], const Unit& u, int wr, int wc, int fr, int fq) const {
        const int col0 = u.pn * BM + wc * 32 + 4 * fq;
#pragma unroll
        for (int ai = 0; ai < 2; ++ai)
#pragma unroll
            for (int m = 0; m < 4; ++m) { const int r = u.pm * BM + ai * HALF + wr * 64 + m * 16 + fr;
#pragma unroll
                for (int bj = 0; bj < 2; ++bj)
#pragma unroll
                    for (int n = 0; n < 2; ++n) { float* p = out + (size_t)r * 1024 + col0 + bj * HALF + n * 16; f32x4 a = acc[ai][bj][m][n];
                        if (MODE == 1) { const f32x4 e = *(const f32x4*)p;
#pragma unroll
                            for (int k = 0; k < 4; ++k) a[k] = e[k] / (1.0f + __expf(-a[k])); }
                        *(f32x4*)p = a; } }
    }
};
struct EpiRelu2 {
    static constexpr bool PERM = true, AFTER_DRAIN = false;
    bf16_t* out;
    __device__ __forceinline__ void operator()(const f32x4 (&acc)[2][2][4][2], const Unit& u, int wr, int wc, int fr, int fq) const {
        const int row0 = u.pm * BM + wr * 64 + fr, col0 = u.pn * BM + wc * 32 + 8 * fq;
#pragma unroll
        for (int ai = 0; ai < 2; ++ai)
#pragma unroll
            for (int m = 0; m < 4; ++m) { bf16_t* rowp = out + (size_t)(row0 + ai * HALF + m * 16) * 4096 + col0;
#pragma unroll
                for (int bj = 0; bj < 2; ++bj) { f32x4 v0 = acc[ai][bj][m][0], v1 = acc[ai][bj][m][1];
#pragma unroll
                    for (int k = 0; k < 4; ++k) { const float a = fmaxf(v0[k], 0.f), b = fmaxf(v1[k], 0.f); v0[k] = a * a; v1[k] = b * b; }
                    u32x4 w; w.x = cvt_pk_bf16(v0[0], v0[1]); w.y = cvt_pk_bf16(v0[2], v0[3]); w.z = cvt_pk_bf16(v1[0], v1[1]); w.w = cvt_pk_bf16(v1[2], v1[3]);
                    *(u32x4*)(rowp + bj * HALF) = w; } }
    }
};
}

__device__ __forceinline__ void p0_transpose_item(const float* W, int K, int N, bf16* WT, int row_off, LAS float* scr, int item, int lane) {
    const int nblk = N / 32, kb = item / nblk, nb = item % nblk, k0 = 64 * kb, n0 = 32 * nb;
#pragma unroll 8
    for (int i = 0; i < 32; ++i) { const int kk = 2 * i + (lane >> 5); scr[kk * 33 + (lane & 31)] = W[(size_t)(k0 + kk) * N + n0 + (lane & 31)]; }
    LDS_WAIT(); asm volatile("" ::: "memory");
    const int c = lane & 7;
#pragma unroll
    for (int j = 0; j < 4; ++j) { const int n = (lane >> 3) + 8 * j; const LAS float* s = scr + (8 * c) * 33 + n;
        v4u o; o.x = pk2(s[0 * 33], s[1 * 33]); o.y = pk2(s[2 * 33], s[3 * 33]); o.z = pk2(s[4 * 33], s[5 * 33]); o.w = pk2(s[6 * 33], s[7 * 33]);
        *(GAS v4u*)(WT + (size_t)(row_off + n0 + n) * K + k0 + 8 * c) = o; }
    LDS_WAIT(); asm volatile("" ::: "memory");
}
__device__ __forceinline__ void rms_row_to_bf16(const float* xrow, const float* g, bf16* orow, int lane) {
    const GAS f32x4* xr = (const GAS f32x4*)xrow + lane; const GAS f32x4* gr = (const GAS f32x4*)g + lane;
    f32x4 v[4]; float s = 0.f;
#pragma unroll
    for (int j = 0; j < 4; ++j) { v[j] = xr[64 * j]; s += (v[j].x * v[j].x + v[j].y * v[j].y) + (v[j].z * v[j].z + v[j].w * v[j].w); }
    const float rs = 1.f / sqrtf(wave_sum(s) * (1.f / D) + NORM_EPS);
    GAS unsigned long long* o8 = (GAS unsigned long long*)orow + lane;
#pragma unroll
    for (int j = 0; j < 4; ++j) { const f32x4 gg = gr[64 * j];
        o8[64 * j] = (unsigned long long)pk2(v[j].x * rs * gg.x, v[j].y * rs * gg.y) | ((unsigned long long)pk2(v[j].z * rs * gg.z, v[j].w * rs * gg.w) << 32); }
}

struct Args { const float* in[26]; float* out; unsigned char* ws; int ph_lo, ph_hi, li, pad; };

__global__ void __launch_bounds__(NWAVES * 64, 2) skel_fwd(Args args) {
    extern __shared__ __attribute__((aligned(16))) unsigned char lds_raw[];
    LAS unsigned char* const lds = (LAS unsigned char*)lds_raw;
    volatile LAS unsigned* const MISC = (volatile LAS unsigned*)(lds + MISC_OFF);
    const int tid0 = threadIdx.x;
    const int G = gridDim.x; int vcu; { const int bx = blockIdx.x; vcu = (G % 8 == 0) ? (bx % 8) * (G / 8) + bx / 8 : bx; }
    for (int u = tid0; u < (LDS_BYTES - LDSCTL_OFF) / 4; u += NWAVES * 64) ((LAS unsigned*)(lds + LDSCTL_OFF))[u] = 0u;
    __syncthreads();
    XcdBarrier bar = xcd_barrier_post((unsigned*)((gu32*)(args.ws + WS_CTL) + CW_BAR), MISC + 8);
#define GRID_BAR() xcd_barrier(bar)
    const int lo = args.ph_lo, hi = args.ph_hi;
#ifndef PH_MASK
#define PH_MASK 0xFFFFFFFFu
#endif
#define IN(k) (((PH_MASK >> (k)) & 1u) && lo <= (k) && (k) < hi)
#define BOTH(k) (IN(k) && IN((k) + 1))
#define PH_BEGIN \
    int tid_l = tid0; asm volatile("" : "+v"(tid_l)); const int tid = tid_l, lane = tid & 63, wave = __builtin_amdgcn_readfirstlane(tid >> 6); \
    unsigned char* ws_l = args.ws; asm volatile("" : "+s"(ws_l)); unsigned char* const ws = ws_l; \
    float* out_l = args.out; asm volatile("" : "+s"(out_l)); float* const out = out_l; \
    const int gw = vcu * NWAVES + wave, NGW = G * NWAVES, gt = vcu * (NWAVES * 64) + tid, NGT = G * NWAVES * 64; \
    const float* const x = args.in[0]; const float* const pin = args.in[1]; \
    bf16* const WinT = (bf16*)(ws + WS_WIN); bf16* const WfiT = (bf16*)(ws + WS_WFI); bf16* const WfoT = (bf16*)(ws + WS_WFO); \
    bf16* const WoT = (bf16*)(ws + WS_WO); bf16* const WpgT = (bf16*)(ws + WS_WPG); bf16* const WpleT = (bf16*)(ws + WS_WPLE); \
    bf16* const WauT = (bf16*)(ws + WS_WAU); bf16* const WruT = (bf16*)(ws + WS_WRU); \
    bf16* const XN = (bf16*)(ws + WS_XN); bf16* const PB = (bf16*)(ws + WS_PB); \
    bf16* const ZA = (bf16*)(ws + WS_ZA); bf16* const ZR = (bf16*)(ws + WS_ZR); bf16* const ZG = (bf16*)(ws + WS_ZG); \
    float2* const CS = (float2*)(ws + WS_CS); \
    (void)lane; (void)wave; (void)gw; (void)NGW; (void)gt; (void)NGT; (void)x; (void)pin; (void)out; (void)WinT; (void)WfiT; (void)WfoT; (void)WoT; (void)WpgT; (void)WpleT; (void)WauT; (void)WruT; (void)XN; (void)PB; (void)ZA; (void)ZR; (void)ZG; (void)CS;

    if (IN(PH_PRO)) { PH_BEGIN
        LAS float* scr = (LAS float*)(lds + RING_OFF + wave * 16384);
        constexpr int I_IN = (D / 64) * (6048 / 32), I_FI = (D / 64) * (FF / 32), I_FO = (FF / 64) * (D / 32), I_O = (D / 64) * (D / 32), I_PG = I_O;
        constexpr int I_PLE = (PLE / 64) * (D / 32), I_AU = (256 / 64) * (D / 32), I_RU = (512 / 64) * (D / 32);
        constexpr int NITEMS = I_IN + I_FI + I_FO + I_O + I_PG + I_PLE + I_AU + I_RU;
        for (int it = gw; it < NITEMS; it += NGW) {
            int r = it;
            if (r < I_IN) { const int nb = r % (6048 / 32); p0_transpose_item(args.in[3], D, 6048, WinT, (nb * 32 >= 4000) ? 96 : 0, scr, r, lane); continue; } r -= I_IN;
            if (r < I_FI) { p0_transpose_item(args.in[20], D, FF, WfiT, 0, scr, r, lane); continue; } r -= I_FI;
            if (r < I_FO) { p0_transpose_item(args.in[21], FF, D, WfoT, 0, scr, r, lane); continue; } r -= I_FO;
            if (r < I_O) { p0_transpose_item(args.in[17], D, D, WoT, 0, scr, r, lane); continue; } r -= I_O;
            if (r < I_PG) { p0_transpose_item(args.in[24], D, D, WpgT, 0, scr, r, lane); continue; } r -= I_PG;
            if (r < I_PLE) { p0_transpose_item(args.in[23], PLE, D, WpleT, 0, scr, r, lane); continue; } r -= I_PLE;
            if (r < I_AU) { p0_transpose_item(args.in[15], 256, D, WauT, 0, scr, r, lane); continue; } r -= I_AU;
            p0_transpose_item(args.in[16], 512, D, WruT, 0, scr, r, lane);
        }
        for (int i = gt; i < 96 * 1024 / 8; i += NGT) ((GAS v4u*)(WinT + (size_t)4000 * 1024))[i] = (v4u){0u, 0u, 0u, 0u};
        for (int m = gw; m < T; m += NGW) rms_row_to_bf16(x + (size_t)m * D, args.in[2], XN + (size_t)m * D, lane);
        for (int m = gw; m < T; m += NGW) { const f32x4 v = ((const GAS f32x4*)(pin + (size_t)m * PLE))[lane];
            ((GAS unsigned long long*)(PB + (size_t)m * PLE))[lane] = (unsigned long long)pk2(v.x, v.y) | ((unsigned long long)pk2(v.z, v.w) << 32); }
        for (int i = gt; i < SEQ * 32; i += NGT) { const int pos = i >> 5, fi = i & 31;
            const float inv = (float)exp(-(double)fi * (1.0 / 32.0) * 9.210340371976184);
            const float ang = (float)pos * inv;
            const double a = (double)ang; const double kq = rint(a * 0.15915494309189535); const double rr = a - kq * 6.283185307179586;
            const float rf = (float)rr; CS[i] = make_float2(cosf(rf), sinf(rf)); }
        if (BOTH(PH_PRO)) GRID_BAR();
    }

    if (IN(PH_INPROJ)) { PH_BEGIN
        pg8::Gemm g{XN, WinT, T, NIN, D}; pg8::StaticOrder S; S.init(T, NIN, G, (int)blockIdx.x);
        pg8::EpiInProj E{ZA, ZR, ZG};
        pg8::gemm_phase<pg8::EpiInProj, pg8::StaticOrder, PG8_ALIGN, PG8_SP2>(lds + RING_OFF, g, S, E);
        if (BOTH(PH_INPROJ)) GRID_BAR();
    }

    if (IN(PH_ATT)) { PH_BEGIN
        constexpr int KS = 72, VS = 264;
        bf16* const OG = (bf16*)(ws + WS_OG); float* const LSE = (float*)(ws + WS_LSE);
        LAS bf16* const Kl = (LAS bf16*)(lds + RING_OFF); LAS bf16* const VT = (LAS bf16*)(lds + RING_OFF + 36864);
        const int lr = lane & 15, lq = lane >> 4;
        for (int unit = vcu; unit < BATCH * 3 * 4 * 64; unit += G) {
            const int tau = unit & 63, h = (unit >> 6) & 3, g = (unit >> 8) % 3, b = unit / (64 * 4 * 3);
            const int dl = (g == 0) ? 1 : (g == 1) ? 4 : 16;
            const int rho = tau % dl, it = tau / dl, i0 = it * 128;
            const int colq = g * 256 + h * 64, colk = 768 + colq, colv = 1536 + colq;
#pragma unroll
            for (int r2 = 0; r2 < 2; ++r2) { const int idx = tid + 512 * r2, key = idx >> 2, p = idx & 3, ik = i0 - 128 + key;
                v4u lo = {0u, 0u, 0u, 0u}, hi = {0u, 0u, 0u, 0u};
                if (ik >= 0) { const int t = ik * dl + rho; const bf16* rowp = ZA + (size_t)(b * SEQ + t) * ZA_LD + colk + 8 * p;
                    const v4u x1 = *(const GAS v4u*)rowp, x2 = *(const GAS v4u*)(rowp + 32);
                    const GAS f32x4* cs = (const GAS f32x4*)(CS + t * 32 + 8 * p); const f32x4 c0 = cs[0], c1 = cs[1], c2 = cs[2], c3 = cs[3];
                    float a1[8] = {bflo(x1.x), bfhi(x1.x), bflo(x1.y), bfhi(x1.y), bflo(x1.z), bfhi(x1.z), bflo(x1.w), bfhi(x1.w)};
                    float a2[8] = {bflo(x2.x), bfhi(x2.x), bflo(x2.y), bfhi(x2.y), bflo(x2.z), bfhi(x2.z), bflo(x2.w), bfhi(x2.w)};
                    float cc[8] = {c0.x, c0.z, c1.x, c1.z, c2.x, c2.z, c3.x, c3.z}, ss[8] = {c0.y, c0.w, c1.y, c1.w, c2.y, c2.w, c3.y, c3.w};
                    float o1[8], o2[8];
#pragma unroll
                    for (int e = 0; e < 8; ++e) { o1[e] = a1[e] * cc[e] - a2[e] * ss[e]; o2[e] = a2[e] * cc[e] + a1[e] * ss[e]; }
                    lo = (v4u){pk2(o1[0], o1[1]), pk2(o1[2], o1[3]), pk2(o1[4], o1[5]), pk2(o1[6], o1[7])}; hi = (v4u){pk2(o2[0], o2[1]), pk2(o2[2], o2[3]), pk2(o2[4], o2[5]), pk2(o2[6], o2[7])}; }
                *(LAS v4u*)(Kl + key * KS + 8 * p) = lo; *(LAS v4u*)(Kl + key * KS + 32 + 8 * p) = hi; }
#pragma unroll
            for (int r4 = 0; r4 < 4; ++r4) { const int idx = tid + 512 * r4, key = idx >> 3, pc = idx & 7, ik = i0 - 128 + key;
                v4u x = {0u, 0u, 0u, 0u};
                if (ik >= 0) { const int t = ik * dl + rho; x = *(const GAS v4u*)(ZA + (size_t)(b * SEQ + t) * ZA_LD + colv + 8 * pc); }
                LAS bf16* vp = VT + (8 * pc) * VS + key;
                vp[0] = (bf16)(x.x & 0xffffu); vp[VS] = (bf16)(x.x >> 16); vp[2 * VS] = (bf16)(x.y & 0xffffu); vp[3 * VS] = (bf16)(x.y >> 16);
                vp[4 * VS] = (bf16)(x.z & 0xffffu); vp[5 * VS] = (bf16)(x.z >> 16); vp[6 * VS] = (bf16)(x.w & 0xffffu); vp[7 * VS] = (bf16)(x.w >> 16); }
            const int tq = (i0 + 16 * wave + lr) * dl + rho; const size_t trow = (size_t)(b * SEQ + tq);
            bf16x8 qf0, qf1;
            { const bf16* rowp = ZA + trow * ZA_LD + colq + 8 * lq; const v4u x1 = *(const GAS v4u*)rowp, x2 = *(const GAS v4u*)(rowp + 32);
              const GAS f32x4* cs = (const GAS f32x4*)(CS + tq * 32 + 8 * lq); const f32x4 c0 = cs[0], c1 = cs[1], c2 = cs[2], c3 = cs[3];
              float a1[8] = {bflo(x1.x), bfhi(x1.x), bflo(x1.y), bfhi(x1.y), bflo(x1.z), bfhi(x1.z), bflo(x1.w), bfhi(x1.w)};
              float a2[8] = {bflo(x2.x), bfhi(x2.x), bflo(x2.y), bfhi(x2.y), bflo(x2.z), bfhi(x2.z), bflo(x2.w), bfhi(x2.w)};
              float cc[8] = {c0.x, c0.z, c1.x, c1.z, c2.x, c2.z, c3.x, c3.z}, ss[8] = {c0.y, c0.w, c1.y, c1.w, c2.y, c2.w, c3.y, c3.w};
              const float qs = 0.125f * 1.4426950408889634f; float o1[8], o2[8];
#pragma unroll
              for (int e = 0; e < 8; ++e) { o1[e] = (a1[e] * cc[e] - a2[e] * ss[e]) * qs; o2[e] = (a2[e] * cc[e] + a1[e] * ss[e]) * qs; }
              const v4u lo = {pk2(o1[0], o1[1]), pk2(o1[2], o1[3]), pk2(o1[4], o1[5]), pk2(o1[6], o1[7])}, hi = {pk2(o2[0], o2[1]), pk2(o2[2], o2[3]), pk2(o2[4], o2[5]), pk2(o2[6], o2[7])};
              qf0 = __builtin_bit_cast(bf16x8, lo); qf1 = __builtin_bit_cast(bf16x8, hi); }
            __syncthreads();
            f32x4 sc[9]; float m = -INFINITY;
#pragma unroll
            for (int kt = 0; kt < 9; ++kt) { const LAS bf16* kp = Kl + (16 * wave + 16 * kt + lr) * KS + 8 * lq;
                const bf16x8 a0 = *(const LAS bf16x8*)kp, a1 = *(const LAS bf16x8*)(kp + 32);
                f32x4 acc = {0.f, 0.f, 0.f, 0.f};
                acc = __builtin_amdgcn_mfma_f32_16x16x32_bf16(a0, qf0, acc, 0, 0, 0); acc = __builtin_amdgcn_mfma_f32_16x16x32_bf16(a1, qf1, acc, 0, 0, 0);
#pragma unroll
                for (int i = 0; i < 4; ++i) { const int ko = 4 * lq + i; const int ik = i0 - 128 + 16 * wave + 16 * kt + ko;
                    const bool valid = (ik >= 0) && (kt > 0 || ko >= lr) && (kt < 8 || ko <= lr);
                    acc[i] = valid ? acc[i] : -INFINITY; m = fmaxf(m, acc[i]); }
                sc[kt] = acc; }
            m = fmaxf(m, __shfl_xor(m, 16)); m = fmaxf(m, __shfl_xor(m, 32));
            float l = 0.f;
#pragma unroll
            for (int kt = 0; kt < 9; ++kt)
#pragma unroll
                for (int i = 0; i < 4; ++i) { const float pj = __builtin_amdgcn_exp2f(sc[kt][i] - m); sc[kt][i] = pj; l += pj; }
            l += __shfl_xor(l, 16); l += __shfl_xor(l, 32);
            bf16x8 pb[5];
#pragma unroll
            for (int st = 0; st < 5; ++st) { const f32x4 t0v = sc[2 * st]; const f32x4 t1v = (st < 4) ? sc[2 * st + 1] : (f32x4){0.f, 0.f, 0.f, 0.f};
                const v4u pk = {pk2(t0v[0], t0v[1]), pk2(t0v[2], t0v[3]), pk2(t1v[0], t1v[1]), pk2(t1v[2], t1v[3])}; pb[st] = __builtin_bit_cast(bf16x8, pk); }
            const float il = 1.0f / l;
#pragma unroll
            for (int dt = 0; dt < 4; ++dt) { f32x4 acc = {0.f, 0.f, 0.f, 0.f};
#pragma unroll
                for (int st = 0; st < 5; ++st) { const LAS bf16* vp = VT + (16 * dt + lr) * VS + 16 * wave + 32 * st + 4 * lq;
                    const v2u v0 = *(const LAS v2u*)vp; const v2u v1 = (st < 4) ? *(const LAS v2u*)(vp + 16) : (v2u){0u, 0u};
                    const v4u av = {v0.x, v0.y, v1.x, v1.y};
                    acc = __builtin_amdgcn_mfma_f32_16x16x32_bf16(__builtin_bit_cast(bf16x8, av), pb[st], acc, 0, 0, 0); }
                *(GAS unsigned long long*)(OG + ((size_t)g * T + trow) * 256 + h * 64 + 16 * dt + 4 * lq) = (unsigned long long)pk2(acc[0] * il, acc[1] * il) | ((unsigned long long)pk2(acc[2] * il, acc[3] * il) << 32); }
            if (lq == 0) LSE[((size_t)g * T + trow) * 4 + h] = (m + __builtin_amdgcn_logf(l)) * 0.6931471805599453f;
            __syncthreads();
        }
        if (BOTH(PH_ATT)) GRID_BAR();
    }

    if (IN(PH_PREP)) { PH_BEGIN
        {
            const bf16* const OG = (const bf16*)(ws + WS_OG); const float* const LSE = (const float*)(ws + WS_LSE); bf16* const OA = (bf16*)(ws + WS_OA);
            for (int i = gt; i < T * 32; i += NGT) { const int t = i >> 5, h = (i >> 3) & 3, c8 = i & 7;
                const float l0 = LSE[((size_t)0 * T + t) * 4 + h], l1 = LSE[((size_t)1 * T + t) * 4 + h], l2 = LSE[((size_t)2 * T + t) * 4 + h];
                const float mx = fmaxf(l0, fmaxf(l1, l2)); const float e0 = __expf(l0 - mx), e1 = __expf(l1 - mx), e2 = __expf(l2 - mx); const float inv = 1.0f / (e0 + e1 + e2);
                const float a0 = e0 * inv, a1 = e1 * inv, a2 = e2 * inv;
                const v4u x0 = *(const GAS v4u*)(OG + ((size_t)0 * T + t) * 256 + h * 64 + 8 * c8), x1 = *(const GAS v4u*)(OG + ((size_t)1 * T + t) * 256 + h * 64 + 8 * c8), x2 = *(const GAS v4u*)(OG + ((size_t)2 * T + t) * 256 + h * 64 + 8 * c8);
                v4u w;
                w.x = pk2(a0 * bflo(x0.x) + a1 * bflo(x1.x) + a2 * bflo(x2.x), a0 * bfhi(x0.x) + a1 * bfhi(x1.x) + a2 * bfhi(x2.x));
                w.y = pk2(a0 * bflo(x0.y) + a1 * bflo(x1.y) + a2 * bflo(x2.y), a0 * bfhi(x0.y) + a1 * bfhi(x1.y) + a2 * bfhi(x2.y));
                w.z = pk2(a0 * bflo(x0.z) + a1 * bflo(x1.z) + a2 * bflo(x2.z), a0 * bfhi(x0.z) + a1 * bfhi(x1.z) + a2 * bfhi(x2.z));
                w.w = pk2(a0 * bflo(x0.w) + a1 * bflo(x1.w) + a2 * bflo(x2.w), a0 * bfhi(x0.w) + a1 * bfhi(x1.w) + a2 * bfhi(x2.w));
                *(GAS v4u*)(OA + (size_t)t * 256 + h * 64 + 8 * c8) = w; }
        }
        {
            const float* const mu = args.in[4]; const float* const w0 = args.in[5]; const float* const w2 = args.in[6]; const float* const a0 = args.in[7];
            const float* const a2 = args.in[8]; const float* const g2 = args.in[9]; const float* const k_k = args.in[10]; const float* const k_a = args.in[11]; const float* const r_k = args.in[12];
            bf16* const Rb = (bf16*)(ws + WS_R); bf16* const Kb = (bf16*)(ws + WS_KP); bf16* const Vb = (bf16*)(ws + WS_V); bf16* const AVb = (bf16*)(ws + WS_AV);
            float* const DEC = (float*)((unsigned char*)out + DO_DEC);   bf16* const BVb = (bf16*)((unsigned char*)out + DO_BV); bf16* const GTb = (bf16*)((unsigned char*)out + DO_GT);
            float* const BONUS = (float*)(ws + WS_BONUS);
            const int lr = lane & 15, lq = lane >> 4;
            constexpr int LAS_ = 168;
            float mu_r[4], mu_k[4], mu_v[4], w0c[4], a0c[4], kkc[4], kac[4], rkc[4];
            bf16x8 w2f[4], a2f[4], g2f[4][3];
#pragma unroll
            for (int nt = 0; nt < 4; ++nt) { const int cc = wave * 64 + 16 * nt + lr;
                mu_r[nt] = mu[cc]; mu_k[nt] = mu[512 + cc]; mu_v[nt] = mu[1024 + cc]; w0c[nt] = w0[cc]; a0c[nt] = a0[cc]; kkc[nt] = k_k[cc]; kac[nt] = k_a[cc]; rkc[nt] = r_k[cc];
                { const float* p = w2 + (8 * lq) * RW + cc; const v4u t = {pk2(p[0], p[RW]), pk2(p[2 * RW], p[3 * RW]), pk2(p[4 * RW], p[5 * RW]), pk2(p[6 * RW], p[7 * RW])}; w2f[nt] = __builtin_bit_cast(bf16x8, t); }
                { const float* p = a2 + (8 * lq) * RW + cc; const v4u t = {pk2(p[0], p[RW]), pk2(p[2 * RW], p[3 * RW]), pk2(p[4 * RW], p[5 * RW]), pk2(p[6 * RW], p[7 * RW])}; a2f[nt] = __builtin_bit_cast(bf16x8, t); }
#pragma unroll
                for (int sk = 0; sk < 3; ++sk) { const float* p = g2 + (32 * sk + 8 * lq) * RW + cc; const v4u t = {pk2(p[0], p[RW]), pk2(p[2 * RW], p[3 * RW]), pk2(p[4 * RW], p[5 * RW]), pk2(p[6 * RW], p[7 * RW])}; g2f[nt][sk] = __builtin_bit_cast(bf16x8, t); } }
            LAS bf16* La = (LAS bf16*)(lds + RING_OFF);
            LAS bf16* Zs = (LAS bf16*)(lds + RING_OFF + 16384);
            for (int tile = vcu; tile < T / 16; tile += G) {
                const int t0 = tile * 16; const bool first = (t0 & (SEQ - 1)) == 0;
                for (int p = tid; p < 17 * 224; p += 512) { const int r = p / 224, cp = p - r * 224; v4u xz = {0u, 0u, 0u, 0u};
                    if (!(r == 0 && first)) xz = *(const GAS v4u*)(ZR + (size_t)(t0 - 1 + r) * ZR_LD + cp * 8);
                    *(LAS v4u*)(Zs + r * 1792 + cp * 8) = xz; }
                __syncthreads();
                for (int idx = tid; idx < 16 * 160; idx += 512) { const int tok = idx / 160, j = idx - tok * 160;
                    const float z = bf2f(Zs[(tok + 1) * 1792 + 1536 + j]), zp = bf2f(Zs[tok * 1792 + 1536 + j]);
                    const float xx = z + (zp - z) * mu[1536 + j];
                    La[tok * LAS_ + j] = (bf16)f2bf((j < 32) ? tanhf(xx) : (j < 64) ? xx : sigmoidf_(xx)); }
                __syncthreads();
                const LAS bf16* Lr = La + lr * LAS_ + 8 * lq;
                const bf16x8 aw = *(const LAS bf16x8*)Lr, aa = *(const LAS bf16x8*)(Lr + 32), ag0 = *(const LAS bf16x8*)(Lr + 64), ag1 = *(const LAS bf16x8*)(Lr + 96), ag2 = *(const LAS bf16x8*)(Lr + 128);
                float ssum[4] = {0.f, 0.f, 0.f, 0.f}, bsum[4] = {0.f, 0.f, 0.f, 0.f}; float kkv[4][4], aav[4][4];
#pragma unroll
                for (int nt = 0; nt < 4; ++nt) { const int cc = wave * 64 + 16 * nt + lr;
                    f32x4 wl = {0.f, 0.f, 0.f, 0.f}, al = {0.f, 0.f, 0.f, 0.f}, gl = {0.f, 0.f, 0.f, 0.f};
                    wl = __builtin_amdgcn_mfma_f32_16x16x32_bf16(aw, w2f[nt], wl, 0, 0, 0); al = __builtin_amdgcn_mfma_f32_16x16x32_bf16(aa, a2f[nt], al, 0, 0, 0);
                    gl = __builtin_amdgcn_mfma_f32_16x16x32_bf16(ag0, g2f[nt][0], gl, 0, 0, 0); gl = __builtin_amdgcn_mfma_f32_16x16x32_bf16(ag1, g2f[nt][1], gl, 0, 0, 0); gl = __builtin_amdgcn_mfma_f32_16x16x32_bf16(ag2, g2f[nt][2], gl, 0, 0, 0);
#pragma unroll
                    for (int i = 0; i < 4; ++i) { const int tok = 4 * lq + i; const LAS bf16* zc = Zs + (tok + 1) * 1792 + cc; const LAS bf16* zq = Zs + tok * 1792 + cc;
                        const float zr = bf2f(zc[0]), zk = bf2f(zc[512]), zv = bf2f(zc[1024]);
                        const float r = zr + (bf2f(zq[0]) - zr) * mu_r[nt]; float k = zk + (bf2f(zq[512]) - zk) * mu_k[nt]; const float v = zv + (bf2f(zq[1024]) - zv) * mu_v[nt];
                        const float nx = -(w0c[nt] + wl[i]);
                        const float sp = fmaxf(nx, 0.f) + log1pf(__expf(-fabsf(nx)));
                        const float dec = -__expf(-sp - 0.5f);
                        const float a = sigmoidf_(a0c[nt] + al[i]);
                        const float kk = k * kkc[nt]; ssum[i] += kk * kk; kkv[nt][i] = kk; aav[nt][i] = a;
                        k = k * (1.0f + (a - 1.0f) * kac[nt]); bsum[i] += r * k * rkc[nt];
                        const size_t o = (size_t)(t0 + tok) * RW + cc;
                        Rb[o] = (bf16)f2bf(r); Kb[o] = (bf16)f2bf(k); Vb[o] = (bf16)f2bf(v); GTb[o] = (bf16)f2bf(gl[i]); DEC[o] = dec; } }
#pragma unroll
                for (int i = 0; i < 4; ++i) { float sv = quad_sum(ssum[i]); sv += dpp_f<0x141>(sv); sv += dpp_f<0x140>(sv); float bv = quad_sum(bsum[i]); bv += dpp_f<0x141>(bv); bv += dpp_f<0x140>(bv);
                    const float inv = 1.0f / fmaxf(sqrtf(sv), 1e-12f); const int tok = 4 * lq + i;
#pragma unroll
                    for (int nt = 0; nt < 4; ++nt) { const size_t o = (size_t)(t0 + tok) * RW + wave * 64 + 16 * nt + lr; const float kn = kkv[nt][i] * inv;
                        AVb[o] = (bf16)f2bf(-kn); BVb[o] = (bf16)f2bf(kn * aav[nt][i]); }
                    if (lr == 0) BONUS[(size_t)(t0 + tok) * 8 + wave] = bv; }
                __syncthreads();
            }
        }
        if (BOTH(PH_PREP)) GRID_BAR();
    }

    if (IN(PH_CHUNK)) { PH_BEGIN
        constexpr int LS = 72, FS = 68;
        bf16* const Rb = (bf16*)(ws + WS_R); bf16* const Kb = (bf16*)(ws + WS_KP); const bf16* const Vb = (const bf16*)(ws + WS_V); bf16* const AVb = (bf16*)(ws + WS_AV);
        float* const LW = (float*)((unsigned char*)out + DO_DEC); bf16* const BVb = (bf16*)((unsigned char*)out + DO_BV);
        bf16* const YLT = (bf16*)(ws + WS_YLT); float* const GC = (float*)(ws + WS_GC);
        LAS bf16* const At = (LAS bf16*)(lds + 0); LAS bf16* const Rt = (LAS bf16*)(lds + 9216); LAS bf16* const Bt = (LAS bf16*)(lds + 18432); LAS bf16* const Kt = (LAS bf16*)(lds + 27648);
        LAS bf16* const VmT = (LAS bf16*)(lds + 36864); LAS bf16* const KhT = (LAS bf16*)(lds + 46080); LAS bf16* const Lak = (LAS bf16*)(lds + 55296); LAS bf16* const Mrb = (LAS bf16*)(lds + 64512);
        LAS bf16* const Mrk = (LAS bf16*)(lds + 73728); LAS bf16* const BhT = (LAS bf16*)(lds + 82944); LAS float* const LabF = (LAS float*)(lds + 92160); LAS float* const X1F = (LAS float*)(lds + 109568);
        LAS bf16* const ApT = Bt; LAS bf16* const WT2 = Kt; LAS float* const cum = X1F;
        const int lr = lane & 15, lq = lane >> 4;
        for (int unit = vcu; unit < BATCH * 8 * (SEQ / 64); unit += G) {
            const int ch = unit & 127, h = (unit >> 7) & 7, b = unit >> 10;
            const size_t t0 = (size_t)b * SEQ + (size_t)ch * 64;
            const int c = tid >> 3, kq = tid & 7;
            const size_t goff = (t0 + c) * RW + h * 64 + kq * 8;
            const v4u r8 = *(const GAS v4u*)(Rb + goff), k8 = *(const GAS v4u*)(Kb + goff), v8 = *(const GAS v4u*)(Vb + goff), a8 = *(const GAS v4u*)(AVb + goff), b8 = *(const GAS v4u*)(BVb + goff);
            const f32x4 lw0 = *(const GAS f32x4*)(LW + goff), lw1 = *(const GAS f32x4*)(LW + goff + 4);
            float lwv[8] = {lw0.x, lw0.y, lw0.z, lw0.w, lw1.x, lw1.y, lw1.z, lw1.w};
#pragma unroll
            for (int i = 0; i < 8; ++i) cum[c * 65 + kq * 8 + i] = lwv[i];
            __syncthreads();
#pragma unroll
            for (int i = 0; i < 8; ++i) { const int chn = 8 * wave + i; float xx = cum[lane * 65 + chn];
#pragma unroll
                for (int o = 1; o < 64; o <<= 1) { const float yy = __shfl_up(xx, o); if (lane >= o) xx += yy; }
                cum[lane * 65 + chn] = xx; }
            __syncthreads();
            {
                float rr[8], kk8[8], vv[8], aa[8], bb[8];
                rr[0] = bflo(r8.x); rr[1] = bfhi(r8.x); rr[2] = bflo(r8.y); rr[3] = bfhi(r8.y); rr[4] = bflo(r8.z); rr[5] = bfhi(r8.z); rr[6] = bflo(r8.w); rr[7] = bfhi(r8.w);
                kk8[0] = bflo(k8.x); kk8[1] = bfhi(k8.x); kk8[2] = bflo(k8.y); kk8[3] = bfhi(k8.y); kk8[4] = bflo(k8.z); kk8[5] = bfhi(k8.z); kk8[6] = bflo(k8.w); kk8[7] = bfhi(k8.w);
                vv[0] = bflo(v8.x); vv[1] = bfhi(v8.x); vv[2] = bflo(v8.y); vv[3] = bfhi(v8.y); vv[4] = bflo(v8.z); vv[5] = bfhi(v8.z); vv[6] = bflo(v8.w); vv[7] = bfhi(v8.w);
                aa[0] = bflo(a8.x); aa[1] = bfhi(a8.x); aa[2] = bflo(a8.y); aa[3] = bfhi(a8.y); aa[4] = bflo(a8.z); aa[5] = bfhi(a8.z); aa[6] = bflo(a8.w); aa[7] = bfhi(a8.w);
                bb[0] = bflo(b8.x); bb[1] = bfhi(b8.x); bb[2] = bflo(b8.y); bb[3] = bfhi(b8.y); bb[4] = bflo(b8.z); bb[5] = bfhi(b8.z); bb[6] = bflo(b8.w); bb[7] = bfhi(b8.w);
                float at[8], rt[8], bt[8], kt[8];
#pragma unroll
                for (int i = 0; i < 8; ++i) { const float cu = cum[c * 65 + kq * 8 + i], cC = cum[63 * 65 + kq * 8 + i];
                    const float ep = __expf(cu), em = __expf(-cu), epv = __expf(cu - lwv[i]), eh = __expf(cC - cu);
                    at[i] = aa[i] * epv; rt[i] = rr[i] * ep; bt[i] = bb[i] * em; kt[i] = kk8[i] * em;
                    const int kk_ = kq * 8 + i;
                    VmT[kk_ * LS + c] = (bf16)f2bf(vv[i]); KhT[kk_ * LS + c] = (bf16)f2bf(kk8[i] * eh); BhT[kk_ * LS + c] = (bf16)f2bf(bb[i] * eh);
                    if (c == 63) GC[(size_t)unit * 64 + kk_] = __expf(cC); }
                *(LAS v4u*)(At + c * LS + kq * 8) = (v4u){pk2(at[0], at[1]), pk2(at[2], at[3]), pk2(at[4], at[5]), pk2(at[6], at[7])};
                *(LAS v4u*)(Rt + c * LS + kq * 8) = (v4u){pk2(rt[0], rt[1]), pk2(rt[2], rt[3]), pk2(rt[4], rt[5]), pk2(rt[6], rt[7])};
                *(LAS v4u*)(Bt + c * LS + kq * 8) = (v4u){pk2(bt[0], bt[1]), pk2(bt[2], bt[3]), pk2(bt[4], bt[5]), pk2(bt[6], bt[7])};
                *(LAS v4u*)(Kt + c * LS + kq * 8) = (v4u){pk2(kt[0], kt[1]), pk2(kt[2], kt[3]), pk2(kt[4], kt[5]), pk2(kt[6], kt[7])};
            }
            __syncthreads();
            {
                const int p = wave >> 1; const LAS bf16* Ab = (p < 2) ? At : Rt; const LAS bf16* Bb = (p & 1) ? Kt : Bt;
                LAS bf16* dstb = (p == 1) ? Lak : (p == 2) ? Mrb : Mrk;
#pragma unroll 1
                for (int tl = (wave & 1) * 8; tl < (wave & 1) * 8 + 8; ++tl) { const int mt = tl >> 2, nt = tl & 3;
                    f32x4 acc = {0.f, 0.f, 0.f, 0.f};
                    if (nt <= mt) {
#pragma unroll
                        for (int ks = 0; ks < 2; ++ks) { const bf16x8 a = *(const LAS bf16x8*)(Ab + (16 * mt + lr) * LS + 32 * ks + 8 * lq), bq = *(const LAS bf16x8*)(Bb + (16 * nt + lr) * LS + 32 * ks + 8 * lq);
                            acc = __builtin_amdgcn_mfma_f32_16x16x32_bf16(a, bq, acc, 0, 0, 0); } }
                    const int col = 16 * nt + lr;
#pragma unroll
                    for (int i = 0; i < 4; ++i) { const int row = 16 * mt + 4 * lq + i; const bool keep = (p < 2) ? (col < row) : (col <= row); const float val = keep ? acc[i] : 0.f;
                        if (p == 0) LabF[row * FS + (col & 3) * 16 + (col >> 2)] = val; else dstb[row * LS + col] = (bf16)f2bf(val); } }
            }
            __syncthreads();
#pragma unroll 1
            for (int tl = wave * 2; tl < wave * 2 + 2; ++tl) { const int mt = tl >> 2, nt = tl & 3; f32x4 acc = {0.f, 0.f, 0.f, 0.f};
#pragma unroll
                for (int ks = 0; ks < 2; ++ks) { const bf16x8 a = *(const LAS bf16x8*)(Lak + (16 * mt + lr) * LS + 32 * ks + 8 * lq), bq = *(const LAS bf16x8*)(VmT + (16 * nt + lr) * LS + 32 * ks + 8 * lq);
                    acc = __builtin_amdgcn_mfma_f32_16x16x32_bf16(a, bq, acc, 0, 0, 0); }
#pragma unroll
                for (int i = 0; i < 4; ++i) X1F[(16 * mt + 4 * lq + i) * FS + 16 * nt + lr] = acc[i]; }
            __syncthreads();
            {
                const int jl = lane >> 2, part = lane & 3, j = 16 * (wave & 3) + jl;
                float xp[16];
                if (wave < 4) {
#pragma unroll
                    for (int m = 0; m < 16; ++m) xp[m] = bf2f(At[(4 * m + part) * LS + j]);
                } else {
#pragma unroll
                    for (int m = 0; m < 16; ++m) xp[m] = X1F[(4 * m + part) * FS + j];
                }
                int lpo = part * 16;
#pragma unroll
                for (int t = 1; t < 64; ++t) { const int tm = t >> 2, tp = t & 3; float s0 = 0.f, s1 = 0.f;
#pragma unroll
                    for (int m4 = 0; m4 <= tm / 4; ++m4) { const f32x4 L4 = *(const LAS f32x4*)(LabF + lpo + t * FS + 4 * m4);
                        s0 += L4.x * xp[4 * m4]; if (4 * m4 + 1 <= tm) s1 += L4.y * xp[4 * m4 + 1]; if (4 * m4 + 2 <= tm) s0 += L4.z * xp[4 * m4 + 2]; if (4 * m4 + 3 <= tm) s1 += L4.w * xp[4 * m4 + 3]; }
                    const float sum = quad_sum(s0 + s1);
                    xp[tm] = (part == tp) ? xp[tm] + sum : xp[tm];
                    if (tp == 3) asm volatile("" : "+v"(lpo) : "v"(xp[tm])); }
                LAS bf16* dl = (wave < 4) ? ApT : WT2;
#pragma unroll
                for (int m = 0; m < 16; ++m) dl[j * LS + 4 * m + part] = (bf16)f2bf(xp[m]);
            }
            __syncthreads();
            {
                const int kind = wave >> 1;
#pragma unroll 1
                for (int tl = (wave & 1) * 8; tl < (wave & 1) * 8 + 8; ++tl) { const int mt = tl >> 2, nt = tl & 3; f32x4 acc = {0.f, 0.f, 0.f, 0.f};
                    const LAS bf16* A1 = (kind == 0) ? Mrb : (kind == 2) ? ApT : WT2;
                    const LAS bf16* B1 = (kind == 0) ? ApT : (kind == 1) ? Mrb : BhT;
#pragma unroll
                    for (int ks = 0; ks < 2; ++ks) { const bf16x8 a = *(const LAS bf16x8*)(A1 + (16 * mt + lr) * LS + 32 * ks + 8 * lq), bq = *(const LAS bf16x8*)(B1 + (16 * nt + lr) * LS + 32 * ks + 8 * lq);
                        acc = __builtin_amdgcn_mfma_f32_16x16x32_bf16(a, bq, acc, 0, 0, 0); }
                    if (kind == 1 || kind == 3) { const LAS bf16* A2 = VmT; const LAS bf16* B2 = (kind == 1) ? Mrk : KhT;
#pragma unroll
                        for (int ks = 0; ks < 2; ++ks) { const bf16x8 a = *(const LAS bf16x8*)(A2 + (16 * mt + lr) * LS + 32 * ks + 8 * lq), bq = *(const LAS bf16x8*)(B2 + (16 * nt + lr) * LS + 32 * ks + 8 * lq);
                            acc = __builtin_amdgcn_mfma_f32_16x16x32_bf16(a, bq, acc, 0, 0, 0); } }
                    if (kind == 0) {
#pragma unroll
                        for (int i = 0; i < 4; ++i) { const int row = 16 * mt + 4 * lq + i, col = 16 * nt + lr; Kb[(t0 + row) * RW + h * 64 + col] = (bf16)f2bf(acc[i] + bf2f(Rt[row * LS + col])); }
                    } else {
                        bf16* dst = (kind == 1) ? YLT : (kind == 2) ? Rb : AVb;
                        *(GAS unsigned long long*)(dst + (t0 + 16 * nt + lr) * RW + h * 64 + 16 * mt + 4 * lq) = (unsigned long long)pg8::cvt_pk_bf16(acc[0], acc[1]) | ((unsigned long long)pg8::cvt_pk_bf16(acc[2], acc[3]) << 32);
                    } }
            }
            __syncthreads();
        }
        if (BOTH(PH_CHUNK)) GRID_BAR();
    }

    if (IN(PH_SEQ)) { PH_BEGIN
        if (vcu < BATCH * 8 * 4 && wave == 0) {
            constexpr int LS = 72;
            const bf16* const PhiT = (const bf16*)(ws + WS_R); const bf16* const PsiT = (const bf16*)(ws + WS_AV); const float* const GC = (const float*)(ws + WS_GC);
            bf16* const SST = (bf16*)((unsigned char*)out + DO_BV);
            const int chain = vcu >> 2, q = vcu & 3, b = chain >> 3, h = chain & 7, lr = lane & 15, lq = lane >> 4;
            LAS bf16* const Sbf = (LAS bf16*)(lds + RING_OFF);
            for (int i = lane; i < 16 * LS / 2; i += 64) ((LAS unsigned*)Sbf)[i] = 0u;
            f32x4 st[4];
#pragma unroll
            for (int nt = 0; nt < 4; ++nt) st[nt] = (f32x4){0.f, 0.f, 0.f, 0.f};
            v4u phA[8], phB[8], phC[8], phD[8]; v2u psA[4], psB[4], psC[4], psD[4]; float gA[4], gB[4], gC4[4], gD[4];
#define SQ_LOAD(ph, ps, gg, ck) do { const size_t tb = (size_t)b * SEQ + (size_t)(ck) * 64; \
        _Pragma("unroll") for (int nt = 0; nt < 4; ++nt) { const size_t ro = (tb + 16 * nt + lr) * RW + h * 64; \
            ph[2 * nt] = *(const GAS v4u*)(PhiT + ro + 8 * lq); ph[2 * nt + 1] = *(const GAS v4u*)(PhiT + ro + 32 + 8 * lq); \
            ps[nt] = *(const GAS v2u*)(PsiT + ro + 16 * q + 4 * lq); gg[nt] = GC[((size_t)(chain * 128 + (ck))) * 64 + 16 * nt + lr]; } } while (0)
#define SQ_STEP(ph, ps, gg, ck) do { \
        const bf16x8 a0 = *(const LAS bf16x8*)(Sbf + lr * LS + 8 * lq), a1 = *(const LAS bf16x8*)(Sbf + lr * LS + 32 + 8 * lq); \
        { const size_t so = ((size_t)b * SEQ + (size_t)(ck) * 64 + 16 * q + lr) * RW + h * 64; *(GAS bf16x8*)(SST + so + 8 * lq) = a0; *(GAS bf16x8*)(SST + so + 32 + 8 * lq) = a1; } \
        _Pragma("unroll") for (int nt = 0; nt < 4; ++nt) { \
            st[nt] = st[nt] * gg[nt] + (f32x4){bflo(ps[nt].x), bfhi(ps[nt].x), bflo(ps[nt].y), bfhi(ps[nt].y)}; \
            st[nt] = __builtin_amdgcn_mfma_f32_16x16x32_bf16(a0, __builtin_bit_cast(bf16x8, ph[2 * nt]), st[nt], 0, 0, 0); \
            st[nt] = __builtin_amdgcn_mfma_f32_16x16x32_bf16(a1, __builtin_bit_cast(bf16x8, ph[2 * nt + 1]), st[nt], 0, 0, 0); } \
        _Pragma("unroll") for (int nt = 0; nt < 4; ++nt) { const unsigned p01 = pg8::cvt_pk_bf16(st[nt][0], st[nt][1]), p23 = pg8::cvt_pk_bf16(st[nt][2], st[nt][3]); \
            Sbf[(4 * lq + 0) * LS + 16 * nt + lr] = (bf16)(p01 & 0xffffu); Sbf[(4 * lq + 1) * LS + 16 * nt + lr] = (bf16)(p01 >> 16); \
            Sbf[(4 * lq + 2) * LS + 16 * nt + lr] = (bf16)(p23 & 0xffffu); Sbf[(4 * lq + 3) * LS + 16 * nt + lr] = (bf16)(p23 >> 16); } } while (0)
            SQ_LOAD(phA, psA, gA, 0); SQ_LOAD(phB, psB, gB, 1); SQ_LOAD(phC, psC, gC4, 2); SQ_LOAD(phD, psD, gD, 3);
            for (int ck = 0; ck < SEQ / 64; ck += 4) {
                SQ_STEP(phA, psA, gA, ck);      if (ck + 4 < SEQ / 64) SQ_LOAD(phA, psA, gA, ck + 4);
                SQ_STEP(phB, psB, gB, ck + 1);  if (ck + 5 < SEQ / 64) SQ_LOAD(phB, psB, gB, ck + 5);
                SQ_STEP(phC, psC, gC4, ck + 2); if (ck + 6 < SEQ / 64) SQ_LOAD(phC, psC, gC4, ck + 6);
                SQ_STEP(phD, psD, gD, ck + 3);  if (ck + 7 < SEQ / 64) SQ_LOAD(phD, psD, gD, ck + 7);
            }
#undef SQ_LOAD
#undef SQ_STEP
        }
        if (BOTH(PH_SEQ)) GRID_BAR();
    }

    if (IN(PH_POST)) { PH_BEGIN
        const bf16* const RPg = (const bf16*)(ws + WS_KP); const bf16* const SST = (const bf16*)((unsigned char*)out + DO_BV); const bf16* const YL = (const bf16*)(ws + WS_YLT);
        const bf16* const Vb = (const bf16*)(ws + WS_V); const bf16* const GTb = (const bf16*)((unsigned char*)out + DO_GT); const float* const BONUS = (const float*)(ws + WS_BONUS);
        bf16* const ORW = (bf16*)(ws + WS_ORW);
        const int lr = lane & 15, lq = lane >> 4;
        for (int unit = gw; unit < BATCH * 8 * (SEQ / 64); unit += NGW) {
            const int ch = unit & 127, h = (unit >> 7) & 7, b = unit >> 10;
            const size_t t0 = (size_t)b * SEQ + (size_t)ch * 64;
            bf16x8 sa[4][2];
#pragma unroll
            for (int vt = 0; vt < 4; ++vt)
#pragma unroll
                for (int ks = 0; ks < 2; ++ks) sa[vt][ks] = *(const GAS bf16x8*)(SST + (t0 + 16 * vt + lr) * RW + h * 64 + 32 * ks + 8 * lq);
            f32x4 lnw[4], lnb[4];
#pragma unroll
            for (int vt = 0; vt < 4; ++vt) { lnw[vt] = *(const GAS f32x4*)(args.in[13] + h * 64 + 16 * vt + 4 * lq); lnb[vt] = *(const GAS f32x4*)(args.in[14] + h * 64 + 16 * vt + 4 * lq); }
#pragma unroll 2
            for (int ct = 0; ct < 4; ++ct) {
                const size_t trow = t0 + 16 * ct + lr;
                const bf16x8 rb0 = *(const GAS bf16x8*)(RPg + trow * RW + h * 64 + 8 * lq), rb1 = *(const GAS bf16x8*)(RPg + trow * RW + h * 64 + 32 + 8 * lq);
                v2u yl[4], vv[4], gg[4];
#pragma unroll
                for (int vt = 0; vt < 4; ++vt) { const size_t o = trow * RW + h * 64 + 16 * vt + 4 * lq; yl[vt] = *(const GAS v2u*)(YL + o); vv[vt] = *(const GAS v2u*)(Vb + o); gg[vt] = *(const GAS v2u*)(GTb + o); }
                const float bon = BONUS[trow * 8 + h];
                f32x4 y[4]; float sm = 0.f;
#pragma unroll
                for (int vt = 0; vt < 4; ++vt) { y[vt] = (f32x4){bflo(yl[vt].x), bfhi(yl[vt].x), bflo(yl[vt].y), bfhi(yl[vt].y)};
                    y[vt] = __builtin_amdgcn_mfma_f32_16x16x32_bf16(sa[vt][0], rb0, y[vt], 0, 0, 0); y[vt] = __builtin_amdgcn_mfma_f32_16x16x32_bf16(sa[vt][1], rb1, y[vt], 0, 0, 0);
                    sm += (y[vt][0] + y[vt][1]) + (y[vt][2] + y[vt][3]); }
                sm += __shfl_xor(sm, 16); sm += __shfl_xor(sm, 32);
                const float mean = sm * (1.f / 64.f); float sq = 0.f;
#pragma unroll
                for (int vt = 0; vt < 4; ++vt) { y[vt] = y[vt] - mean; sq += (y[vt][0] * y[vt][0] + y[vt][1] * y[vt][1]) + (y[vt][2] * y[vt][2] + y[vt][3] * y[vt][3]); }
                sq += __shfl_xor(sq, 16); sq += __shfl_xor(sq, 32);
                const float rstd = 1.f / sqrtf(sq * (1.f / 64.f) + GN_EPS);
#pragma unroll
                for (int vt = 0; vt < 4; ++vt) { const size_t o = trow * RW + h * 64 + 16 * vt + 4 * lq;
                    const float o0 = (y[vt][0] * rstd * lnw[vt][0] + lnb[vt][0] + bon * bflo(vv[vt].x)) * bflo(gg[vt].x), o1 = (y[vt][1] * rstd * lnw[vt][1] + lnb[vt][1] + bon * bfhi(vv[vt].x)) * bfhi(gg[vt].x);
                    const float o2 = (y[vt][2] * rstd * lnw[vt][2] + lnb[vt][2] + bon * bflo(vv[vt].y)) * bflo(gg[vt].y), o3 = (y[vt][3] * rstd * lnw[vt][3] + lnb[vt][3] + bon * bfhi(vv[vt].y)) * bfhi(gg[vt].y);
                    *(GAS v2u*)(ORW + o) = (v2u){pk2(o0, o1), pk2(o2, o3)}; }
            }
        }
        if (BOTH(PH_POST)) GRID_BAR();
    }

    if (IN(PH_UPA)) { PH_BEGIN
        pg8::Gemm g{(const bf16*)(ws + WS_OA), WauT, T, D, 256}; pg8::StaticOrder S; S.init(T, D, G, (int)blockIdx.x);
        pg8::EpiGateF32 E{out, ZG, ZG_LD, 0};
        pg8::gemm_phase<pg8::EpiGateF32, pg8::StaticOrder, PG8_ALIGN, PG8_SP2>(lds + RING_OFF, g, S, E);
        if (BOTH(PH_UPA)) GRID_BAR();
    }
    if (IN(PH_UPR)) { PH_BEGIN
        pg8::Gemm g{(const bf16*)(ws + WS_ORW), WruT, T, D, 512}; pg8::StaticOrder S; S.init(T, D, G, (int)blockIdx.x);
        pg8::EpiMerge E{out, ZG, ZG_LD, 1024, (bf16*)(ws + WS_M1)};
        pg8::gemm_phase<pg8::EpiMerge, pg8::StaticOrder, PG8_ALIGN, PG8_SP2>(lds + RING_OFF, g, S, E);
        if (BOTH(PH_UPR)) GRID_BAR();
    }
    if (IN(PH_WO)) { PH_BEGIN
        pg8::Gemm g{(const bf16*)(ws + WS_M1), WoT, T, D, D}; pg8::StaticOrder S; S.init(T, D, G, (int)blockIdx.x);
        pg8::EpiF32<0> E{(float*)(ws + WS_TMP2A)};
        pg8::gemm_phase<pg8::EpiF32<0>, pg8::StaticOrder, PG8_ALIGN, PG8_SP2>(lds + RING_OFF, g, S, E);
        if (BOTH(PH_WO)) GRID_BAR();
    }
    if (IN(PH_ROWA)) { PH_BEGIN
        const float* const tmp = (const float*)(ws + WS_TMP2A); const float* const g1 = args.in[18]; const float* const g2 = args.in[19];
        for (int m = gw; m < T; m += NGW) {
            const GAS f32x4* tr = (const GAS f32x4*)(tmp + (size_t)m * D) + lane; const GAS f32x4* xr = (const GAS f32x4*)(x + (size_t)m * D) + lane;
            f32x4 v[4]; float s = 0.f;
#pragma unroll
            for (int j = 0; j < 4; ++j) { v[j] = tr[64 * j]; s += (v[j].x * v[j].x + v[j].y * v[j].y) + (v[j].z * v[j].z + v[j].w * v[j].w); }
            const float rs = 1.f / sqrtf(wave_sum(s) * (1.f / D) + NORM_EPS); float s2 = 0.f;
#pragma unroll
            for (int j = 0; j < 4; ++j) { const f32x4 gg = ((const GAS f32x4*)g1)[lane + 64 * j]; const f32x4 xx = xr[64 * j];
                v[j].x = xx.x + v[j].x * rs * gg.x; v[j].y = xx.y + v[j].y * rs * gg.y; v[j].z = xx.z + v[j].z * rs * gg.z; v[j].w = xx.w + v[j].w * rs * gg.w;
                ((GAS f32x4*)(out + (size_t)m * D))[lane + 64 * j] = v[j];
                s2 += (v[j].x * v[j].x + v[j].y * v[j].y) + (v[j].z * v[j].z + v[j].w * v[j].w); }
            const float rs2 = 1.f / sqrtf(wave_sum(s2) * (1.f / D) + NORM_EPS);
            GAS unsigned long long* o8 = (GAS unsigned long long*)(XN + (size_t)m * D) + lane;
#pragma unroll
            for (int j = 0; j < 4; ++j) { const f32x4 gg = ((const GAS f32x4*)g2)[lane + 64 * j];
                o8[64 * j] = (unsigned long long)pk2(v[j].x * rs2 * gg.x, v[j].y * rs2 * gg.y) | ((unsigned long long)pk2(v[j].z * rs2 * gg.z, v[j].w * rs2 * gg.w) << 32); }
        }
        if (BOTH(PH_ROWA)) GRID_BAR();
    }
    if (IN(PH_FFI)) { PH_BEGIN
        pg8::Gemm g{XN, WfiT, T, FF, D}; pg8::StaticOrder S; S.init(T, FF, G, (int)blockIdx.x);
        pg8::EpiRelu2 E{(bf16*)(ws + WS_H)};
        pg8::gemm_phase<pg8::EpiRelu2, pg8::StaticOrder, PG8_ALIGN, PG8_SP2>(lds + RING_OFF, g, S, E);
        if (BOTH(PH_FFI)) GRID_BAR();
    }
    if (IN(PH_FFO)) { PH_BEGIN
        pg8::Gemm g{(const bf16*)(ws + WS_H), WfoT, T, D, FF}; pg8::StaticOrder S; S.init(T, D, G, (int)blockIdx.x);
        pg8::EpiF32<0> E{(float*)(ws + WS_TMP2B)};
        pg8::gemm_phase<pg8::EpiF32<0>, pg8::StaticOrder, PG8_ALIGN, PG8_SP2>(lds + RING_OFF, g, S, E);
        if (BOTH(PH_FFO)) GRID_BAR();
    }
    if (IN(PH_ROWB)) { PH_BEGIN
        const float* const tmp = (const float*)(ws + WS_TMP2B); const float* const g1 = args.in[22];
        for (int m = gw; m < T; m += NGW) {
            const GAS f32x4* tr = (const GAS f32x4*)(tmp + (size_t)m * D) + lane; GAS f32x4* hr = (GAS f32x4*)(out + (size_t)m * D) + lane;
            f32x4 v[4]; float s = 0.f;
#pragma unroll
            for (int j = 0; j < 4; ++j) { v[j] = tr[64 * j]; s += (v[j].x * v[j].x + v[j].y * v[j].y) + (v[j].z * v[j].z + v[j].w * v[j].w); }
            const float rs = 1.f / sqrtf(wave_sum(s) * (1.f / D) + NORM_EPS);
            GAS unsigned long long* o8 = (GAS unsigned long long*)(XN + (size_t)m * D) + lane;
#pragma unroll
            for (int j = 0; j < 4; ++j) { const f32x4 gg = ((const GAS f32x4*)g1)[lane + 64 * j]; const f32x4 hh = hr[64 * j];
                v[j].x = hh.x + v[j].x * rs * gg.x; v[j].y = hh.y + v[j].y * rs * gg.y; v[j].z = hh.z + v[j].z * rs * gg.z; v[j].w = hh.w + v[j].w * rs * gg.w;
                hr[64 * j] = v[j];
                o8[64 * j] = (unsigned long long)pk2(v[j].x, v[j].y) | ((unsigned long long)pk2(v[j].z, v[j].w) << 32); }
        }
        if (BOTH(PH_ROWB)) GRID_BAR();
    }
    if (IN(PH_PLE)) { PH_BEGIN
        pg8::Gemm g{PB, WpleT, T, D, PLE}; pg8::StaticOrder S; S.init(T, D, G, (int)blockIdx.x);
        pg8::EpiF32<0> E{(float*)(ws + WS_E)};
        pg8::gemm_phase<pg8::EpiF32<0>, pg8::StaticOrder, PG8_ALIGN, PG8_SP2>(lds + RING_OFF, g, S, E);
        if (BOTH(PH_PLE)) GRID_BAR();
    }
    if (IN(PH_PLEG)) { PH_BEGIN
        pg8::Gemm g{XN, WpgT, T, D, D}; pg8::StaticOrder S; S.init(T, D, G, (int)blockIdx.x);
        pg8::EpiF32<1> E{(float*)(ws + WS_E)};
        pg8::gemm_phase<pg8::EpiF32<1>, pg8::StaticOrder, PG8_ALIGN, PG8_SP2>(lds + RING_OFF, g, S, E);
        if (BOTH(PH_PLEG)) GRID_BAR();
    }
    if (IN(PH_ROWC)) { PH_BEGIN
        const float* const tmp = (const float*)(ws + WS_E); const float* const g1 = args.in[25];
        for (int m = gw; m < T; m += NGW) {
            const GAS f32x4* tr = (const GAS f32x4*)(tmp + (size_t)m * D) + lane; GAS f32x4* hr = (GAS f32x4*)(out + (size_t)m * D) + lane;
            f32x4 v[4]; float s = 0.f;
#pragma unroll
            for (int j = 0; j < 4; ++j) { v[j] = tr[64 * j]; s += (v[j].x * v[j].x + v[j].y * v[j].y) + (v[j].z * v[j].z + v[j].w * v[j].w); }
            const float rs = 1.f / sqrtf(wave_sum(s) * (1.f / D) + NORM_EPS);
#pragma unroll
            for (int j = 0; j < 4; ++j) { const f32x4 gg = ((const GAS f32x4*)g1)[lane + 64 * j]; const f32x4 hh = hr[64 * j];
                v[j].x = hh.x + v[j].x * rs * gg.x; v[j].y = hh.y + v[j].y * rs * gg.y; v[j].z = hh.z + v[j].z * rs * gg.z; v[j].w = hh.w + v[j].w * rs * gg.w;
                hr[64 * j] = v[j]; }
        }
    }
#undef IN
#undef BOTH
}

extern "C" void kernel_launch(void* const* d_in, const int* in_sizes, int n_in, void* d_out, int out_size, void* d_ws, size_t ws_size, hipStream_t stream) {
    static int grid = 0;
    if (grid == 0) {
        if (n_in != 26 || in_sizes[0] != T * D || out_size != T * D || ws_size < WS_END) { fprintf(stderr, "kernel_launch: shape/workspace mismatch (n_in %d, in0 %d, out %d, ws %zu)\n", n_in, n_in > 0 ? in_sizes[0] : -1, out_size, ws_size); grid = -1; return; }
        int dev = 0, cus = 0, per_cu = 0;
        if (hipGetDevice(&dev) != hipSuccess || hipDeviceGetAttribute(&cus, hipDeviceAttributeMultiprocessorCount, dev) != hipSuccess) { grid = -1; return; }
        if (hipFuncSetAttribute((const void*)skel_fwd, hipFuncAttributeMaxDynamicSharedMemorySize, LDS_BYTES) != hipSuccess) { fprintf(stderr, "kernel_launch: hipFuncSetAttribute failed\n"); grid = -1; return; }
        if (hipOccupancyMaxActiveBlocksPerMultiprocessor(&per_cu, (const void*)skel_fwd, NWAVES * 64, LDS_BYTES) != hipSuccess || per_cu < 1) { fprintf(stderr, "kernel_launch: occupancy query says %d\n", per_cu); }
        (void)hipGetLastError();
        grid = cus;
    }
    if (grid < 0) return;
    if (hipMemsetAsync((char*)d_ws + WS_CTL, 0, CTL_ZERO_BYTES, stream) != hipSuccess) return;
    Args a{};
    for (int i = 0; i < 26; ++i) a.in[i] = (const float*)d_in[i];
    a.out = (float*)d_out; a.ws = (unsigned char*)d_ws;
#if MK_PER_PHASE
    for (int li = 0; li < N_PHASES; ++li) { a.ph_lo = li; a.ph_hi = li + 1; a.li = li; hipLaunchKernelGGL(skel_fwd, dim3(grid), dim3(NWAVES * 64), LDS_BYTES, stream, a); }
#else
    a.ph_lo = 0; a.ph_hi = N_PHASES; a.li = 0; hipLaunchKernelGGL(skel_fwd, dim3(grid), dim3(NWAVES * 64), LDS_BYTES, stream, a);
#endif
}
```
